# Optimizing an MI355X kernel written in HIP

```python
import jax, jax.numpy as jnp
from jax import lax
import numpy as np

D_MODEL = 1024
BATCH = 4
SEQ = 8192
DEPTH = 4

EPS = 1e-6
HEAD_DIM = 64
LRU_WIDTH = 384
LRU_BLOCKS = 6
LRU_BLOCK = LRU_WIDTH // LRU_BLOCKS
CONV_WIDTH = 4
LRU_C = 8.0
FOX_HEADS = 6
FOX_WIDTH = FOX_HEADS * HEAD_DIM
Q_BLOCK = 128
GLA_HEADS = 4
GLA_DK = 64
GLA_DV = 64
GLA_KW = GLA_HEADS * GLA_DK
GLA_VW = GLA_HEADS * GLA_DV
GLA_RANK = 16
GLA_TAU = 16.0
GLA_CHUNK = 64
D_MIX = LRU_WIDTH + FOX_WIDTH + GLA_VW
SPLIT_SIZES = (LRU_WIDTH, LRU_WIDTH, FOX_WIDTH, FOX_WIDTH, FOX_WIDTH, FOX_HEADS,
               GLA_KW, GLA_KW, GLA_VW, GLA_RANK, GLA_VW)
D_IN = sum(SPLIT_SIZES)
D_FF = -(-8 * D_MODEL // (3 * 256)) * 256
N_MOD = 6

kernel_name = 'hybrid_rglru_fox_gla_block'


def rms_norm(x, gain):
    xf = x.astype(jnp.float32)
    y = xf * lax.rsqrt(jnp.mean(xf * xf, axis=-1, keepdims=True) + EPS)
    return (y * gain.astype(jnp.float32)).astype(x.dtype)


def causal_depthwise_conv(x, w, b):
    S = x.shape[1]
    K = w.shape[0]
    xp = jnp.pad(x, ((0, 0), (K - 1, 0), (0, 0)))
    out = xp[:, K - 1:K - 1 + S] * w[K - 1] + b
    for j in range(K - 1):
        out = out + xp[:, j:j + S] * w[j]
    return out


def rg_lru(x, w_r, b_r, w_i, b_i, lam):
    B, S, _ = x.shape
    xb = x.reshape(B, S, LRU_BLOCKS, LRU_BLOCK)
    r = jax.nn.sigmoid(jnp.einsum('bsnd,nde->bsne', xb, w_r).reshape(B, S, LRU_WIDTH) + b_r)
    i = jax.nn.sigmoid(jnp.einsum('bsnd,nde->bsne', xb, w_i).reshape(B, S, LRU_WIDTH) + b_i)
    log_a = (-LRU_C * r.astype(jnp.float32) * jax.nn.softplus(-lam.astype(jnp.float32)))
    a = jnp.exp(log_a)
    mult = jnp.sqrt(-jnp.expm1(2.0 * log_a))
    u = mult * (i * x).astype(jnp.float32)

    def combine(left, right):
        a1, b1 = left
        a2, b2 = right
        return a1 * a2, a2 * b1 + b2

    _, h = lax.associative_scan(combine, (a, u), axis=1)
    return h.astype(x.dtype)


def forgetting_attention(q, k, v, f_logit, b_f, q_gain, k_gain):
    B, S, _ = q.shape
    q = rms_norm(q.reshape(B, S, FOX_HEADS, HEAD_DIM), q_gain).transpose(0, 2, 1, 3)
    k = rms_norm(k.reshape(B, S, FOX_HEADS, HEAD_DIM), k_gain).transpose(0, 2, 1, 3)
    v = v.reshape(B, S, FOX_HEADS, HEAD_DIM).transpose(0, 2, 1, 3)
    log_f = jax.nn.log_sigmoid((f_logit + b_f).astype(jnp.float32))
    cum = jnp.cumsum(log_f, axis=1).transpose(0, 2, 1)
    scale = HEAD_DIM ** -0.5
    k_pos = jnp.arange(S)

    def one_block(start):
        qb = lax.dynamic_slice_in_dim(q, start, Q_BLOCK, axis=2)
        cb = lax.dynamic_slice_in_dim(cum, start, Q_BLOCK, axis=2)
        s = (jnp.einsum('bhqd,bhkd->bhqk', qb, k).astype(jnp.float32) * scale
             + cb[..., :, None] - cum[..., None, :])
        q_pos = start + jnp.arange(Q_BLOCK)
        s = jnp.where(k_pos[None, :] <= q_pos[:, None], s, -jnp.inf)
        p = jax.nn.softmax(s, axis=-1)
        return jnp.einsum('bhqk,bhkd->bhqd', p.astype(v.dtype), v)

    starts = jnp.arange(S // Q_BLOCK) * Q_BLOCK
    o = lax.map(one_block, starts)
    return o.transpose(1, 0, 3, 2, 4).reshape(B, S, FOX_WIDTH)


def gated_linear_attention(q, k, v, low, g, w_alpha, b_alpha, out_gain):
    B, S, _ = q.shape
    nc = S // GLA_CHUNK

    def to_chunks(t, d):
        return t.reshape(B, nc, GLA_CHUNK, GLA_HEADS, d).transpose(0, 3, 1, 2, 4).astype(jnp.float32)

    log_alpha = jax.nn.log_sigmoid((low @ w_alpha + b_alpha).astype(jnp.float32)) / GLA_TAU
    qh = to_chunks(q, GLA_DK) * (GLA_DK ** -0.5)
    kh = to_chunks(k, GLA_DK)
    vh = to_chunks(v, GLA_DV)
    la = to_chunks(log_alpha, GLA_DK)
    bcum = jnp.cumsum(la, axis=3)
    b_last = bcum[..., -1:, :]
    q_dec = qh * jnp.exp(bcum)
    k_dec = kh * jnp.exp(-bcum)
    k_to_end = kh * jnp.exp(b_last - bcum)
    att = jnp.einsum('bhnid,bhnjd->bhnij', q_dec, k_dec)
    att = jnp.where(jnp.tril(jnp.ones((GLA_CHUNK, GLA_CHUNK), dtype=bool)), att, 0.0)
    o_intra = jnp.einsum('bhnij,bhnjv->bhniv', att, vh)
    kv = jnp.einsum('bhnjd,bhnjv->bhndv', k_to_end, vh)
    decay = jnp.exp(b_last[..., 0, :])

    def step(state, inp):
        dec, kv_n = inp
        return dec[..., None] * state + kv_n, state

    init = jnp.zeros((B, GLA_HEADS, GLA_DK, GLA_DV), jnp.float32)
    _, s_prev = lax.scan(step, init, (decay.transpose(2, 0, 1, 3), kv.transpose(2, 0, 1, 3, 4)))
    s_prev = s_prev.transpose(1, 2, 0, 3, 4)
    o_inter = jnp.einsum('bhnid,bhndv->bhniv', q_dec, s_prev)
    o = (o_intra + o_inter).transpose(0, 2, 3, 1, 4).reshape(B, S, GLA_HEADS, GLA_DV)
    o = rms_norm(o, out_gain).reshape(B, S, GLA_VW)
    return (o * jax.nn.silu(g.astype(jnp.float32))).astype(q.dtype)


def hybrid_layer(x, c_act, norm1_gain, norm2_gain, w_mod, b_mod, w_in, conv_w, conv_b,
                 lru_w_r, lru_b_r, lru_w_i, lru_b_i, lru_lambda, fox_b_f, fox_q_gain,
                 fox_k_gain, gla_w_alpha, gla_b_alpha, gla_out_gain, w_out,
                 ffn_w_gate_up, ffn_w_down):
    mod = (c_act @ w_mod + b_mod)[:, None, :]
    shift1, scale1, gate1, shift2, scale2, gate2 = jnp.split(mod, N_MOD, axis=-1)

    h = rms_norm(x, norm1_gain) * (1.0 + scale1) + shift1
    proj = h @ w_in
    (xa, ya, fq, fk, fv, ff, gq, gk, gv, glow, gg) = jnp.split(
        proj, np.cumsum(SPLIT_SIZES)[:-1].tolist(), axis=-1)
    xa = causal_depthwise_conv(xa, conv_w, conv_b)
    out_a = rg_lru(xa, lru_w_r, lru_b_r, lru_w_i, lru_b_i, lru_lambda) * jax.nn.gelu(ya)
    out_b = forgetting_attention(fq, fk, fv, ff, fox_b_f, fox_q_gain, fox_k_gain)
    out_c = gated_linear_attention(gq, gk, gv, glow, gg, gla_w_alpha, gla_b_alpha, gla_out_gain)
    mix = jnp.concatenate([out_a, out_b, out_c], axis=-1) @ w_out
    x = x + gate1 * mix

    h = rms_norm(x, norm2_gain) * (1.0 + scale2) + shift2
    gt, up = jnp.split(h @ ffn_w_gate_up, 2, axis=-1)
    x = x + gate2 * ((jax.nn.silu(gt) * up) @ ffn_w_down)
    return x


def setup_inputs(seed: int = 0) -> dict:
    key = jax.random.key(seed)
    ks = jax.random.split(key, 24)
    f32 = jnp.float32
    L = DEPTH

    def nrm(k, shape, fan_in, mult=1.0):
        return (jax.random.normal(k, shape, f32) * (mult * fan_in ** -0.5)).astype(f32)

    def gain(k, shape):
        return 1.0 + 0.02 * jax.random.normal(k, shape, f32)

    def small(k, shape):
        return 0.01 * jax.random.normal(k, shape, f32)

    a0 = jax.random.uniform(ks[12], (L, LRU_WIDTH), f32, minval=0.9, maxval=0.999)
    return {
        'x': jax.random.normal(ks[0], (BATCH, SEQ, D_MODEL), f32),
        'c': jax.random.normal(ks[1], (BATCH, D_MODEL), f32),
        'norm1_gain': gain(ks[2], (L, D_MODEL)),
        'norm2_gain': gain(ks[3], (L, D_MODEL)),
        'w_mod': nrm(ks[4], (L, D_MODEL, N_MOD * D_MODEL), D_MODEL, 0.5),
        'b_mod': small(ks[5], (L, N_MOD * D_MODEL)),
        'w_in': nrm(ks[6], (L, D_MODEL, D_IN), D_MODEL),
        'conv_w': nrm(ks[7], (L, CONV_WIDTH, LRU_WIDTH), CONV_WIDTH),
        'conv_b': small(ks[8], (L, LRU_WIDTH)),
        'lru_w_r': nrm(ks[9], (L, LRU_BLOCKS, LRU_BLOCK, LRU_BLOCK), LRU_BLOCK),
        'lru_b_r': small(ks[10], (L, LRU_WIDTH)),
        'lru_w_i': nrm(ks[11], (L, LRU_BLOCKS, LRU_BLOCK, LRU_BLOCK), LRU_BLOCK),
        'lru_b_i': small(ks[13], (L, LRU_WIDTH)),
        'lru_lambda': jnp.log(a0) - jnp.log1p(-a0),
        'fox_b_f': jax.random.uniform(ks[14], (L, FOX_HEADS), f32, minval=1.0, maxval=4.0),
        'fox_q_gain': gain(ks[15], (L, HEAD_DIM)),
        'fox_k_gain': gain(ks[16], (L, HEAD_DIM)),
        'gla_w_alpha': nrm(ks[17], (L, GLA_RANK, GLA_KW), GLA_RANK),
        'gla_b_alpha': small(ks[18], (L, GLA_KW)),
        'gla_out_gain': gain(ks[19], (L, GLA_DV)),
        'w_out': nrm(ks[20], (L, D_MIX, D_MODEL), D_MIX),
        'ffn_w_gate_up': nrm(ks[21], (L, D_MODEL, 2 * D_FF), D_MODEL),
        'ffn_w_down': nrm(ks[22], (L, D_FF, D_MODEL), D_FF),
    }


def reference(x, c, norm1_gain, norm2_gain, w_mod, b_mod, w_in, conv_w, conv_b,
              lru_w_r, lru_b_r, lru_w_i, lru_b_i, lru_lambda, fox_b_f, fox_q_gain,
              fox_k_gain, gla_w_alpha, gla_b_alpha, gla_out_gain, w_out,
              ffn_w_gate_up, ffn_w_down):
    c_act = jax.nn.silu(c)
    for l in range(DEPTH):
        x = hybrid_layer(x, c_act, norm1_gain[l], norm2_gain[l], w_mod[l], b_mod[l], w_in[l],
                         conv_w[l], conv_b[l], lru_w_r[l], lru_b_r[l], lru_w_i[l], lru_b_i[l],
                         lru_lambda[l], fox_b_f[l], fox_q_gain[l], fox_k_gain[l],
                         gla_w_alpha[l], gla_b_alpha[l], gla_out_gain[l], w_out[l],
                         ffn_w_gate_up[l], ffn_w_down[l])
    return x
```

```cpp
#include <hip/hip_runtime.h>
#include <hip/hip_cooperative_groups.h>
#include <hip/hip_bf16.h>
#include <cstdio>
#include <cstdint>
#include <cmath>
namespace cg = cooperative_groups;
namespace pg8 {
#define PG8_LAS __attribute__((address_space(3)))
typedef unsigned short bf16_t;
typedef short bf16x8 __attribute__((ext_vector_type(8)));
typedef float f32x4 __attribute__((ext_vector_type(4)));
typedef unsigned u32x4 __attribute__((ext_vector_type(4)));
constexpr int BM = 256, BK = 64, HALF = 128, HTB = HALF * BK * 2  , STAGE_BYTES = 8 * HTB, NXCD = 8, WGM = 8;

__host__ __device__ __forceinline__ int lds_byte(int r, int c) { const int st = (r >> 4) * 2 + (c >> 5), rr = r & 15, cc = c & 31, ob = rr * 64 + cc * 2; return st * 1024 + (ob ^ (((ob >> 9) & 1) << 5)); }
__host__ __device__ __forceinline__ void stage_rc(int b, int& R, int& C) { const int st = b / 1024, sb = b % 1024, swz = sb ^ (((sb >> 9) & 1) << 5); R = (st >> 1) * 16 + swz / 64; C = (st & 1) * 32 + (swz % 64) / 2; }
__host__ __device__ __forceinline__ int perm32(int rho) { const int n = rho >> 4, i = rho & 15; return 8 * (i >> 2) + 4 * n + (i & 3); }

struct Unit { int pm, pn; };
struct Gemm { const bf16_t* A; const bf16_t* Bt; int M, N, K; };

struct StaticOrder {
    int nM, nN, nwg, G, c;
    __host__ __device__ void init(int M, int N, int G_, int c_) { nM = M / BM; nN = N / BM; nwg = nM * nN; G = G_; c = c_; }
    __host__ __device__ bool next(int i, Unit& u) const {
        const long L = (long)i * G + c; if (L >= nwg) return false;
        int wgid = (int)L; { const int q = nwg / NXCD, r = nwg % NXCD, xcd = wgid % NXCD, off = wgid / NXCD; wgid = (xcd < r ? xcd * (q + 1) : r * (q + 1) + (xcd - r) * q) + off; }
        const int nig = WGM * nN, gid = wgid / nig, fm = gid * WGM, gsz = (nM - fm) < WGM ? (nM - fm) : WGM;
        u.pm = fm + ((wgid % nig) % gsz); u.pn = (wgid % nig) / gsz; return true;
    }
    __device__ __forceinline__ void a_ready(const Unit&) const {}
    __device__ __forceinline__ void done(const Unit&) const {}
};

__device__ __forceinline__ unsigned cvt_pk_bf16(float lo, float hi) { unsigned r; asm volatile("v_cvt_pk_bf16_f32 %0, %1, %2" : "=v"(r) : "v"(lo), "v"(hi)); return r; }
typedef float f32x2 __attribute__((ext_vector_type(2)));
__device__ __forceinline__ f32x2 gelu_pk(f32x2 v) {
    const f32x2 av = __builtin_elementwise_abs(v), d = av * 0.2316418882f + 1.0f;
    f32x2 t; t.x = __builtin_amdgcn_rcpf(d.x); t.y = __builtin_amdgcn_rcpf(d.y);
    f32x2 q = t * 0.5307027145f + (-0.7265760135f); q = q * t + 0.7107068705f; q = q * t + (-0.142248368f); q = q * t + 0.127414796f; q = q * t;
    const f32x2 s = (v * v) * (-0.72134752044f);
    f32x2 e; e.x = __builtin_amdgcn_exp2f(s.x); e.y = __builtin_amdgcn_exp2f(s.y);
    const f32x2 m = v * (q * e), r = v - m;
    f32x2 o; o.x = v.x < 0.f ? m.x : r.x; o.y = v.y < 0.f ? m.y : r.y; return o;
}

template <int ACT  > struct EpiBf16 {
    static constexpr bool PERM = true, AFTER_DRAIN = false; static_assert(ACT == 0 || ACT == 1, "EpiBf16: ACT is 0 (none) or 1 (gelu_pk)");
    bf16_t* O; int ldc; const float* bias; int split_cols; size_t split_stride; float scale0;
    __device__ __forceinline__ void operator()(const f32x4 (&acc)[2][2][4][2], const Unit& u, int wr, int wc, int fr, int fq) const {
        const int row0 = u.pm * BM + wr * 64 + fr; int colt = u.pn * BM; bf16_t* base = O;
        float sc = 1.f; if (split_cols) { const int t = colt / split_cols; base += (size_t)t * split_stride; colt -= t * split_cols; if (t == 0) sc = scale0; }
        const int col0 = colt + wc * 32 + 8 * fq, bcol0 = u.pn * BM + wc * 32 + 8 * fq;
        f32x4 bv[2][2];
#pragma unroll
        for (int bj = 0; bj < 2; ++bj)
#pragma unroll
            for (int n = 0; n < 2; ++n) bv[bj][n] = bias ? *(const f32x4*)(bias + bcol0 + bj * HALF + 4 * n) : (f32x4){0.f, 0.f, 0.f, 0.f};
#pragma unroll
        for (int ai = 0; ai < 2; ++ai)
#pragma unroll
            for (int m = 0; m < 4; ++m) { bf16_t* rowp = base + (size_t)(row0 + ai * HALF + m * 16) * ldc + col0;
#pragma unroll
                for (int bj = 0; bj < 2; ++bj) { f32x4 v0 = acc[ai][bj][m][0] + bv[bj][0], v1 = acc[ai][bj][m][1] + bv[bj][1];
                    if (ACT == 1) { f32x2 a = gelu_pk((f32x2){v0[0], v0[1]}), b = gelu_pk((f32x2){v0[2], v0[3]}), c = gelu_pk((f32x2){v1[0], v1[1]}), d = gelu_pk((f32x2){v1[2], v1[3]});
                        v0 = (f32x4){a.x, a.y, b.x, b.y}; v1 = (f32x4){c.x, c.y, d.x, d.y}; }
                    v0 = v0 * sc; v1 = v1 * sc; u32x4 w; w.x = cvt_pk_bf16(v0[0], v0[1]); w.y = cvt_pk_bf16(v0[2], v0[3]); w.z = cvt_pk_bf16(v1[0], v1[1]); w.w = cvt_pk_bf16(v1[2], v1[3]);
                    *(u32x4*)(rowp + bj * HALF) = w; } }
    }
};


struct EpiProj {
    static constexpr bool PERM = true, AFTER_DRAIN = false;
    bf16_t* O; int ldc; const float* qgain; const float* kgain; int cfq;
    __device__ __forceinline__ void operator()(const f32x4 (&acc)[2][2][4][2], const Unit& u, int wr, int wc, int fr, int fq) const {
        const int row0 = u.pm * BM + wr * 64 + fr;
        if (u.pn < 3 || u.pn > 5) {
            const int col0 = u.pn * BM + wc * 32 + 8 * fq;
#pragma unroll
            for (int ai = 0; ai < 2; ++ai)
#pragma unroll
                for (int m = 0; m < 4; ++m) { bf16_t* rowp = O + (size_t)(row0 + ai * HALF + m * 16) * ldc + col0;
#pragma unroll
                    for (int bj = 0; bj < 2; ++bj) { const f32x4 v0 = acc[ai][bj][m][0], v1 = acc[ai][bj][m][1];
                        u32x4 w; w.x = cvt_pk_bf16(v0[0], v0[1]); w.y = cvt_pk_bf16(v0[2], v0[3]); w.z = cvt_pk_bf16(v1[0], v1[1]); w.w = cvt_pk_bf16(v1[2], v1[3]);
                        *(u32x4*)(rowp + bj * HALF) = w; } }
        } else {
            const int H = 4 * (u.pn - 3) + wc;
            const float* gp = (H < 6 ? qgain : kgain) + 8 * fq; const float sc = H < 6 ? 0.125f * 1.4426950408889634f : 1.0f;
            f32x4 gv[2][2];
#pragma unroll
            for (int bj = 0; bj < 2; ++bj)
#pragma unroll
                for (int n = 0; n < 2; ++n) gv[bj][n] = *(const f32x4*)(gp + 32 * bj + 4 * n) * sc;
            const int col0 = cfq + H * 64 + 8 * fq;
#pragma unroll
            for (int ai = 0; ai < 2; ++ai)
#pragma unroll
                for (int m = 0; m < 4; ++m) { bf16_t* rowp = O + (size_t)(row0 + ai * HALF + m * 16) * ldc + col0;
                    float ss = 0.f;
#pragma unroll
                    for (int bj = 0; bj < 2; ++bj)
#pragma unroll
                        for (int n = 0; n < 2; ++n) { const f32x4 x = acc[ai][bj][m][n]; ss += (x[0] * x[0] + x[1] * x[1]) + (x[2] * x[2] + x[3] * x[3]); }
                    ss += __shfl_xor(ss, 16); ss += __shfl_xor(ss, 32);
                    const float rs = __builtin_amdgcn_rsqf(ss * (1.0f / 64.0f) + 1e-6f);
#pragma unroll
                    for (int bj = 0; bj < 2; ++bj) { const f32x4 v0 = acc[ai][bj][m][0] * rs * gv[bj][0], v1 = acc[ai][bj][m][1] * rs * gv[bj][1];
                        u32x4 w; w.x = cvt_pk_bf16(v0[0], v0[1]); w.y = cvt_pk_bf16(v0[2], v0[3]); w.z = cvt_pk_bf16(v1[0], v1[1]); w.w = cvt_pk_bf16(v1[2], v1[3]);
                        *(u32x4*)(rowp + 32 * bj) = w; } }
        }
    }
};
struct EpiSwiGLU {
    static constexpr bool PERM = true, AFTER_DRAIN = false;
    bf16_t* O; int ldc;
    __device__ __forceinline__ void operator()(const f32x4 (&acc)[2][2][4][2], const Unit& u, int wr, int wc, int fr, int fq) const {
        const int row0 = u.pm * BM + wr * 64 + fr; const int col0 = u.pn * HALF + wc * 32 + 8 * fq;
#pragma unroll
        for (int ai = 0; ai < 2; ++ai)
#pragma unroll
            for (int m = 0; m < 4; ++m) { bf16_t* rowp = O + (size_t)(row0 + ai * HALF + m * 16) * ldc + col0;
                float o[8];
#pragma unroll
                for (int n = 0; n < 2; ++n)
#pragma unroll
                    for (int j = 0; j < 4; ++j) { const float g = acc[ai][0][m][n][j], up = acc[ai][1][m][n][j];
                        const float sg = g * __builtin_amdgcn_rcpf(1.0f + __builtin_amdgcn_exp2f(-1.4426950408889634f * g)); o[n * 4 + j] = sg * up; }
                u32x4 w; w.x = cvt_pk_bf16(o[0], o[1]); w.y = cvt_pk_bf16(o[2], o[3]); w.z = cvt_pk_bf16(o[4], o[5]); w.w = cvt_pk_bf16(o[6], o[7]);
                *(u32x4*)rowp = w; }
    }
};
struct EpiResid {
    static constexpr bool PERM = false, AFTER_DRAIN = false;
    const float* base; float* out; int ldc; const float* gate; int gstride; int rows_per_batch;
    __device__ __forceinline__ void operator()(const f32x4 (&acc)[2][2][4][2], const Unit& u, int wr, int wc, int fr, int fq) const {
        const int col0 = u.pn * BM + wc * 32 + 4 * fq;
        const float* gp = gate + (size_t)((u.pm * BM) / rows_per_batch) * gstride + col0;
        f32x4 gv[2][2];
#pragma unroll
        for (int bj = 0; bj < 2; ++bj)
#pragma unroll
            for (int n = 0; n < 2; ++n) gv[bj][n] = *(const f32x4*)(gp + bj * HALF + n * 16);
#pragma unroll
        for (int ai = 0; ai < 2; ++ai)
#pragma unroll
            for (int m = 0; m < 4; ++m) { const size_t off = (size_t)(u.pm * BM + ai * HALF + wr * 64 + m * 16 + fr) * ldc + col0;
#pragma unroll
                for (int bj = 0; bj < 2; ++bj)
#pragma unroll
                    for (int n = 0; n < 2; ++n) { const f32x4 bs = *(const f32x4*)(base + off + bj * HALF + n * 16);
                        *(f32x4*)(out + off + bj * HALF + n * 16) = bs + gv[bj][n] * acc[ai][bj][m][n]; } }
    }
};


typedef _Float16 h16x2 __attribute__((ext_vector_type(2)));
__device__ __forceinline__ f32x2 h2f(unsigned w) { return __builtin_convertvector(__builtin_bit_cast(h16x2, w), f32x2); }
__device__ __forceinline__ unsigned f2h(float lo, float hi) { f32x2 v = {lo, hi}; return __builtin_bit_cast(unsigned, __builtin_convertvector(v, h16x2)); }
struct EpiResidB {
    static constexpr bool PERM = true, AFTER_DRAIN = false;
    const float* base32; const bf16_t* base16; bf16_t* out16; float* out32; int ldc; const float* gate; int gstride; int rows_per_batch;
    __device__ __forceinline__ void operator()(const f32x4 (&acc)[2][2][4][2], const Unit& u, int wr, int wc, int fr, int fq) const {
        const int row0 = u.pm * BM + wr * 64 + fr; const int col0 = u.pn * BM + wc * 32 + 8 * fq;
        const float* gp = gate + (size_t)((u.pm * BM) / rows_per_batch) * gstride + col0;
        f32x4 gv[2][2];
#pragma unroll
        for (int bj = 0; bj < 2; ++bj)
#pragma unroll
            for (int n = 0; n < 2; ++n) gv[bj][n] = *(const f32x4*)(gp + bj * HALF + 4 * n);
#pragma unroll
        for (int ai = 0; ai < 2; ++ai)
#pragma unroll
            for (int m = 0; m < 4; ++m) { const size_t off = (size_t)(row0 + ai * HALF + m * 16) * ldc + col0;
#pragma unroll
                for (int bj = 0; bj < 2; ++bj) {
                    f32x4 b0, b1;
                    if (base32) { b0 = *(const f32x4*)(base32 + off + bj * HALF); b1 = *(const f32x4*)(base32 + off + bj * HALF + 4); }
                    else { const u32x4 w = *(const u32x4*)(base16 + off + bj * HALF);
                        const f32x2 p0 = h2f(w.x), p1 = h2f(w.y), p2 = h2f(w.z), p3 = h2f(w.w);
                        b0 = (f32x4){p0.x, p0.y, p1.x, p1.y}; b1 = (f32x4){p2.x, p2.y, p3.x, p3.y}; }
                    const f32x4 v0 = b0 + gv[bj][0] * acc[ai][bj][m][0], v1 = b1 + gv[bj][1] * acc[ai][bj][m][1];
                    if (out32) { *(f32x4*)(out32 + off + bj * HALF) = v0; *(f32x4*)(out32 + off + bj * HALF + 4) = v1; }
                    else { u32x4 w; w.x = f2h(v0[0], v0[1]); w.y = f2h(v0[2], v0[3]); w.z = f2h(v1[0], v1[1]); w.w = f2h(v1[2], v1[3]); *(u32x4*)(out16 + off + bj * HALF) = w; } } }
    }
};

template <class Epi, class Sched, bool ALIGN_EPI = false, bool SP2 = false>
__device__ __forceinline__ void gemm_phase(PG8_LAS unsigned char* lds, const Gemm g, const Sched& S, const Epi& E) {
    int tid = threadIdx.x; asm volatile("" : "+v"(tid)); const int wid = __builtin_amdgcn_readfirstlane(tid >> 6), lane = tid & 63, wr = wid >> 2, wc = wid & 3, fr = lane & 15, fq = lane >> 4;
    const int K = g.K, nt = K / BK;
    unsigned voffA[2], voffB[2];
#pragma unroll
    for (int i = 0; i < 2; ++i) { int R, C; stage_rc(tid * 16 + i * 8192, R, C); const int Rb = Epi::PERM ? ((R & ~31) + perm32(R & 31)) : R;
        voffA[i] = (unsigned)(R * K + C) * 2u; voffB[i] = (unsigned)(Rb * K + C) * 2u; }
    const size_t kstep = (size_t)(BK * 2);
    const size_t hstep = (size_t)HALF * K * 2;
    const size_t tstep = 2 * hstep;
    const unsigned ldsw = (unsigned)wid * 1024u;
    const int aoff = lds_byte(wr * 64 + fr, fq * 8), boff = lds_byte(wc * 32 + fr, fq * 8);
#define PG8_SA(b, h) (((b) * 2 + (h)) * HTB)
#define PG8_SB(b, h) ((4 + (b) * 2 + (h)) * HTB)
#define PG8_STAGE(bufoff, gbase, voff) do { _Pragma("unroll") for (int _i = 0; _i < 2; ++_i) \
        __builtin_amdgcn_global_load_lds((const unsigned*)((const char*)(gbase) + (voff)[_i]), (PG8_LAS unsigned*)(lds + (bufoff) + ldsw + _i * 8192), 16, 0, 0); } while (0)
#define PG8_LDA(dst, b, h) do { _Pragma("unroll") for (int m = 0; m < 4; ++m) _Pragma("unroll") for (int k = 0; k < 2; ++k) dst[m][k] = *(const PG8_LAS bf16x8*)(lds + PG8_SA(b, h) + aoff + m * 2048 + k * 1024); } while (0)
#define PG8_LDB(dst, b, h) do { _Pragma("unroll") for (int n = 0; n < 2; ++n) _Pragma("unroll") for (int k = 0; k < 2; ++k) dst[n][k] = *(const PG8_LAS bf16x8*)(lds + PG8_SB(b, h) + boff + n * 2048 + k * 1024); } while (0)
#define PG8_MMA(ai, bj, At, Bt) do { __builtin_amdgcn_s_setprio(1); _Pragma("unroll") for (int m = 0; m < 4; ++m) _Pragma("unroll") for (int n = 0; n < 2; ++n) _Pragma("unroll") for (int k = 0; k < 2; ++k) \
        acc[ai][bj][m][n] = __builtin_amdgcn_mfma_f32_16x16x32_bf16(Bt[n][k], At[m][k], acc[ai][bj][m][n], 0, 0, 0); __builtin_amdgcn_s_setprio(0); } while (0)
#define PG8_WAIT_V(n) asm volatile("s_waitcnt vmcnt(" #n ")" ::: "memory")
#define PG8_WAIT_L(n) asm volatile("s_waitcnt lgkmcnt(" #n ")" ::: "memory")
#define PG8_BAR __builtin_amdgcn_s_barrier()
#define PG8_SCHED __builtin_amdgcn_sched_barrier(0)
    Unit cur, nxt; int ui = 0;
    if (!S.next(0, cur)) return;
    f32x4 acc[2][2][4][2];
#pragma unroll
    for (int a = 0; a < 2; ++a)
#pragma unroll
        for (int b = 0; b < 2; ++b)
#pragma unroll
            for (int m = 0; m < 4; ++m)
#pragma unroll
                for (int n = 0; n < 2; ++n) acc[a][b][m][n] = (f32x4){0.f, 0.f, 0.f, 0.f};
    bf16x8 At[4][2], B0[2][2], B1[2][2];
    const char* cA = (const char*)g.A + (size_t)cur.pm * tstep; const char* cB = (const char*)g.Bt + (size_t)cur.pn * tstep;
    S.a_ready(cur);
    if constexpr (SP2) {
        PG8_STAGE(PG8_SB(0, 0), cB, voffB); PG8_STAGE(PG8_SB(0, 1), cB + hstep, voffB); PG8_STAGE(PG8_SA(0, 0), cA, voffA); PG8_STAGE(PG8_SA(0, 1), cA + hstep, voffA);
        if (wr == 1) PG8_BAR;
        PG8_WAIT_V(2); PG8_BAR;
        PG8_STAGE(PG8_SB(1, 0), cB + kstep, voffB); PG8_STAGE(PG8_SA(1, 0), cA + kstep, voffA); PG8_STAGE(PG8_SB(1, 1), cB + hstep + kstep, voffB);
        PG8_WAIT_V(6); PG8_BAR;
    } else {
        PG8_STAGE(PG8_SB(0, 0), cB, voffB); PG8_STAGE(PG8_SA(0, 0), cA, voffA); PG8_STAGE(PG8_SB(0, 1), cB + hstep, voffB); PG8_STAGE(PG8_SA(0, 1), cA + hstep, voffA);
        if (wr == 1) PG8_BAR;
        PG8_WAIT_V(4); PG8_BAR;
        PG8_STAGE(PG8_SB(1, 0), cB + kstep, voffB); PG8_STAGE(PG8_SA(1, 0), cA + kstep, voffA); PG8_STAGE(PG8_SB(1, 1), cB + hstep + kstep, voffB);
        PG8_WAIT_V(6); PG8_BAR;
    }
    for (;;) {
        const bool has_next = S.next(ui + 1, nxt);
        const char* nA = has_next ? (const char*)g.A + (size_t)nxt.pm * tstep : cA; const char* nB = has_next ? (const char*)g.Bt + (size_t)nxt.pn * tstep : cB;
        for (int t = 0; t < nt; t += 2) {
            const bool last = (t == nt - 2);
            const char* a1 = cA + (size_t)(t + 1) * kstep;
            const char* a2 = last ? nA : cA + (size_t)(t + 2) * kstep; const char* b2 = last ? nB : cB + (size_t)(t + 2) * kstep;
            const char* a3 = a2 + kstep; const char* b3 = b2 + kstep;
            if (last && has_next) S.a_ready(nxt);
            if constexpr (SP2) {
            PG8_LDB(B0, 0, 0); PG8_LDB(B1, 0, 1); PG8_SCHED; PG8_LDA(At, 0, 0); PG8_STAGE(PG8_SA(1, 1), a1 + hstep, voffA);
            PG8_WAIT_V(8); PG8_WAIT_L(0); PG8_BAR; PG8_MMA(0, 0, At, B0); PG8_MMA(0, 1, At, B1); PG8_BAR; PG8_SCHED;
            PG8_LDA(At, 0, 1); PG8_STAGE(PG8_SB(0, 0), b2, voffB); PG8_STAGE(PG8_SB(0, 1), b2 + hstep, voffB); PG8_STAGE(PG8_SA(0, 0), a2, voffA);
            PG8_WAIT_V(8); PG8_WAIT_L(0); PG8_BAR; PG8_MMA(1, 0, At, B0); PG8_MMA(1, 1, At, B1); PG8_BAR; PG8_SCHED;
            PG8_LDB(B0, 1, 0); PG8_LDB(B1, 1, 1); PG8_SCHED; PG8_LDA(At, 1, 0); PG8_STAGE(PG8_SA(0, 1), a2 + hstep, voffA);
            PG8_WAIT_V(8); PG8_WAIT_L(0); PG8_BAR; PG8_MMA(0, 0, At, B0); PG8_MMA(0, 1, At, B1); PG8_BAR; PG8_SCHED;
            PG8_LDA(At, 1, 1); PG8_STAGE(PG8_SB(1, 0), b3, voffB); PG8_STAGE(PG8_SB(1, 1), b3 + hstep, voffB); PG8_STAGE(PG8_SA(1, 0), a3, voffA);
            PG8_WAIT_V(8); PG8_WAIT_L(0); PG8_BAR; PG8_MMA(1, 0, At, B0); PG8_MMA(1, 1, At, B1); PG8_BAR; PG8_SCHED;
            } else {
            PG8_LDB(B0, 0, 0); PG8_SCHED; PG8_LDA(At, 0, 0); PG8_STAGE(PG8_SA(1, 1), a1 + hstep, voffA);
            PG8_WAIT_L(8); PG8_BAR; PG8_WAIT_L(0); PG8_MMA(0, 0, At, B0); PG8_BAR; PG8_SCHED;
            PG8_LDB(B1, 0, 1); PG8_STAGE(PG8_SB(0, 0), b2, voffB);
            PG8_BAR; PG8_WAIT_L(0); PG8_MMA(0, 1, At, B1); PG8_BAR;
            PG8_LDA(At, 0, 1); PG8_STAGE(PG8_SA(0, 0), a2, voffA);
            PG8_BAR; PG8_WAIT_L(0); PG8_MMA(1, 0, At, B0); PG8_BAR; PG8_SCHED;
            PG8_STAGE(PG8_SB(0, 1), b2 + hstep, voffB);
            PG8_WAIT_V(6); PG8_BAR; PG8_MMA(1, 1, At, B1); PG8_BAR;
            PG8_LDB(B0, 1, 0); PG8_SCHED; PG8_LDA(At, 1, 0); PG8_STAGE(PG8_SA(0, 1), a2 + hstep, voffA);
            PG8_WAIT_L(8); PG8_BAR; PG8_WAIT_L(0); PG8_MMA(0, 0, At, B0); PG8_BAR; PG8_SCHED;
            PG8_LDB(B1, 1, 1); PG8_STAGE(PG8_SB(1, 0), b3, voffB);
            PG8_BAR; PG8_WAIT_L(0); PG8_MMA(0, 1, At, B1); PG8_BAR;
            PG8_LDA(At, 1, 1); PG8_STAGE(PG8_SA(1, 0), a3, voffA);
            PG8_BAR; PG8_WAIT_L(0); PG8_MMA(1, 0, At, B0); PG8_BAR; PG8_SCHED;
            PG8_STAGE(PG8_SB(1, 1), b3 + hstep, voffB);
            PG8_WAIT_V(6); PG8_BAR; PG8_MMA(1, 1, At, B1); PG8_BAR;
            }
        }
        if constexpr (ALIGN_EPI) { if (wr == 0) PG8_BAR; }
        if constexpr (!Epi::AFTER_DRAIN) { E(acc, cur, wr, wc, fr, fq); S.done(cur); }
        if (!has_next) break;
#pragma unroll
        for (int a = 0; a < 2; ++a)
#pragma unroll
            for (int b = 0; b < 2; ++b)
#pragma unroll
                for (int m = 0; m < 4; ++m)
#pragma unroll
                    for (int n = 0; n < 2; ++n) acc[a][b][m][n] = (f32x4){0.f, 0.f, 0.f, 0.f};
        cur = nxt; cA = nA; cB = nB; ++ui;
        if constexpr (ALIGN_EPI) { if (wr == 1) PG8_BAR; }
    }
    PG8_WAIT_V(0);
    if constexpr (!ALIGN_EPI) { if (wr == 0) PG8_BAR; }
    PG8_BAR;
    if constexpr (Epi::AFTER_DRAIN) { E.fused(acc, cur, wr, wc, fr, fq, lds, wid, lane); S.done(cur); }
#undef PG8_SA
#undef PG8_SB
#undef PG8_STAGE
#undef PG8_LDA
#undef PG8_LDB
#undef PG8_MMA
#undef PG8_WAIT_V
#undef PG8_WAIT_L
#undef PG8_BAR
#undef PG8_SCHED
}
}

#ifndef PG8_SP2
#define PG8_SP2 true
#endif
#ifndef PG8_ALIGN
#define PG8_ALIGN true
#endif
#include <hip/hip_bf16.h>
#include <cmath>
namespace attn_body {
using bf16=__hip_bfloat16;
using bf16x8=__attribute__((ext_vector_type(8)))short;
using s16x4=__attribute__((ext_vector_type(4)))short;
using f32x16=__attribute__((ext_vector_type(16)))float;
using u32x4=__attribute__((ext_vector_type(4)))unsigned;
constexpr int BATCH=4,NHEAD=6,SEQ=8192,D=64,DM=3072,ODM=1024;
constexpr int NW=8,QBLK=32,QB=QBLK*NW,KVBLK=64,NQB=SEQ/QB;
constexpr int ATTN_PITCH=DM, ATTN_UNIT_ROWS=QB;
__device__ __forceinline__ int crow(int r,int hi){return (r&3)+8*(r>>2)+4*hi;}
#define SBAR() __builtin_amdgcn_sched_barrier(0)
__device__ __forceinline__ void cmask(f32x16&p0,f32x16&p1,int jb,int qrel,int hi){
  const float NEG=-INFINITY; int kb=64*jb+4*hi;
  #pragma unroll
  for(int r=0;r<16;++r){int kv=kb+(r&3)+8*(r>>2); if(kv>qrel)p0[r]=NEG; if(kv+32>qrel)p1[r]=NEG;}
}

constexpr int NSLOT=3, SLOTB=8192;
constexpr int LDS_K=0, LDS_V=NSLOT*SLOTB, LDS_WS=2*NSLOT*SLOTB, LDS_OST=LDS_WS+NW*64*4, LDS_CKS=LDS_OST+NW*4096, LDS_BYTES=LDS_CKS+SEQ*4;
constexpr float C2=0.125f*1.4426950408889634f;
__device__ __forceinline__ void glds16(const void*gsrc,unsigned lds_dst){unsigned keep;
  asm volatile("s_mov_b32 %0, m0\n\ts_mov_b32 m0, %2\n\ts_nop 0\n\tglobal_load_lds_dwordx4 %1, off\n\ts_mov_b32 m0, %0":"=&s"(keep):"v"(gsrc),"s"(lds_dst):"memory");}
__device__ __forceinline__ float max3f(float a,float b,float c){float r;asm("v_max3_f32 %0, %1, %2, %3":"=v"(r):"v"(a),"v"(b),"v"(c));return r;}
__device__ __forceinline__ float max2f(float a,float b){float r;asm("v_max_f32_e32 %0, %1, %2":"=v"(r):"v"(a),"v"(b));return r;}
__device__ __forceinline__ float fadd_s(float a,float b){float r;asm("v_add_f32_e32 %0, %1, %2":"=v"(r):"v"(a),"v"(b));return r;}
__device__ __forceinline__ float fsub_s(float a,float b){float r;asm("v_sub_f32_e32 %0, %1, %2":"=v"(r):"v"(a),"v"(b));return r;}
typedef float f32x2_t __attribute__((ext_vector_type(2))); typedef __bf16 bf16x2_t __attribute__((ext_vector_type(2)));
__device__ __forceinline__ unsigned cvtpk_s(float lo,float hi){f32x2_t v={lo,hi};bf16x2_t b=__builtin_convertvector(v,bf16x2_t);return __builtin_bit_cast(unsigned,b);}
#define WAIT_BAR(N) asm volatile("s_waitcnt vmcnt(" #N ") lgkmcnt(0)\n\ts_barrier":::"memory")

__device__ __forceinline__ void qkt(f32x16&p0,f32x16&p1,const char*Kslot,const bf16x8*qr,const f32x16&negm,int r32,int hi){
  const char*kb=Kslot+hi*1024+r32*16;
  #pragma unroll
  for(int d0=0;d0<4;++d0){
    const bf16x8 b0=*reinterpret_cast<const bf16x8*>(kb+d0*2048);
    const bf16x8 b1=*reinterpret_cast<const bf16x8*>(kb+d0*2048+512);
    if(d0==0){p0=__builtin_amdgcn_mfma_f32_32x32x16_bf16(b0,qr[0],negm,0,0,0);p1=__builtin_amdgcn_mfma_f32_32x32x16_bf16(b1,qr[0],negm,0,0,0);}
    else{p0=__builtin_amdgcn_mfma_f32_32x32x16_bf16(b0,qr[d0],p0,0,0,0);p1=__builtin_amdgcn_mfma_f32_32x32x16_bf16(b1,qr[d0],p1,0,0,0);}}
}
typedef __attribute__((address_space(3))) const char* lds_cptr;
typedef short v4i16_t __attribute__((ext_vector_type(4)));
__device__ __forceinline__ void kload8(bf16x8*kf,lds_cptr kp){
  kf[0]=*(const __attribute__((address_space(3))) bf16x8*)(kp);      kf[1]=*(const __attribute__((address_space(3))) bf16x8*)(kp+512);
  kf[2]=*(const __attribute__((address_space(3))) bf16x8*)(kp+2048); kf[3]=*(const __attribute__((address_space(3))) bf16x8*)(kp+2560);
  kf[4]=*(const __attribute__((address_space(3))) bf16x8*)(kp+4096); kf[5]=*(const __attribute__((address_space(3))) bf16x8*)(kp+4608);
  kf[6]=*(const __attribute__((address_space(3))) bf16x8*)(kp+6144); kf[7]=*(const __attribute__((address_space(3))) bf16x8*)(kp+6656);
}
__device__ __forceinline__ void kload2(bf16x8*kf,lds_cptr kp,int j){ kf[2*j]=*(const __attribute__((address_space(3))) bf16x8*)(kp+j*2048); kf[2*j+1]=*(const __attribute__((address_space(3))) bf16x8*)(kp+j*2048+512); }
__device__ __forceinline__ s16x4 vtr(lds_cptr p){ return __builtin_bit_cast(s16x4,__builtin_amdgcn_ds_read_tr16_b64_v4i16((__attribute__((address_space(3))) v4i16_t*)p)); }
__device__ __forceinline__ float rowmax(const f32x16&p0,const f32x16&p1){
  float a=max3f(p0[0],p0[1],p1[0]),b=max3f(p0[2],p0[3],p1[1]);a=max3f(a,p1[2],p1[3]);
  #pragma unroll
  for(int r=4;r<16;r+=4){a=max3f(a,p0[r],p0[r+1]);b=max3f(b,p0[r+2],p0[r+3]);a=max3f(a,p1[r],p1[r+1]);b=max3f(b,p1[r+2],p1[r+3]);}
  const float m=max2f(a,b);
  auto rr=__builtin_amdgcn_permlane32_swap(__float_as_uint(m),__float_as_uint(m),false,false);
  return max2f(__uint_as_float(rr[0]),__uint_as_float(rr[1]));
}
__device__ __forceinline__ void pv(f32x16*o,int vb,bf16x8 pa0,bf16x8 pa1,bf16x8 pa2,bf16x8 pa3){
  #pragma unroll
  for(int d0=0;d0<2;++d0){s16x4 lo[4],hi[4];
    #pragma unroll
    for(int ks=0;ks<4;++ks){
      asm volatile("ds_read_b64_tr_b16 %0,%1 offset:%c2":"=&v"(lo[ks]):"v"(vb),"i"(d0*4096+ks*1024):"memory");
      asm volatile("ds_read_b64_tr_b16 %0,%1 offset:%c2":"=&v"(hi[ks]):"v"(vb),"i"(d0*4096+ks*1024+512):"memory");}
    asm volatile("s_waitcnt lgkmcnt(0)":::"memory");SBAR();
    #define PK(k) (bf16x8){lo[k][0],lo[k][1],lo[k][2],lo[k][3],hi[k][0],hi[k][1],hi[k][2],hi[k][3]}
    o[d0]=__builtin_amdgcn_mfma_f32_32x32x16_bf16(pa0,PK(0),o[d0],0,0,0);
    o[d0]=__builtin_amdgcn_mfma_f32_32x32x16_bf16(pa1,PK(1),o[d0],0,0,0);
    o[d0]=__builtin_amdgcn_mfma_f32_32x32x16_bf16(pa2,PK(2),o[d0],0,0,0);
    o[d0]=__builtin_amdgcn_mfma_f32_32x32x16_bf16(pa3,PK(3),o[d0],0,0,0);
    #undef PK
  }
}

#ifndef ATTN_STORE16
#define ATTN_STORE16(p,v) (*(u32x4*)(p)=(v))
#endif
template<int THRL> __device__ __forceinline__ void attn_unit(int b,int h,int qb,const bf16*Q,const bf16*__restrict__ K,const bf16*__restrict__ V,bf16*O,const float*__restrict__ CUMh,const float*__restrict__ qgain,const float skip_th,char*shm){
  int tid=threadIdx.x; asm volatile("":"+v"(tid)); const int lane=tid&63,r32=lane&31,hi=lane>>5; const int wid=__builtin_amdgcn_readfirstlane(tid>>6);
  const long rowbase=(long)b*SEQ; const int q0=qb*QB;
  const bf16*Qw=Q+(rowbase+q0+wid*QBLK)*DM+h*D;
  const bf16*Kh=K+rowbase*DM+h*D,*Vh=V+rowbase*DM+h*D;
  const float cref=CUMh[q0]; int ts=0;
  { const int tmax=(q0+QB)/KVBLK-4;
    for(int t0=0;t0<tmax;t0+=64){ const int t=t0+lane; bool sk=false; if(t<tmax) sk=(CUMh[64*t+63]-cref)*1.4426950408889634f>skip_th; ts+=__popcll(__ballot(sk)); }
    ts=__builtin_amdgcn_readfirstlane(ts)&~1; }
  Kh+=(long)ts*KVBLK*DM; Vh+=(long)ts*KVBLK*DM;
  const unsigned lds0=(unsigned)(uintptr_t)shm;
  float*wsf=(float*)(shm+LDS_WS)+wid*64;
  const bf16*ksrc=Kh+(long)lane*DM+wid*8;
  const bf16*vsrc=Vh+(long)(16*(wid&3)+(lane>>2))*DM+(wid>>2)*32+(lane&3)*8;
  const unsigned kdst=lds0+LDS_K+wid*1024, vdst=lds0+LDS_V+wid*1024;
  #define DMA_K(t,slot) glds16(ksrc+(long)(t)*KVBLK*DM,(unsigned)__builtin_amdgcn_readfirstlane(kdst+(slot)))
  #define DMA_V(t,slot) glds16(vsrc+(long)(t)*KVBLK*DM,(unsigned)__builtin_amdgcn_readfirstlane(vdst+(slot)))
  const int vb0=(int)(lds0+LDS_V)+((lane>>4)&1)*32+(lane&3)*8+(4*hi+((lane&15)>>2))*64;
  const char*Kbase=shm+LDS_K; bf16x8 kf[8];
  const lds_cptr shm3=(lds_cptr)shm; const lds_cptr kp0=shm3+LDS_K+hi*1024+r32*16; const lds_cptr vp0=shm3+LDS_V+((lane>>4)&1)*32+(lane&3)*8+(4*hi+((lane&15)>>2))*64;
  const int NT=(q0+QB)/KVBLK-ts;
  DMA_K(0,0);DMA_V(0,0);DMA_K(1,SLOTB);
  bf16x8 qr[4];
  #pragma unroll
  for(int d0=0;d0<4;++d0)qr[d0]=*reinterpret_cast<const bf16x8*>(&Qw[(long)r32*DM+d0*16+hi*8]);
  {
    __attribute__((address_space(3))) float*ckw=(__attribute__((address_space(3))) float*)(shm3+LDS_CKS); const int nkv=q0+QB-ts*KVBLK; const float*cums=CUMh+ts*KVBLK;
    for(int i=tid*4;i<nkv;i+=NW*64*4){ const float4 c4=*reinterpret_cast<const float4*>(cums+i);
      ckw[i]=(c4.x-cref)*1.4426950408889634f; ckw[i+1]=(c4.y-cref)*1.4426950408889634f; ckw[i+2]=(c4.z-cref)*1.4426950408889634f; ckw[i+3]=(c4.w-cref)*1.4426950408889634f; }
  }
  float mhat=0.f,l_reg=0.f;f32x16 o[2];o[0]=f32x16{};o[1]=f32x16{};f32x16 negm=f32x16{};asm volatile("":"+v"(negm));
  const int qrel=wid*QBLK+r32;
  #define CMASK(P0,P1,t) do{int jb_=(t)-(NT-4); if(jb_>=0)cmask(P0,P1,jb_,qrel,hi);}while(0)
  bool resc=false;
  #define START(P0,P1) do{ const float rm=rowmax(P0,P1); resc=false; \
    { const float dl=rm; mhat=fadd_s(mhat,dl); \
      _Pragma("unroll") for(int r=0;r<16;++r){P0[r]=fsub_s(P0[r],dl);P1[r]=fsub_s(P1[r],dl);} \
      _Pragma("unroll") for(int r=0;r<16;++r)negm[r]=-mhat; asm volatile("":"+v"(negm)); } \
    _Pragma("unroll") for(int r=0;r<16;++r)P0[r]=__builtin_amdgcn_exp2f(P0[r]); }while(0)
  #define RESC() do{ if(resc){ asm volatile("s_waitcnt lgkmcnt(0)":::"memory"); \
      _Pragma("unroll") for(int d_=0;d_<2;++d_) _Pragma("unroll") for(int r=0;r<16;++r)o[d_][r]*=wsf[crow(r,hi)]; } }while(0)
  typedef float f32x4_t __attribute__((ext_vector_type(4)));
  #define BIAS(P0,P1,t) do{ const __attribute__((address_space(3))) float*ck_=(const __attribute__((address_space(3))) float*)(shm3+LDS_CKS)+(t)*64+4*hi; \
    _Pragma("unroll") for(int g_=0;g_<4;++g_){ const f32x4_t a_=*(const __attribute__((address_space(3))) f32x4_t*)(ck_+8*g_), b_=*(const __attribute__((address_space(3))) f32x4_t*)(ck_+32+8*g_); \
      _Pragma("unroll") for(int j_=0;j_<4;++j_){ float t0_=P0[4*g_+j_]-a_[j_]; asm volatile("":"+v"(t0_)); P0[4*g_+j_]=t0_; float t1_=P1[4*g_+j_]-b_[j_]; asm volatile("":"+v"(t1_)); P1[4*g_+j_]=t1_; } } }while(0)
  f32x16 pA0,pA1,pB0,pB1;
  int sl_prev=0,sl_cur=0,sl_next=SLOTB;
  #define ROT() do{sl_prev=sl_cur;sl_cur=sl_next;sl_next=(sl_next==(NSLOT-1)*SLOTB)?0:sl_next+SLOTB;}while(0)
  DMA_K(2,2*SLOTB);
  WAIT_BAR(3);
  qkt(pA0,pA1,Kbase,qr,negm,r32,hi);asm volatile("s_nop 15\n\ts_nop 7":"+v"(pA0),"+v"(pA1));BIAS(pA0,pA1,0);CMASK(pA0,pA1,0);
  START(pA0,pA1);
  _Pragma("unroll") for(int r=0;r<16;++r)pA1[r]=__builtin_amdgcn_exp2f(pA1[r]);
  WAIT_BAR(0);
  DMA_K(3,0);DMA_V(1,SLOTB);
  ROT();
  kload8(kf,kp0+sl_cur);
  WAIT_BAR(2);
  s16x4 vlo[8],vhi[8]; u32x4 pw0,pw1,pw2,pw3;
  f32x4_t cka_[4],ckb_[4];
  #define CKLD(dst,t,off) do{ const __attribute__((address_space(3))) float*ck_=(const __attribute__((address_space(3))) float*)(shm3+LDS_CKS)+(t)*64+4*hi+(off); \
    _Pragma("unroll") for(int g_=0;g_<4;++g_) dst[g_]=*(const __attribute__((address_space(3))) f32x4_t*)(ck_+8*g_); }while(0)
  #define BIASR(P0,P1) do{ _Pragma("unroll") for(int g_=0;g_<4;++g_){ _Pragma("unroll") for(int j_=0;j_<4;++j_){ float t0_=P0[4*g_+j_]-cka_[g_][j_]; asm volatile("":"+v"(t0_)); P0[4*g_+j_]=t0_; float t1_=P1[4*g_+j_]-ckb_[g_][j_]; asm volatile("":"+v"(t1_)); P1[4*g_+j_]=t1_; } } }while(0)
  #define PKW(P,B) cvtpk_s(P[B],P[B+1])
  #define PAF(k) __builtin_bit_cast(bf16x8,pw##k)
  #define VFR(i) (bf16x8){vlo[i][0],vlo[i][1],vlo[i][2],vlo[i][3],vhi[i][0],vhi[i][1],vhi[i][2],vhi[i][3]}
  #define PIN(x) asm volatile("":"+v"(x))
  #define MX3(a,b,c) __builtin_fmaxf(__builtin_fmaxf((a),(b)),(c))
  #define GAPA(MF,A0,A1,A2,A3,W0,W1,PW) do{ MF; sacc+=A0; sacc+=A1; sacc+=A2; sacc+=A3; PIN(sacc); W0; W1; PIN(PW); SBAR(); }while(0)
  #define EX(v) __builtin_amdgcn_exp2f(v)
  #define GAPB(MF,X,B) do{ MF; X[B]=EX(X[B]); X[B+1]=EX(X[B+1]); X[B+2]=EX(X[B+2]); X[B+3]=EX(X[B+3]); PIN(X); SBAR(); }while(0)
  #define VRD(i) do{ vlo[i]=vtr(vp_+(((i)>>2)*4096+((i)&3)*1024)); vhi[i]=vtr(vp_+(((i)>>2)*4096+((i)&3)*1024+512)); }while(0)
  #define KRD(G,j) do{ if(G){ kload2(kf,kp0+sl_next,j); SBAR(); } }while(0)
  #define STEP(C0,C1,P0,P1,t,GK,GV,GL) do{ SBAR(); \
    const lds_cptr vp_=vp0+sl_prev; \
    VRD(0); SBAR(); float sacc=(P0[0]+P0[1]); \
    GAPA(C0=__builtin_amdgcn_mfma_f32_32x32x16_bf16(kf[0],qr[0],negm,0,0,0), P0[2],P0[3],P0[4],P0[5],     pw0[0]=PKW(P0,0), pw0[1]=PKW(P0,2), pw0); \
    VRD(4); SBAR(); GAPA(C1=__builtin_amdgcn_mfma_f32_32x32x16_bf16(kf[1],qr[0],negm,0,0,0), P0[6],P0[7],P0[8],P0[9],     pw0[2]=PKW(P0,4), pw0[3]=PKW(P0,6), pw0); \
    VRD(1); SBAR(); GAPA(C0=__builtin_amdgcn_mfma_f32_32x32x16_bf16(kf[2],qr[1],C0,0,0,0),   P0[10],P0[11],P0[12],P0[13], pw1[0]=PKW(P0,8), pw1[1]=PKW(P0,10), pw1); \
    VRD(5); SBAR(); GAPA(C1=__builtin_amdgcn_mfma_f32_32x32x16_bf16(kf[3],qr[1],C1,0,0,0),   P0[14],P0[15],P1[0],P1[1],   pw1[2]=PKW(P0,12),pw1[3]=PKW(P0,14), pw1); \
    VRD(2); SBAR(); GAPA(C0=__builtin_amdgcn_mfma_f32_32x32x16_bf16(kf[4],qr[2],C0,0,0,0),   P1[2],P1[3],P1[4],P1[5],     pw2[0]=PKW(P1,0), pw2[1]=PKW(P1,2), pw2); \
    VRD(6); CKLD(cka_,t,0); SBAR(); GAPA(C1=__builtin_amdgcn_mfma_f32_32x32x16_bf16(kf[5],qr[2],C1,0,0,0),   P1[6],P1[7],P1[8],P1[9],     pw2[2]=PKW(P1,4), pw2[3]=PKW(P1,6), pw2); \
    VRD(3); SBAR(); GAPA(C0=__builtin_amdgcn_mfma_f32_32x32x16_bf16(kf[6],qr[3],C0,0,0,0),   P1[10],P1[11],P1[12],P1[13], pw3[0]=PKW(P1,8), pw3[1]=PKW(P1,10), pw3); \
    VRD(7); CKLD(ckb_,t,32); SBAR(); GAPA(C1=__builtin_amdgcn_mfma_f32_32x32x16_bf16(kf[7],qr[3],C1,0,0,0),   P1[14],P1[15],0.f,0.f,       pw3[2]=PKW(P1,12),pw3[3]=PKW(P1,14), pw3); \
    l_reg+=sacc; \
    if(GK){DMA_K((t)+3,sl_cur);} if(GV){DMA_V((t)+1,sl_next);} \
    BIASR(C0,C1); CMASK(C0,C1,t); \
    { float a=MX3(C0[0],C0[1],C1[0]),b=MX3(C0[2],C0[3],C1[1]); a=MX3(a,C1[2],C1[3]); \
      _Pragma("unroll") for(int r=4;r<16;r+=4){a=MX3(a,C0[r],C0[r+1]);b=MX3(b,C0[r+2],C0[r+3]);a=MX3(a,C1[r],C1[r+1]);b=MX3(b,C1[r+2],C1[r+3]);} \
      float rm=__builtin_fmaxf(a,b); { auto rr=__builtin_amdgcn_permlane32_swap(__float_as_uint(rm),__float_as_uint(rm),false,false); rm=__builtin_fmaxf(__uint_as_float(rr[0]),__uint_as_float(rr[1])); } \
      resc=false; \
      if(__builtin_expect(__any(rm>(float)THRL),0)){ const float dl=__builtin_fmaxf(rm,0.f); mhat+=dl; \
        _Pragma("unroll") for(int r=0;r<16;++r){C0[r]-=dl;C1[r]-=dl;} \
        _Pragma("unroll") for(int r=0;r<16;++r)negm[r]=-mhat; asm volatile("":"+v"(negm)); \
        const float f=__builtin_amdgcn_exp2f(-dl); l_reg*=f; if(hi==0)wsf[r32]=f; resc=true; } } \
    SBAR(); \
    GAPB(o[0]=__builtin_amdgcn_mfma_f32_32x32x16_bf16(PAF(0),VFR(0),o[0],0,0,0), C0,0); \
    GAPB(o[1]=__builtin_amdgcn_mfma_f32_32x32x16_bf16(PAF(0),VFR(4),o[1],0,0,0), C0,4); \
    KRD(GL,0); GAPB(o[0]=__builtin_amdgcn_mfma_f32_32x32x16_bf16(PAF(1),VFR(1),o[0],0,0,0), C0,8); \
    KRD(GL,1); GAPB(o[1]=__builtin_amdgcn_mfma_f32_32x32x16_bf16(PAF(1),VFR(5),o[1],0,0,0), C0,12); \
    KRD(GL,2); GAPB(o[0]=__builtin_amdgcn_mfma_f32_32x32x16_bf16(PAF(2),VFR(2),o[0],0,0,0), C1,0); \
    KRD(GL,3); GAPB(o[1]=__builtin_amdgcn_mfma_f32_32x32x16_bf16(PAF(2),VFR(6),o[1],0,0,0), C1,4); \
    GAPB(o[0]=__builtin_amdgcn_mfma_f32_32x32x16_bf16(PAF(3),VFR(3),o[0],0,0,0), C1,8); \
    GAPB(o[1]=__builtin_amdgcn_mfma_f32_32x32x16_bf16(PAF(3),VFR(7),o[1],0,0,0), C1,12); \
    }while(0)
  int t=1;
  #undef CMASK
  #define CMASK(P0,P1,t) do{}while(0)
  for(;t+5<NT;t+=2){
    STEP(pB0,pB1,pA0,pA1,t,true,true,true);     WAIT_BAR(2); RESC(); ROT();
    STEP(pA0,pA1,pB0,pB1,t+1,true,true,true);   WAIT_BAR(2); RESC(); ROT();
  }
  #undef CMASK
  #define CMASK(P0,P1,t) do{int jb_=(t)-(NT-4); if(jb_>=0)cmask(P0,P1,jb_,qrel,hi);}while(0)
  #define ENDW(tt) do{ if((tt)+3<NT){WAIT_BAR(2);} else if((tt)+2<NT){WAIT_BAR(1);} else {WAIT_BAR(0);} }while(0)
  for(;t+1<NT;t+=2){
    STEP(pB0,pB1,pA0,pA1,t,(t+3<NT),(t+1<NT),(t+1<NT));       ENDW(t);   RESC(); ROT();
    STEP(pA0,pA1,pB0,pB1,t+1,(t+4<NT),(t+2<NT),(t+2<NT));     ENDW(t+1); RESC(); ROT();
  }
  STEP(pB0,pB1,pA0,pA1,NT-1,false,false,false); RESC();
  { float sacc=pB0[0]+pB0[1]; _Pragma("unroll") for(int r=2;r<16;++r)sacc+=pB0[r]; _Pragma("unroll") for(int r=0;r<16;++r)sacc+=pB1[r]; l_reg+=sacc;
    pw0=(u32x4){PKW(pB0,0),PKW(pB0,2),PKW(pB0,4),PKW(pB0,6)};pw1=(u32x4){PKW(pB0,8),PKW(pB0,10),PKW(pB0,12),PKW(pB0,14)};pw2=(u32x4){PKW(pB1,0),PKW(pB1,2),PKW(pB1,4),PKW(pB1,6)};pw3=(u32x4){PKW(pB1,8),PKW(pB1,10),PKW(pB1,12),PKW(pB1,14)};
    SBAR(); pv(o,vb0+sl_cur,PAF(0),PAF(1),PAF(2),PAF(3)); }
  #undef PKW
  #undef PAF
  #undef VFR
  #undef PIN
  #undef MX3
  #undef GAPA
  #undef GAPB
  #undef EX
  #undef VRD
  #undef KRD
  #undef STEP
  #undef ENDW
  {auto rr=__builtin_amdgcn_permlane32_swap(__float_as_uint(l_reg),__float_as_uint(l_reg),false,false);l_reg=__uint_as_float(rr[0])+__uint_as_float(rr[1]);}
  if(hi==0)wsf[32+r32]=l_reg;asm volatile("s_waitcnt lgkmcnt(0)":::"memory");
  float rli[16];
  #pragma unroll
  for(int r=0;r<16;++r)rli[r]=__builtin_amdgcn_rcpf(wsf[32+crow(r,hi)]);
  bf16*Ow=O+(rowbase+q0+wid*QBLK)*ODM+h*D;
  { bf16*stg=(bf16*)(shm+LDS_OST)+wid*2048;
    #pragma unroll
    for(int r=0;r<16;++r){const int orow=crow(r,hi);
      #pragma unroll
      for(int d0=0;d0<2;++d0)stg[orow*64+d0*32+r32]=__float2bfloat16(o[d0][r]*rli[r]);}
    asm volatile("s_waitcnt lgkmcnt(0)":::"memory");
    #pragma unroll
    for(int i=0;i<4;++i){const int row=i*8+(lane>>3),ch=lane&7; const u32x4 v=*(const u32x4*)(stg+row*64+ch*8); ATTN_STORE16(Ow+(long)row*ODM+ch*8,v);} }
  asm volatile("s_waitcnt lgkmcnt(0)\n\ts_barrier":::"memory");
  #undef DMA_K
  #undef DMA_V
  #undef CMASK
  #undef START
  #undef RESC
  #undef ROT
  #undef BIAS
  #undef BIASR
  #undef CKLD
}
constexpr int ATTN_LDS_BYTES=LDS_BYTES;
#undef SBAR
#undef WAIT_BAR
}

#define LAS __attribute__((address_space(3)))
typedef unsigned short bfr;
typedef float f32x4v __attribute__((ext_vector_type(4)));
typedef unsigned u32x4v __attribute__((ext_vector_type(4)));
typedef unsigned u32x2v __attribute__((ext_vector_type(2)));
typedef short bf16x8v __attribute__((ext_vector_type(8)));

constexpr int NB = 4, SEQ = 8192, DMODEL = 1024, DEPTH = 4, MROWS = NB * SEQ;
constexpr int NPROJ = 3072, DIN = 2966, DFF = 2816, NGU = 5632, NMOD = 6144, DMIX = 1024;
constexpr int C_LX = 0, C_LG = 384, C_FQ = 768, C_FK = 1152, C_FV = 1536, C_GQ = 1920, C_GK = 2176, C_GV = 2432, C_GG = 2688, C_GL = 2944, C_FF = 2960;
constexpr float EPS = 1e-6f, LOG2E = 1.4426950408889634f;

constexpr size_t MiB = 1u << 20;
constexpr size_t WS_CTL = 0, CTL_BYTES = 65536;
constexpr int CW_BAR = 1024;
constexpr size_t WS_MOD = 1 * MiB;
constexpr size_t WS_CUM = 2 * MiB;
constexpr size_t WS_DEC = 3 * MiB;
constexpr size_t WS_SUMA = 4 * MiB, WS_SUMH = 5 * MiB;
constexpr size_t WS_LRUW = 6 * MiB;
constexpr size_t WS_WIN = 8 * MiB, WS_WOUT = 32 * MiB, WS_WGU = 40 * MiB, WS_WDN = 84 * MiB;
constexpr size_t WIN_L = (size_t)NPROJ * 1024 * 2, WOUT_L = (size_t)1024 * 1024 * 2, WGU_L = (size_t)NGU * 1024 * 2, WDN_L = (size_t)1024 * DFF * 2;
constexpr size_t WS_PROJ = 106 * MiB;
constexpr size_t WS_MIX = 298 * MiB;
constexpr size_t WS_HN = 362 * MiB;
constexpr size_t WS_HL = 362 * MiB, WS_ACUM = 386 * MiB, WS_QDEC = 410 * MiB;
constexpr size_t WS_OINTRA = 426 * MiB;
constexpr size_t WS_KV = 442 * MiB;
constexpr size_t WS_ST = 474 * MiB;
constexpr size_t WS_END = 490 * MiB;
static_assert(WS_WDN + 4 * WDN_L <= WS_PROJ && WS_WGU + 4 * WGU_L <= WS_WDN && WS_WIN + 4 * WIN_L <= WS_WOUT && WS_WOUT + 4 * WOUT_L <= WS_WGU, "ws map");

constexpr int RING_BYTES = 131072, MISC_OFF = RING_BYTES, LDS_BYTES = 147456;
static_assert(attn_body::ATTN_LDS_BYTES <= RING_BYTES, "attention LDS");

__device__ __forceinline__ float bf2f(bfr h) { return __uint_as_float((unsigned)h << 16); }
typedef float f32x2v_ __attribute__((ext_vector_type(2))); typedef __bf16 bf16x2v_ __attribute__((ext_vector_type(2)));
__device__ __forceinline__ unsigned pk2(float lo, float hi) { f32x2v_ v = {lo, hi}; bf16x2v_ b = __builtin_convertvector(v, bf16x2v_); return __builtin_bit_cast(unsigned, b); }
__device__ __forceinline__ bfr f2bf(float f) { return (bfr)(pk2(f, f) & 0xffffu); }
__device__ __forceinline__ float wave_sum(float v) {
#pragma unroll
    for (int o = 1; o < 64; o <<= 1) v += __shfl_xor(v, o);
    return v;
}
__device__ __forceinline__ float sigmoidf_(float x) { return __builtin_amdgcn_rcpf(1.0f + __expf(-x)); }
__device__ __forceinline__ float log_sigmoid_(float z) { return fminf(z, 0.f) - __logf(1.0f + __expf(-fabsf(z))); }
__device__ __forceinline__ float gelu_tanh_(float y) { const float z = 0.7978845608028654f * (y + 0.044715f * y * y * y); const float t = 1.0f - 2.0f * __builtin_amdgcn_rcpf(__expf(2.0f * z) + 1.0f); return 0.5f * y * (1.0f + t); }
__device__ __forceinline__ float silu_(float g) { return g * __builtin_amdgcn_rcpf(1.0f + __expf(-g)); }

struct Params { const float* in[23]; float* out; unsigned char* ws; };

__device__ __forceinline__ int map_in(int n) {
    if (n >= 768 && n < 1536) {
        const int c = n & 255, s_ = (c & 127) >> 5, d = (c & 31) + 32 * (c >> 7), H = 4 * ((n >> 8) - 3) + s_;
        return 768 + H * 64 + d; }
    if (n < 1920) return n;
    if (n < 2688) return n + 6;
    if (n < 2944) return n - 2688 + 2710;
    if (n < 2960) return n - 2944 + 2694;
    if (n < 2966) return n - 2960 + 1920;
    return -1;
}
__device__ __forceinline__ int map_gu(int n) { const int pn = n >> 8, r = n & 255; return r < 128 ? pn * 128 + r : DFF + pn * 128 + (r - 128); }
template <int MODE> __device__ __forceinline__ void transpose_item(const float* __restrict__ W, int K, int N, int NP, bfr* __restrict__ WT, LAS float* scr, int item, int lane) {
    const int nblk = NP / 32, kb = item / nblk, nb = item % nblk, k0 = 64 * kb, n0 = 32 * nb;
    const int nme = n0 + (lane & 31);
    const int nsrc = MODE == 0 ? nme : (MODE == 1 ? map_in(nme) : map_gu(nme));
#pragma unroll 8
    for (int i = 0; i < 32; ++i) { const int kk = 2 * i + (lane >> 5); scr[kk * 33 + (lane & 31)] = nsrc >= 0 ? W[(size_t)(k0 + kk) * N + nsrc] : 0.f; }
    asm volatile("s_waitcnt lgkmcnt(0)" ::: "memory");
    const int c = lane & 7;
#pragma unroll
    for (int j = 0; j < 4; ++j) { const int n = (lane >> 3) + 8 * j; const LAS float* s = scr + (8 * c) * 33 + n;
        u32x4v o; o.x = pk2(s[0 * 33], s[1 * 33]); o.y = pk2(s[2 * 33], s[3 * 33]); o.z = pk2(s[4 * 33], s[5 * 33]); o.w = pk2(s[6 * 33], s[7 * 33]);
        *(u32x4v*)(WT + (size_t)(n0 + n) * K + k0 + 8 * c) = o; }
    asm volatile("s_waitcnt lgkmcnt(0)" ::: "memory");
}
__device__ __forceinline__ void p0_prologue(const Params& P, LAS unsigned char* lds, int tid, int lane, int wid, int G) {
    asm volatile("" : "+v"(tid), "+v"(lane), "+s"(wid));
    unsigned char* ws = P.ws;
    {
        LAS float* CA = (LAS float*)lds;
        LAS float* RED = (LAS float*)(lds + 16384);
        const float* c = P.in[1];
        for (int i = tid; i < NB * DMODEL; i += 512) CA[i] = silu_(c[i]);
        __syncthreads();
        const int kp = tid >> 5, col = tid & 31;
        float* MOD = (float*)(ws + WS_MOD);
        for (int it = blockIdx.x; it < DEPTH * (NMOD / 32); it += G) {
            const int l = it / (NMOD / 32), c0 = (it % (NMOD / 32)) * 32;
            const float* w = P.in[4] + ((size_t)l * DMODEL + kp * 64) * NMOD + c0 + col;
            float a0 = 0.f, a1 = 0.f, a2 = 0.f, a3 = 0.f;
#pragma unroll 8
            for (int k = 0; k < 64; ++k) { const float wv = w[(size_t)k * NMOD]; const int kk = kp * 64 + k;
                a0 += CA[kk] * wv; a1 += CA[1024 + kk] * wv; a2 += CA[2048 + kk] * wv; a3 += CA[3072 + kk] * wv; }
            RED[(kp * 4 + 0) * 32 + col] = a0; RED[(kp * 4 + 1) * 32 + col] = a1; RED[(kp * 4 + 2) * 32 + col] = a2; RED[(kp * 4 + 3) * 32 + col] = a3;
            __syncthreads();
            if (tid < 128) { const int b = tid >> 5; float s = P.in[5][(size_t)l * NMOD + c0 + col];
#pragma unroll
                for (int q = 0; q < 16; ++q) s += RED[(q * 4 + b) * 32 + col];
                MOD[((size_t)l * NB + b) * NMOD + c0 + col] = s; }
            __syncthreads();
        }
    }
    __syncthreads();
    {
        bfr* LW = (bfr*)(ws + WS_LRUW);
        for (int i = blockIdx.x * 512 + tid; i < DEPTH * 6 * 2 * 4096; i += G * 512) {
            const int d = i & 63, e = (i >> 6) & 63, mat = (i >> 12) & 1, ln = i >> 13;
            const float* src = mat ? P.in[11] : P.in[9];
            LW[i] = f2bf(src[(size_t)ln * 4096 + d * 64 + e]);
        }
    }
    {
        LAS float* scr = (LAS float*)(lds + wid * 16384);
        const int gw = blockIdx.x * 8 + wid, NGW = G * 8;
        constexpr int I_IN = 16 * (NPROJ / 32), I_OUT = 16 * 32, I_GU = 16 * (NGU / 32), I_DN = (DFF / 64) * 32, I_L = I_IN + I_OUT + I_GU + I_DN;
        for (int it = gw; it < DEPTH * I_L; it += NGW) {
            const int l = it / I_L; int r = it % I_L;
            if (r < I_IN) { transpose_item<1>(P.in[6] + (size_t)l * DMODEL * DIN, DMODEL, DIN, NPROJ, (bfr*)(ws + WS_WIN + l * WIN_L), scr, r, lane); continue; } r -= I_IN;
            if (r < I_OUT) { transpose_item<0>(P.in[20] + (size_t)l * DMIX * DMODEL, DMIX, DMODEL, DMODEL, (bfr*)(ws + WS_WOUT + l * WOUT_L), scr, r, lane); continue; } r -= I_OUT;
            if (r < I_GU) { transpose_item<2>(P.in[21] + (size_t)l * DMODEL * NGU, DMODEL, NGU, NGU, (bfr*)(ws + WS_WGU + l * WGU_L), scr, r, lane); continue; } r -= I_GU;
            transpose_item<0>(P.in[22] + (size_t)l * DFF * DMODEL, DFF, DMODEL, DMODEL, (bfr*)(ws + WS_WDN + l * WDN_L), scr, r, lane);
        }
    }
}

__device__ __forceinline__ void norm_phase(const float* __restrict__ x, const bfr* __restrict__ x16, const float* __restrict__ gain, const float* __restrict__ modl, int shift_off, int scale_off, bfr* __restrict__ HN, int gw, int NGW, int lane) {
    asm volatile("" : "+v"(lane), "+s"(gw));
    for (int m = gw; m < MROWS; m += NGW) {
        f32x4v v[4]; float s = 0.f;
        if (x16) {
            const u32x2v* xr = (const u32x2v*)(x16 + (size_t)m * DMODEL) + lane;
#pragma unroll
            for (int j = 0; j < 4; ++j) { const u32x2v w = xr[64 * j]; const pg8::f32x2 a = pg8::h2f(w.x), b = pg8::h2f(w.y); v[j] = (f32x4v){a.x, a.y, b.x, b.y}; }
        } else {
            const f32x4v* xr = (const f32x4v*)(x + (size_t)m * DMODEL) + lane;
#pragma unroll
            for (int j = 0; j < 4; ++j) v[j] = xr[64 * j];
        }
#pragma unroll
        for (int j = 0; j < 4; ++j) s += (v[j].x * v[j].x + v[j].y * v[j].y) + (v[j].z * v[j].z + v[j].w * v[j].w);
        const float rstd = 1.0f / sqrtf(wave_sum(s) * (1.0f / DMODEL) + EPS);
        const float* mb = modl + (size_t)(m / SEQ) * NMOD;
        u32x2v* o8 = (u32x2v*)(HN + (size_t)m * DMODEL) + lane;
#pragma unroll
        for (int j = 0; j < 4; ++j) { const int col = 4 * lane + 256 * j;
            const f32x4v g = *(const f32x4v*)(gain + col), sc = *(const f32x4v*)(mb + scale_off + col), sh = *(const f32x4v*)(mb + shift_off + col);
            const f32x4v h = v[j] * rstd * g * (sc + 1.0f) + sh;
            u32x2v w; w.x = pk2(h.x, h.y); w.y = pk2(h.z, h.w); o8[64 * j] = w; }
    }
}

struct LayerPtrs {
    const float *conv_w, *conv_b, *b_r, *b_i, *lam, *fox_bf, *qgain, *kgain, *w_alpha, *b_alpha, *ogain;
    const bfr* lruw;
};

constexpr int LRU_LC = 128, LRU_NCH = SEQ / LRU_LC;
__device__ __forceinline__ void lru_local_item(int idx, const LayerPtrs& L, unsigned char* ws, LAS unsigned char* lds, int tid, int lane, int wid) {
    asm volatile("" : "+v"(tid), "+v"(lane), "+s"(wid));
    const int n = idx % 6, c = (idx / 6) % LRU_NCH, b = idx / (6 * LRU_NCH);
    const int ch = tid & 63, tg = wid;
    const bfr* PROJ = (const bfr*)(ws + WS_PROJ);
    LAS bfr* XA = (LAS bfr*)lds;
    LAS float* RI = (LAS float*)(lds + 18432);
    LAS float* SEG = (LAS float*)(lds + 18432 + 65536);
    const int cg_ = n * 64 + ch;
    const int mat = wid >> 2, fr = lane & 15, fq = lane >> 4;
    const bfr* wt = L.lruw + (size_t)(n * 2 + mat) * 4096;
    bf16x8v bfrag[4][2];
#pragma unroll
    for (int te = 0; te < 4; ++te) { bfrag[te][0] = *(const bf16x8v*)(wt + (16 * te + fr) * 64 + 8 * fq); bfrag[te][1] = *(const bf16x8v*)(wt + (16 * te + fr) * 64 + 32 + 8 * fq); }
    const float lam = L.lam[cg_], br = L.b_r[cg_], bi = L.b_i[cg_];
    float xa[16];
    {
        float raw[19];
#pragma unroll
        for (int j = 0; j < 19; ++j) { const int tt = c * LRU_LC + 16 * tg - 3 + j; raw[j] = tt >= 0 ? bf2f(PROJ[((size_t)b * SEQ + tt) * NPROJ + C_LX + cg_]) : 0.f; }
        const float w0 = L.conv_w[cg_], w1 = L.conv_w[384 + cg_], w2 = L.conv_w[768 + cg_], w3 = L.conv_w[1152 + cg_], cb = L.conv_b[cg_];
#pragma unroll
        for (int i = 0; i < 16; ++i) { xa[i] = cb + w0 * raw[i] + w1 * raw[i + 1] + w2 * raw[i + 2] + w3 * raw[i + 3]; XA[(16 * tg + i) * 72 + ch] = f2bf(xa[i]); }
    }
    __syncthreads();
    {
#pragma unroll
        for (int q = 0; q < 2; ++q) {
            const int tr = 2 * (wid & 3) + q;
            const bf16x8v a0 = *(const LAS bf16x8v*)(XA + (16 * tr + fr) * 72 + 8 * fq), a1 = *(const LAS bf16x8v*)(XA + (16 * tr + fr) * 72 + 32 + 8 * fq);
#pragma unroll
            for (int te = 0; te < 4; ++te) {
                f32x4v acc = {0.f, 0.f, 0.f, 0.f};
                acc = __builtin_amdgcn_mfma_f32_16x16x32_bf16(a0, bfrag[te][0], acc, 0, 0, 0);
                acc = __builtin_amdgcn_mfma_f32_16x16x32_bf16(a1, bfrag[te][1], acc, 0, 0, 0);
#pragma unroll
                for (int r = 0; r < 4; ++r) RI[(mat * LRU_LC + 16 * tr + 4 * fq + r) * 64 + 16 * te + fr] = acc[r];
            }
        }
    }
    __syncthreads();
    float hs[16], ps[16];
    {
        const float e_ = __expf(-fabsf(lam));
        const float sp = fmaxf(-lam, 0.f) + (e_ < 0.03125f ? e_ * (1.0f - e_ * (0.5f - e_ * (0.33333334f - 0.25f * e_))) : __logf(1.0f + e_));
        float h = 0.f, p = 1.f;
#pragma unroll
        for (int i = 0; i < 16; ++i) {
            const float r = sigmoidf_(RI[(16 * tg + i) * 64 + ch] + br), ig = sigmoidf_(RI[(LRU_LC + 16 * tg + i) * 64 + ch] + bi);
            const float la = -8.0f * r * sp; const float a = __expf(la); const float mult = __builtin_amdgcn_sqrtf(fmaxf(1.0f - a * a, 0.f));
            h = a * h + mult * ig * xa[i]; p *= a; hs[i] = h; ps[i] = p;
        }
        SEG[(tg * 2 + 0) * 64 + ch] = p; SEG[(tg * 2 + 1) * 64 + ch] = h;
    }
    __syncthreads();
    {
        float carry = 0.f, pref = 1.f;
        for (int g = 0; g < tg; ++g) { const float pg = SEG[(g * 2) * 64 + ch], hg = SEG[(g * 2 + 1) * 64 + ch]; carry = pg * carry + hg; pref *= pg; }
        bfr* HL = (bfr*)(ws + WS_HL); bfr* AC = (bfr*)(ws + WS_ACUM);
        const size_t m0 = (size_t)b * SEQ + c * LRU_LC + 16 * tg;
        float hl = 0.f, ac = 0.f;
#pragma unroll
        for (int i = 0; i < 16; ++i) { hl = hs[i] + ps[i] * carry; ac = ps[i] * pref; HL[(m0 + i) * 384 + cg_] = f2bf(hl); AC[(m0 + i) * 384 + cg_] = f2bf(ac); }
        if (tg == 7) { ((float*)(ws + WS_SUMA))[((size_t)b * LRU_NCH + c) * 384 + cg_] = ac; ((float*)(ws + WS_SUMH))[((size_t)b * LRU_NCH + c) * 384 + cg_] = hl; }
    }
    __syncthreads();
}
__device__ __forceinline__ void knorm_item(int idx, const LayerPtrs& L, unsigned char* ws, int tid) {
    asm volatile("" : "+v"(tid));
    bfr* PROJ = (bfr*)(ws + WS_PROJ);
    const int part = tid & 7, hr = tid >> 3;
    const f32x4v g0 = *(const f32x4v*)(L.kgain + part * 8), g1 = *(const f32x4v*)(L.kgain + part * 8 + 4);
#pragma unroll
    for (int p = 0; p < 6; ++p) {
        const int R = p * 64 + hr, tok = R / 6, head = R % 6;
        u32x4v* ptr = (u32x4v*)(PROJ + ((size_t)idx * 64 + tok) * NPROJ + C_FK + head * 64 + part * 8);
        const u32x4v w = *ptr;
        float f[8];
        f[0] = __uint_as_float(w.x << 16); f[1] = __uint_as_float(w.x & 0xffff0000u); f[2] = __uint_as_float(w.y << 16); f[3] = __uint_as_float(w.y & 0xffff0000u);
        f[4] = __uint_as_float(w.z << 16); f[5] = __uint_as_float(w.z & 0xffff0000u); f[6] = __uint_as_float(w.w << 16); f[7] = __uint_as_float(w.w & 0xffff0000u);
        float ss = 0.f;
#pragma unroll
        for (int j = 0; j < 8; ++j) ss += f[j] * f[j];
        ss += __shfl_xor(ss, 1); ss += __shfl_xor(ss, 2); ss += __shfl_xor(ss, 4);
        const float rs = 1.0f / sqrtf(ss * (1.0f / 64.0f) + EPS);
        u32x4v o; o.x = pk2(f[0] * rs * g0.x, f[1] * rs * g0.y); o.y = pk2(f[2] * rs * g0.z, f[3] * rs * g0.w); o.z = pk2(f[4] * rs * g1.x, f[5] * rs * g1.y); o.w = pk2(f[6] * rs * g1.z, f[7] * rs * g1.w);
        *ptr = o;
    }
}
__device__ __forceinline__ void cum_item(int idx, const LayerPtrs& L, unsigned char* ws, LAS unsigned char* lds, int tid, int lane, int wid) {
    asm volatile("" : "+v"(tid), "+v"(lane), "+s"(wid));
    const int b = idx / 6, h = idx % 6;
    const bfr* PROJ = (const bfr*)(ws + WS_PROJ);
    LAS float* WT = (LAS float*)lds;
    const float bf = L.fox_bf[h];
    float loc[16]; float run = 0.f;
#pragma unroll
    for (int i = 0; i < 16; ++i) { const float z = bf2f(PROJ[((size_t)b * SEQ + 16 * tid + i) * NPROJ + C_FF + h]) + bf; run += log_sigmoid_(z); loc[i] = run; }
    float inc = run;
#pragma unroll
    for (int o = 1; o < 64; o <<= 1) { const float t = __shfl_up(inc, o); if (lane >= o) inc += t; }
    if (lane == 63) WT[wid] = inc;
    __syncthreads();
    float base = inc - run;
    for (int w = 0; w < wid; ++w) base += WT[w];
    float* CUM = (float*)(ws + WS_CUM) + ((size_t)b * 6 + h) * SEQ + 16 * tid;
#pragma unroll
    for (int i = 0; i < 16; i += 4) *(f32x4v*)(CUM + i) = (f32x4v){loc[i] + base, loc[i + 1] + base, loc[i + 2] + base, loc[i + 3] + base};
    __syncthreads();
}
__device__ __forceinline__ void gla_local_item(int idx, const LayerPtrs& L, unsigned char* ws, LAS unsigned char* lds, int tid, int lane, int wid) {
    asm volatile("" : "+v"(tid), "+v"(lane), "+s"(wid));
    const int bh = idx >> 6, np = idx & 63, b = bh >> 2, h = bh & 3;
    const int d = tid & 63, tg = wid, fr = lane & 15, fq = lane >> 4;
    const bfr* PROJ = (const bfr*)(ws + WS_PROJ);
    constexpr int CCB = 49152;
    float qf[2][8], kf[2][8]; bfr vb[2][8];
#pragma unroll
    for (int cc = 0; cc < 2; ++cc)
#pragma unroll
        for (int i = 0; i < 8; ++i) { const size_t m = (size_t)b * SEQ + (2 * np + cc) * 64 + 8 * tg + i;
            qf[cc][i] = bf2f(PROJ[m * NPROJ + C_GQ + h * 64 + d]); kf[cc][i] = bf2f(PROJ[m * NPROJ + C_GK + h * 64 + d]); vb[cc][i] = PROJ[m * NPROJ + C_GV + h * 64 + d]; }
    float bc[2][8];
    {
        float wal[16];
#pragma unroll
        for (int r = 0; r < 16; ++r) wal[r] = L.w_alpha[r * 256 + h * 64 + d];
        const float bal = L.b_alpha[h * 64 + d];
#pragma unroll
        for (int cc = 0; cc < 2; ++cc) {
            LAS float* SEGB = (LAS float*)(lds + cc * CCB);
            const size_t m0 = (size_t)b * SEQ + (2 * np + cc) * 64;
            float run = 0.f;
#pragma unroll
            for (int i = 0; i < 8; ++i) {
                const u32x4v* lp = (const u32x4v*)(PROJ + (m0 + 8 * tg + i) * NPROJ + C_GL);
                const u32x4v l0 = lp[0], l1 = lp[1];
                float z = bal;
                z += __uint_as_float(l0.x << 16) * wal[0] + __uint_as_float(l0.x & 0xffff0000u) * wal[1] + __uint_as_float(l0.y << 16) * wal[2] + __uint_as_float(l0.y & 0xffff0000u) * wal[3];
                z += __uint_as_float(l0.z << 16) * wal[4] + __uint_as_float(l0.z & 0xffff0000u) * wal[5] + __uint_as_float(l0.w << 16) * wal[6] + __uint_as_float(l0.w & 0xffff0000u) * wal[7];
                z += __uint_as_float(l1.x << 16) * wal[8] + __uint_as_float(l1.x & 0xffff0000u) * wal[9] + __uint_as_float(l1.y << 16) * wal[10] + __uint_as_float(l1.y & 0xffff0000u) * wal[11];
                z += __uint_as_float(l1.z << 16) * wal[12] + __uint_as_float(l1.z & 0xffff0000u) * wal[13] + __uint_as_float(l1.w << 16) * wal[14] + __uint_as_float(l1.w & 0xffff0000u) * wal[15];
                run += log_sigmoid_(z) * (1.0f / 16.0f); bc[cc][i] = run;
            }
            SEGB[tg * 64 + d] = run;
        }
    }
    __syncthreads();
#pragma unroll
    for (int cc = 0; cc < 2; ++cc) {
        LAS float* SEGB = (LAS float*)(lds + cc * CCB);
        LAS bfr* QD = (LAS bfr*)(lds + cc * CCB + 2048); LAS bfr* KD = QD + 4608; LAS bfr* KTET = KD + 4608; LAS bfr* VT = KTET + 4608;
        const size_t m0 = (size_t)b * SEQ + (2 * np + cc) * 64;
        float off = 0.f, total = 0.f;
#pragma unroll
        for (int g = 0; g < 8; ++g) { const float sg = SEGB[g * 64 + d]; total += sg; if (g < tg) off += sg; }
        bfr* QDEC = (bfr*)(ws + WS_QDEC);
        unsigned kt[4], vv[4];
#pragma unroll
        for (int i = 0; i < 8; ++i) {
            const size_t m = m0 + 8 * tg + i; const float bcum = bc[cc][i] + off;
            const float q = qf[cc][i], k = kf[cc][i]; const bfr v = vb[cc][i];
            const bfr qd = f2bf(q * 0.125f * __expf(bcum)), kd = f2bf(k * __expf(-bcum)), kte = f2bf(k * __expf(total - bcum));
            QD[(8 * tg + i) * 72 + d] = qd; KD[(8 * tg + i) * 72 + d] = kd; QDEC[m * 256 + h * 64 + d] = qd;
            if (i & 1) { kt[i >> 1] |= (unsigned)kte << 16; vv[i >> 1] |= (unsigned)v << 16; } else { kt[i >> 1] = kte; vv[i >> 1] = v; }
        }
        *(LAS u32x4v*)(KTET + d * 72 + 8 * tg) = (u32x4v){kt[0], kt[1], kt[2], kt[3]};
        *(LAS u32x4v*)(VT + d * 72 + 8 * tg) = (u32x4v){vv[0], vv[1], vv[2], vv[3]};
        if (tg == 0) ((float*)(ws + WS_DEC))[((size_t)bh * 128 + 2 * np + cc) * 64 + d] = __expf(total);
    }
    __syncthreads();
#pragma unroll
    for (int cc = 0; cc < 2; ++cc) {
        LAS bfr* QD = (LAS bfr*)(lds + cc * CCB + 2048); LAS bfr* KD = QD + 4608; LAS bfr* ATT = QD + 4 * 4608;
        const int ti = wid & 3;
#pragma unroll
        for (int q = 0; q < 2; ++q) {
            const int tj = 2 * (wid >> 2) + q;
            f32x4v acc = {0.f, 0.f, 0.f, 0.f};
            if (tj <= ti) {
                const bf16x8v a0 = *(const LAS bf16x8v*)(QD + (16 * ti + fr) * 72 + 8 * fq), a1 = *(const LAS bf16x8v*)(QD + (16 * ti + fr) * 72 + 32 + 8 * fq);
                const bf16x8v b0 = *(const LAS bf16x8v*)(KD + (16 * tj + fr) * 72 + 8 * fq), b1 = *(const LAS bf16x8v*)(KD + (16 * tj + fr) * 72 + 32 + 8 * fq);
                acc = __builtin_amdgcn_mfma_f32_16x16x32_bf16(a0, b0, acc, 0, 0, 0);
                acc = __builtin_amdgcn_mfma_f32_16x16x32_bf16(a1, b1, acc, 0, 0, 0);
            }
#pragma unroll
            for (int r = 0; r < 4; ++r) { const int i = 16 * ti + 4 * fq + r, j = 16 * tj + fr; ATT[i * 72 + j] = f2bf(j <= i ? acc[r] : 0.f); }
        }
    }
    __syncthreads();
#pragma unroll
    for (int cc = 0; cc < 2; ++cc) {
        LAS bfr* QD = (LAS bfr*)(lds + cc * CCB + 2048); LAS bfr* KTET = QD + 2 * 4608; LAS bfr* VT = QD + 3 * 4608; LAS bfr* ATT = QD + 4 * 4608;
        const size_t m0 = (size_t)b * SEQ + (2 * np + cc) * 64;
        const int mat = wid >> 2, t4 = wid & 3;
        if (mat == 0) {
            bfr* OI = (bfr*)(ws + WS_OINTRA);
            const bf16x8v b0 = *(const LAS bf16x8v*)(ATT + (16 * t4 + fr) * 72 + 8 * fq), b1 = *(const LAS bf16x8v*)(ATT + (16 * t4 + fr) * 72 + 32 + 8 * fq);
#pragma unroll
            for (int tv = 0; tv < 4; ++tv) {
                const bf16x8v a0 = *(const LAS bf16x8v*)(VT + (16 * tv + fr) * 72 + 8 * fq), a1 = *(const LAS bf16x8v*)(VT + (16 * tv + fr) * 72 + 32 + 8 * fq);
                f32x4v acc = {0.f, 0.f, 0.f, 0.f};
                acc = __builtin_amdgcn_mfma_f32_16x16x32_bf16(a0, b0, acc, 0, 0, 0);
                acc = __builtin_amdgcn_mfma_f32_16x16x32_bf16(a1, b1, acc, 0, 0, 0);
                u32x2v w; w.x = pk2(acc[0], acc[1]); w.y = pk2(acc[2], acc[3]);
                *(u32x2v*)(OI + (m0 + 16 * t4 + fr) * 256 + h * 64 + 16 * tv + 4 * fq) = w;
            }
        } else {
            float* KV = (float*)(ws + WS_KV) + ((size_t)bh * 128 + 2 * np + cc) * 4096;
            const bf16x8v a0 = *(const LAS bf16x8v*)(KTET + (16 * t4 + fr) * 72 + 8 * fq), a1 = *(const LAS bf16x8v*)(KTET + (16 * t4 + fr) * 72 + 32 + 8 * fq);
#pragma unroll
            for (int tv = 0; tv < 4; ++tv) {
                const bf16x8v b0 = *(const LAS bf16x8v*)(VT + (16 * tv + fr) * 72 + 8 * fq), b1 = *(const LAS bf16x8v*)(VT + (16 * tv + fr) * 72 + 32 + 8 * fq);
                f32x4v acc = {0.f, 0.f, 0.f, 0.f};
                acc = __builtin_amdgcn_mfma_f32_16x16x32_bf16(a0, b0, acc, 0, 0, 0);
                acc = __builtin_amdgcn_mfma_f32_16x16x32_bf16(a1, b1, acc, 0, 0, 0);
                *(f32x4v*)(KV + (16 * tv + fr) * 64 + 16 * t4 + 4 * fq) = acc;
            }
        }
    }
    __syncthreads();
}

__device__ __forceinline__ void gla_scan_item(int idx, unsigned char* ws, int tid) {
    asm volatile("" : "+v"(tid));
    const int bh = idx >> 3, e = (idx & 7) * 512 + tid, d = e & 63;
    const float* KV = (const float*)(ws + WS_KV) + (size_t)bh * 128 * 4096 + e;
    const float* DEC = (const float*)(ws + WS_DEC) + (size_t)bh * 128 * 64 + d;
    bfr* ST = (bfr*)(ws + WS_ST) + (size_t)bh * 128 * 4096 + e;
    float s = 0.f;
#pragma unroll 16
    for (int n = 0; n < 128; ++n) { const float kvv = KV[(size_t)n * 4096], dc = DEC[n * 64]; ST[(size_t)n * 4096] = f2bf(s); s = dc * s + kvv; }
}
__device__ __forceinline__ void lru_out_item(int q, unsigned char* ws, LAS unsigned char* lds, int tid, int wid) {
    asm volatile("" : "+v"(tid), "+s"(wid));
    const int b = q / 96, rem = q % 96, n = rem / 16, cgp = rem % 16;
    const int ch = tid & 63, tg = wid, cg_ = n * 64 + ch;
    const float* SA = (const float*)(ws + WS_SUMA) + (size_t)b * LRU_NCH * 384 + cg_;
    const float* SH = (const float*)(ws + WS_SUMH) + (size_t)b * LRU_NCH * 384 + cg_;
    LAS float* COMP = (LAS float*)lds;
    {
        const int nprev = 4 * cgp;
        float pw = 1.f, hw = 0.f;
        for (int j = (tg * nprev) >> 3; j < ((tg + 1) * nprev) >> 3; ++j) { const float a = SA[j * 384], hh = SH[j * 384]; hw = a * hw + hh; pw *= a; }
        COMP[(tg * 2) * 64 + ch] = pw; COMP[(tg * 2 + 1) * 64 + ch] = hw;
    }
    __syncthreads();
    float carry = 0.f;
#pragma unroll
    for (int g = 0; g < 8; ++g) carry = COMP[(g * 2) * 64 + ch] * carry + COMP[(g * 2 + 1) * 64 + ch];
    const bfr* HL = (const bfr*)(ws + WS_HL); const bfr* AC = (const bfr*)(ws + WS_ACUM); const bfr* PROJ = (const bfr*)(ws + WS_PROJ); bfr* MIX = (bfr*)(ws + WS_MIX);
    for (int cc = 0; cc < 4; ++cc) {
        const int c = cgp * 4 + cc;
        const size_t m0 = (size_t)b * SEQ + c * LRU_LC + 16 * tg;
        const float sa = SA[c * 384], sh = SH[c * 384];
#pragma unroll
        for (int i = 0; i < 16; ++i) { const size_t m = m0 + i;
            const float hh = bf2f(HL[m * 384 + cg_]) + bf2f(AC[m * 384 + cg_]) * carry; const float y = bf2f(PROJ[m * NPROJ + C_LG + cg_]);
            MIX[m * DMIX + cg_] = f2bf(hh * gelu_tanh_(y)); }
        carry = sa * carry + sh;
    }
}
__device__ __forceinline__ void gla_out_item(int idx, const LayerPtrs& L, unsigned char* ws, int lane) {
    asm volatile("" : "+v"(lane));
    const int bh = idx >> 7, n = idx & 127, b = bh >> 2, h = bh & 3, fr = lane & 15, fq = lane >> 4;
    const size_t m0 = (size_t)b * SEQ + n * 64;
    const bfr* ST = (const bfr*)(ws + WS_ST) + (size_t)idx * 4096; const bfr* QDEC = (const bfr*)(ws + WS_QDEC); const bfr* OI = (const bfr*)(ws + WS_OINTRA);
    const bfr* PROJ = (const bfr*)(ws + WS_PROJ); bfr* MIX = (bfr*)(ws + WS_MIX);
    bf16x8v st[4][2];
#pragma unroll
    for (int tv = 0; tv < 4; ++tv)
#pragma unroll
        for (int ks = 0; ks < 2; ++ks) st[tv][ks] = *(const bf16x8v*)(ST + (16 * tv + fr) * 64 + 32 * ks + 8 * fq);
    f32x4v gn[4];
#pragma unroll
    for (int tv = 0; tv < 4; ++tv) gn[tv] = *(const f32x4v*)(L.ogain + 16 * tv + 4 * fq);
#pragma unroll
    for (int ti = 0; ti < 4; ++ti) {
        const size_t m = m0 + 16 * ti + fr;
        const bf16x8v q0 = *(const bf16x8v*)(QDEC + m * 256 + h * 64 + 8 * fq), q1 = *(const bf16x8v*)(QDEC + m * 256 + h * 64 + 32 + 8 * fq);
        f32x4v o[4]; float ss = 0.f;
#pragma unroll
        for (int tv = 0; tv < 4; ++tv) {
            f32x4v acc = {0.f, 0.f, 0.f, 0.f};
            acc = __builtin_amdgcn_mfma_f32_16x16x32_bf16(st[tv][0], q0, acc, 0, 0, 0);
            acc = __builtin_amdgcn_mfma_f32_16x16x32_bf16(st[tv][1], q1, acc, 0, 0, 0);
            const u32x2v w = *(const u32x2v*)(OI + m * 256 + h * 64 + 16 * tv + 4 * fq);
            acc[0] += __uint_as_float(w.x << 16); acc[1] += __uint_as_float(w.x & 0xffff0000u); acc[2] += __uint_as_float(w.y << 16); acc[3] += __uint_as_float(w.y & 0xffff0000u);
            o[tv] = acc; ss += (acc[0] * acc[0] + acc[1] * acc[1]) + (acc[2] * acc[2] + acc[3] * acc[3]);
        }
        ss += __shfl_xor(ss, 16); ss += __shfl_xor(ss, 32);
        const float rs = 1.0f / sqrtf(ss * (1.0f / 64.0f) + EPS);
#pragma unroll
        for (int tv = 0; tv < 4; ++tv) {
            const u32x2v gw = *(const u32x2v*)(PROJ + m * NPROJ + C_GG + h * 64 + 16 * tv + 4 * fq);
            const float g0 = __uint_as_float(gw.x << 16), g1 = __uint_as_float(gw.x & 0xffff0000u), g2 = __uint_as_float(gw.y << 16), g3 = __uint_as_float(gw.y & 0xffff0000u);
            u32x2v w; w.x = pk2(o[tv][0] * rs * gn[tv][0] * silu_(g0), o[tv][1] * rs * gn[tv][1] * silu_(g1)); w.y = pk2(o[tv][2] * rs * gn[tv][2] * silu_(g2), o[tv][3] * rs * gn[tv][3] * silu_(g3));
            *(u32x2v*)(MIX + m * DMIX + 768 + h * 64 + 16 * tv + 4 * fq) = w;
        }
    }
}

#define XB_TMO      128
#define XB_XCNT(j)  (256  + 64 * (j))
#define XB_XSUB(j)  (1280 + 64 * (j))
#define XB_XGEN(j)  (2304 + 64 * (j))
#define XB_TOP      3328
#define XB_TOPGEN   3392
#define XCD_BAR_WORDS 3456
#define XB_SPIN_CAP (1u << 18)

__device__ __forceinline__ unsigned xb_ld(unsigned* p)              { return __hip_atomic_load(p, __ATOMIC_RELAXED, __HIP_MEMORY_SCOPE_AGENT); }
__device__ __forceinline__ unsigned xb_add(unsigned* p, unsigned v) { return __hip_atomic_fetch_add(p, v, __ATOMIC_RELAXED, __HIP_MEMORY_SCOPE_AGENT); }
__device__ __forceinline__ unsigned xb_xcc_id() { return (unsigned)__builtin_amdgcn_s_getreg((3 << 11) | 20) & 0xFu; }
#define XB_SPIN(cond, bar) do { unsigned _sp = 0; while (cond) { __builtin_amdgcn_s_sleep(1); \
    if ((++_sp & 255u) == 0u) { if (xb_ld(&(bar)[XB_TMO])) break; if (_sp > XB_SPIN_CAP) { atomicAdd(&(bar)[XB_TMO], 1u); break; } } } } while (0)

struct XcdBarrier {
    unsigned* bar; unsigned x;
    volatile LAS unsigned* st;
};

__device__ __forceinline__ XcdBarrier xcd_barrier_post(unsigned* bar, volatile LAS unsigned* st) {
    XcdBarrier b; b.bar = bar; b.x = xb_xcc_id(); b.st = st;
    if (threadIdx.x == 0) (void)xb_add(&bar[XB_XCNT(b.x)], 1u);
    return b;
}
__device__ __forceinline__ void xcd_barrier_complete(unsigned* bar, unsigned x, unsigned& nloc, unsigned& nx) {
    const unsigned G = gridDim.x * gridDim.y * gridDim.z;
    unsigned sum, cnt, mine, sp = 0u;
    for (;;) {
        sum = 0u; cnt = 0u; mine = 0u;
#pragma unroll
        for (unsigned j = 0; j < 16; ++j) { const unsigned c = xb_ld(&bar[XB_XCNT(j)]); sum += c; cnt += (c > 0u) ? 1u : 0u; mine = (j == x) ? c : mine; }
        if (sum == G) break;
        __builtin_amdgcn_s_sleep(1);
        if ((++sp & 255u) == 0u) { if (xb_ld(&bar[XB_TMO])) break; if (sp > XB_SPIN_CAP) { atomicAdd(&bar[XB_TMO], 1u); break; } }
    }
    nloc = mine > 0u ? mine : 1u; nx = cnt > 0u ? cnt : 1u;
}

__device__ __forceinline__ void xcd_barrier(const XcdBarrier& b) {
    asm volatile("s_waitcnt vmcnt(0)" ::: "memory");
    __syncthreads();
    if (threadIdx.x == 0) {
        unsigned* bar = b.bar;
        __builtin_amdgcn_s_waitcnt(0);
        unsigned nloc = b.st[0], nx = b.st[1];
        if (nloc == 0u) { xcd_barrier_complete(bar, b.x, nloc, nx); b.st[0] = nloc; b.st[1] = nx; }
        const unsigned old = xb_add(&bar[XB_XSUB(b.x)], 1u);
        const unsigned gen = old / nloc;
        if (old + 1u == (gen + 1u) * nloc) {
            __builtin_amdgcn_fence(__ATOMIC_RELEASE, "agent");
            asm volatile("s_waitcnt vmcnt(0)" ::: "memory");
            const unsigned og = xb_add(&bar[XB_TOP], 1u);
            const unsigned tg = og / nx;
            if (og + 1u == (tg + 1u) * nx) xb_add(&bar[XB_TOPGEN], 1u);
            else XB_SPIN(xb_ld(&bar[XB_TOPGEN]) == tg, bar);
            __builtin_amdgcn_fence(__ATOMIC_ACQUIRE, "agent");
            xb_add(&bar[XB_XGEN(b.x)], 1u);
            asm volatile("s_waitcnt vmcnt(0)" ::: "memory");
        } else {
            XB_SPIN(xb_ld(&bar[XB_XGEN(b.x)]) == gen, bar);
            __builtin_amdgcn_fence(__ATOMIC_ACQUIRE, "agent");
            asm volatile("s_waitcnt vmcnt(0)" ::: "memory");
        }
    }
    __syncthreads();
}

#ifdef EXP_P2
#define EXP_KN_ONCE (rep_ == 0)
#else
#define EXP_KN_ONCE true
#endif
#define XBAR1() do { XcdBarrier b_; b_.bar = (unsigned*)P.ws + CW_BAR; b_.x = xb_xcc_id(); b_.st = (volatile LAS unsigned*)(lds + MISC_OFF + 32); xcd_barrier(b_); } while (0)
#ifdef EXP_SYNC
#define GSYNC() do { XBAR1(); XBAR1(); } while (0)
#else
#define GSYNC() XBAR1()
#endif
__global__ void __launch_bounds__(512, 2) hybrid_fwd(Params P) {
    extern __shared__ __attribute__((aligned(16))) unsigned char lds_raw[];
    cg::grid_group grid = cg::this_grid();
    LAS unsigned char* lds = (LAS unsigned char*)lds_raw;
    const int tid = threadIdx.x, lane = tid & 63, wid = __builtin_amdgcn_readfirstlane(tid >> 6);
    const int G = gridDim.x, gw = blockIdx.x * 8 + wid, NGW = G * 8;
    unsigned char* ws = P.ws;
    unsigned* ctl = (unsigned*)(ws + WS_CTL);
    volatile LAS int* slot = (volatile LAS int*)(lds + MISC_OFF);
    const float* MOD = (const float*)(ws + WS_MOD);
    bfr* XB = (bfr*)P.out;
    bfr* HN = (bfr*)(ws + WS_HN); bfr* PROJ = (bfr*)(ws + WS_PROJ); bfr* MIX = (bfr*)(ws + WS_MIX); bfr* GB = (bfr*)(ws + WS_PROJ);

    if (tid < 16) ((LAS unsigned*)(lds + MISC_OFF))[tid] = 0u;
    __syncthreads();
    (void)xcd_barrier_post(ctl + CW_BAR, (volatile LAS unsigned*)(lds + MISC_OFF + 32));
    p0_prologue(P, lds, tid, lane, wid, G);
#ifdef EXP_P0
    __syncthreads(); p0_prologue(P, lds, tid, lane, wid, G);
#endif
    grid.sync();

    for (int l = 0; l < DEPTH; ++l) {
        const float* modl = MOD + (size_t)l * NB * NMOD;
        bfr* XBm = l < DEPTH - 1 ? XB : (bfr*)(ws + WS_OINTRA);
        LayerPtrs L;
        L.conv_w = P.in[7] + (size_t)l * 4 * 384; L.conv_b = P.in[8] + (size_t)l * 384; L.b_r = P.in[10] + (size_t)l * 384; L.b_i = P.in[12] + (size_t)l * 384; L.lam = P.in[13] + (size_t)l * 384;
        L.fox_bf = P.in[14] + (size_t)l * 6; L.qgain = P.in[15] + (size_t)l * 64; L.kgain = P.in[16] + (size_t)l * 64;
        L.w_alpha = P.in[17] + (size_t)l * 16 * 256; L.b_alpha = P.in[18] + (size_t)l * 256; L.ogain = P.in[19] + (size_t)l * 64;
        L.lruw = (const bfr*)(ws + WS_LRUW) + (size_t)l * 6 * 2 * 4096;

        norm_phase(P.in[0], l == 0 ? (const bfr*)nullptr : XB, P.in[2] + (size_t)l * DMODEL, modl, 0, 1024, HN, gw, NGW, lane);
        GSYNC();
        {
            pg8::Gemm g{HN, (const bfr*)(ws + WS_WIN + l * WIN_L), MROWS, NPROJ, DMODEL}; pg8::StaticOrder S; S.init(MROWS, NPROJ, G, (int)blockIdx.x);
            pg8::EpiProj E{PROJ, NPROJ, L.qgain, L.kgain, C_FQ};
            pg8::gemm_phase<pg8::EpiProj, pg8::StaticOrder, PG8_ALIGN, PG8_SP2>(lds, g, S, E);
#ifdef EXP_G16
            __syncthreads(); pg8::gemm_phase<pg8::EpiBf16<0>, pg8::StaticOrder, PG8_ALIGN, PG8_SP2>(lds, g, S, E);
#endif
        }
        GSYNC();
        {
            constexpr int N_CUM = 24, N_GLA = 1024, N_LL = 6 * LRU_NCH * NB, N_KN = 0, N_P2 = N_CUM + N_GLA + N_LL + N_KN;
#ifdef EXP_P2
          for (int rep_ = 0; rep_ < 2; ++rep_) {
            unsigned* ctr = ctl + 64 * l + 16 + 8 * rep_;
#else
            unsigned* ctr = ctl + 64 * l + 16;
#endif
            int cur = blockIdx.x, itn = 0;
            while (cur < N_P2) {
                if (tid == 0) slot[itn & 1] = (int)atomicAdd(ctr, 1u) + G;
                if (cur < N_CUM) cum_item(cur, L, ws, lds, tid, lane, wid);
                else if (cur < N_CUM + N_GLA) gla_local_item(cur - N_CUM, L, ws, lds, tid, lane, wid);
                else if (cur < N_CUM + N_GLA + N_LL) lru_local_item(cur - N_CUM - N_GLA, L, ws, lds, tid, lane, wid);
                __syncthreads();
                cur = slot[itn & 1]; ++itn;
            }
#ifdef EXP_P2
            __syncthreads();
          }
#endif
        }
        GSYNC();
        {
            constexpr int N_ATT = 768, N_SCAN = 128, N_LRU = 384, N_GO = 256, N_ALL = N_ATT + N_SCAN + N_LRU + N_GO;
            unsigned* sdone = ctl + 64 * l + 48;
#ifdef EXP_P3
          for (int rep_ = 0; rep_ < 2; ++rep_) {
            unsigned* ctr = ctl + 64 * l + 32 * rep_;
#else
            unsigned* ctr = ctl + 64 * l;
#endif
            float skip_th;
            { int ln_ = lane; asm volatile("" : "+v"(ln_)); float gq = fabsf(L.qgain[ln_]), gk = fabsf(L.kgain[ln_]);
#pragma unroll
              for (int o = 1; o < 64; o <<= 1) { gq = fmaxf(gq, __shfl_xor(gq, o)); gk = fmaxf(gk, __shfl_xor(gk, o)); }
              skip_th = 150.0f + 2.0f * 11.7f * gq * gk; }
            int cur = blockIdx.x, itn = 0;
            while (cur < N_ALL) {
                if (tid == 0) slot[itn & 1] = (int)atomicAdd(ctr, 1u) + G;
                if (cur < N_SCAN) {
                    gla_scan_item(cur, ws, tid);
                    __syncthreads();
                    if (tid == 0) { __builtin_amdgcn_fence(__ATOMIC_RELEASE, "agent"); asm volatile("s_waitcnt vmcnt(0)" ::: "memory"); __hip_atomic_fetch_add(sdone + (cur >> 3), 1u, __ATOMIC_RELAXED, __HIP_MEMORY_SCOPE_AGENT); }
                } else if (cur < N_SCAN + N_ATT) {
                    const int ua = cur - N_SCAN; const int qb = 31 - ua / 24, bh = ua % 24, b = bh / 6, h = bh % 6;
                    attn_body::attn_unit<96>(b, h, qb, (const attn_body::bf16*)(PROJ + C_FQ), (const attn_body::bf16*)(PROJ + C_FK), (const attn_body::bf16*)(PROJ + C_FV), (attn_body::bf16*)(MIX + 384),
                                            (const float*)(ws + WS_CUM) + (size_t)bh * SEQ, L.qgain, skip_th, (char*)lds_raw);
                } else if (cur < N_SCAN + N_ATT + N_LRU) {
                    lru_out_item(cur - N_ATT - N_SCAN, ws, lds, tid, wid);
                } else {
                    const int gi = (cur - N_SCAN - N_ATT - N_LRU) * 8;
                    if (tid == 0) { unsigned sp = 0; while (__hip_atomic_load(sdone + (gi >> 7), __ATOMIC_RELAXED, __HIP_MEMORY_SCOPE_AGENT) < 8u) { __builtin_amdgcn_s_sleep(2); if (++sp > (1u << 22)) break; }
                        __builtin_amdgcn_fence(__ATOMIC_ACQUIRE, "agent"); asm volatile("s_waitcnt vmcnt(0)" ::: "memory"); }
                    __syncthreads();
                    gla_out_item(gi + wid, L, ws, lane);
                }
                __syncthreads();
                cur = slot[itn & 1]; ++itn;
            }
#ifdef EXP_P3
            __syncthreads();
          }
#endif
        }
        GSYNC();
        {
            pg8::Gemm g{MIX, (const bfr*)(ws + WS_WOUT + l * WOUT_L), MROWS, DMODEL, DMIX}; pg8::StaticOrder S; S.init(MROWS, DMODEL, G, (int)blockIdx.x);
            pg8::EpiResidB E{l == 0 ? P.in[0] : (const float*)nullptr, XB, XBm, (float*)nullptr, DMODEL, modl + 2048, NMOD, SEQ};
            pg8::gemm_phase<pg8::EpiResidB, pg8::StaticOrder, PG8_ALIGN, PG8_SP2>(lds, g, S, E);
        }
        GSYNC();
        norm_phase(P.in[0], XBm, P.in[3] + (size_t)l * DMODEL, modl, 3072, 4096, HN, gw, NGW, lane);
        GSYNC();
        {
            pg8::Gemm g{HN, (const bfr*)(ws + WS_WGU + l * WGU_L), MROWS, NGU, DMODEL}; pg8::StaticOrder S; S.init(MROWS, NGU, G, (int)blockIdx.x);
            pg8::EpiSwiGLU E{GB, DFF};
            pg8::gemm_phase<pg8::EpiSwiGLU, pg8::StaticOrder, PG8_ALIGN, PG8_SP2>(lds, g, S, E);
#ifdef EXP_G16
            __syncthreads(); pg8::gemm_phase<pg8::EpiSwiGLU, pg8::StaticOrder, PG8_ALIGN, PG8_SP2>(lds, g, S, E);
#endif
        }
        GSYNC();
        {
            pg8::Gemm g{GB, (const bfr*)(ws + WS_WDN + l * WDN_L), MROWS, DMODEL, DFF}; pg8::StaticOrder S; S.init(MROWS, DMODEL, G, (int)blockIdx.x);
            pg8::EpiResidB E{(const float*)nullptr, XBm, l < DEPTH - 1 ? XB : (bfr*)nullptr, l < DEPTH - 1 ? (float*)nullptr : P.out, DMODEL, modl + 5120, NMOD, SEQ};
            pg8::gemm_phase<pg8::EpiResidB, pg8::StaticOrder, PG8_ALIGN, PG8_SP2>(lds, g, S, E);
        }
        if (l < DEPTH - 1) GSYNC();
    }
}

extern "C" void kernel_launch(void* const* d_in, const int* in_sizes, int n_in, void* d_out, int out_size, void* d_ws, size_t ws_size, hipStream_t stream) {
    static int grid = 0;
    if (grid == 0) {
        if (n_in != 23 || out_size != MROWS * DMODEL || ws_size < WS_END) { fprintf(stderr, "kernel_launch: unexpected shapes (n_in %d out %d ws %zu)\n", n_in, out_size, ws_size); grid = -1; return; }
        int dev = 0, cus = 0, per_cu = 0;
        if (hipGetDevice(&dev) != hipSuccess || hipDeviceGetAttribute(&cus, hipDeviceAttributeMultiprocessorCount, dev) != hipSuccess) { grid = -1; return; }
        if (hipFuncSetAttribute((const void*)hybrid_fwd, hipFuncAttributeMaxDynamicSharedMemorySize, LDS_BYTES) != hipSuccess) { fprintf(stderr, "kernel_launch: hipFuncSetAttribute failed\n"); grid = -1; return; }
        if (hipOccupancyMaxActiveBlocksPerMultiprocessor(&per_cu, (const void*)hybrid_fwd, 512, LDS_BYTES) != hipSuccess || per_cu < 1) { fprintf(stderr, "kernel_launch: occupancy query says %d\n", per_cu); per_cu = 1; }
        (void)hipGetLastError();
        grid = cus;
    }
    if (grid < 0) return;
    (void)hipMemsetAsync((char*)d_ws + WS_CTL, 0, CTL_BYTES, stream);
    Params p{};
    for (int i = 0; i < 23; ++i) p.in[i] = (const float*)d_in[i];
    p.out = (float*)d_out; p.ws = (unsigned char*)d_ws;
    void* args[] = {&p};
    hipError_t e = hipLaunchCooperativeKernel((const void*)hybrid_fwd, dim3(grid), dim3(512), args, LDS_BYTES, stream);
    if (e != hipSuccess) fprintf(stderr, "kernel_launch: cooperative launch failed: %s (grid %d)\n", hipGetErrorString(e), grid);
}
```

```cpp
#include <hip/hip_runtime.h>
#include <hip/hip_cooperative_groups.h>
#include <hip/hip_bf16.h>
#include <cstdio>
#include <cstdint>
#include <cmath>
namespace cg = cooperative_groups;
namespace pg8 {
#define PG8_LAS __attribute__((address_space(3)))
typedef unsigned short bf16_t;
typedef short bf16x8 __attribute__((ext_vector_type(8)));
typedef float f32x4 __attribute__((ext_vector_type(4)));
typedef unsigned u32x4 __attribute__((ext_vector_type(4)));
constexpr int BM = 256, BK = 64, HALF = 128, HTB = HALF * BK * 2  , STAGE_BYTES = 8 * HTB, NXCD = 8, WGM = 8;

__host__ __device__ __forceinline__ int lds_byte(int r, int c) { const int st = (r >> 4) * 2 + (c >> 5), rr = r & 15, cc = c & 31, ob = rr * 64 + cc * 2; return st * 1024 + (ob ^ (((ob >> 9) & 1) << 5)); }
__host__ __device__ __forceinline__ void stage_rc(int b, int& R, int& C) { const int st = b / 1024, sb = b % 1024, swz = sb ^ (((sb >> 9) & 1) << 5); R = (st >> 1) * 16 + swz / 64; C = (st & 1) * 32 + (swz % 64) / 2; }
__host__ __device__ __forceinline__ int perm32(int rho) { const int n = rho >> 4, i = rho & 15; return 8 * (i >> 2) + 4 * n + (i & 3); }

struct Unit { int pm, pn; };
struct Gemm { const bf16_t* A; const bf16_t* Bt; int M, N, K; };

struct StaticOrder {
    int nM, nN, nwg, G, c;
    __host__ __device__ void init(int M, int N, int G_, int c_) { nM = M / BM; nN = N / BM; nwg = nM * nN; G = G_; c = c_; }
    __host__ __device__ bool next(int i, Unit& u) const {
        const long L = (long)i * G + c; if (L >= nwg) return false;
        int wgid = (int)L; { const int q = nwg / NXCD, r = nwg % NXCD, xcd = wgid % NXCD, off = wgid / NXCD; wgid = (xcd < r ? xcd * (q + 1) : r * (q + 1) + (xcd - r) * q) + off; }
        const int nig = WGM * nN, gid = wgid / nig, fm = gid * WGM, gsz = (nM - fm) < WGM ? (nM - fm) : WGM;
        u.pm = fm + ((wgid % nig) % gsz); u.pn = (wgid % nig) / gsz; return true;
    }
    __device__ __forceinline__ void a_ready(const Unit&) const {}
    __device__ __forceinline__ void done(const Unit&) const {}
};

__device__ __forceinline__ unsigned cvt_pk_bf16(float lo, float hi) { unsigned r; asm volatile("v_cvt_pk_bf16_f32 %0, %1, %2" : "=v"(r) : "v"(lo), "v"(hi)); return r; }
typedef float f32x2 __attribute__((ext_vector_type(2)));
__device__ __forceinline__ f32x2 gelu_pk(f32x2 v) {
    const f32x2 av = __builtin_elementwise_abs(v), d = av * 0.2316418882f + 1.0f;
    f32x2 t; t.x = __builtin_amdgcn_rcpf(d.x); t.y = __builtin_amdgcn_rcpf(d.y);
    f32x2 q = t * 0.5307027145f + (-0.7265760135f); q = q * t + 0.7107068705f; q = q * t + (-0.142248368f); q = q * t + 0.127414796f; q = q * t;
    const f32x2 s = (v * v) * (-0.72134752044f);
    f32x2 e; e.x = __builtin_amdgcn_exp2f(s.x); e.y = __builtin_amdgcn_exp2f(s.y);
    const f32x2 m = v * (q * e), r = v - m;
    f32x2 o; o.x = v.x < 0.f ? m.x : r.x; o.y = v.y < 0.f ? m.y : r.y; return o;
}

template <int ACT  > struct EpiBf16 {
    static constexpr bool PERM = true, AFTER_DRAIN = false; static_assert(ACT == 0 || ACT == 1, "EpiBf16: ACT is 0 (none) or 1 (gelu_pk)");
    bf16_t* O; int ldc; const float* bias; int split_cols; size_t split_stride; float scale0;
    __device__ __forceinline__ void operator()(const f32x4 (&acc)[2][2][4][2], const Unit& u, int wr, int wc, int fr, int fq) const {
        const int row0 = u.pm * BM + wr * 64 + fr; int colt = u.pn * BM; bf16_t* base = O;
        float sc = 1.f; if (split_cols) { const int t = colt / split_cols; base += (size_t)t * split_stride; colt -= t * split_cols; if (t == 0) sc = scale0; }
        const int col0 = colt + wc * 32 + 8 * fq, bcol0 = u.pn * BM + wc * 32 + 8 * fq;
        f32x4 bv[2][2];
#pragma unroll
        for (int bj = 0; bj < 2; ++bj)
#pragma unroll
            for (int n = 0; n < 2; ++n) bv[bj][n] = bias ? *(const f32x4*)(bias + bcol0 + bj * HALF + 4 * n) : (f32x4){0.f, 0.f, 0.f, 0.f};
#pragma unroll
        for (int ai = 0; ai < 2; ++ai)
#pragma unroll
            for (int m = 0; m < 4; ++m) { bf16_t* rowp = base + (size_t)(row0 + ai * HALF + m * 16) * ldc + col0;
#pragma unroll
                for (int bj = 0; bj < 2; ++bj) { f32x4 v0 = acc[ai][bj][m][0] + bv[bj][0], v1 = acc[ai][bj][m][1] + bv[bj][1];
                    if (ACT == 1) { f32x2 a = gelu_pk((f32x2){v0[0], v0[1]}), b = gelu_pk((f32x2){v0[2], v0[3]}), c = gelu_pk((f32x2){v1[0], v1[1]}), d = gelu_pk((f32x2){v1[2], v1[3]});
                        v0 = (f32x4){a.x, a.y, b.x, b.y}; v1 = (f32x4){c.x, c.y, d.x, d.y}; }
                    v0 = v0 * sc; v1 = v1 * sc; u32x4 w; w.x = cvt_pk_bf16(v0[0], v0[1]); w.y = cvt_pk_bf16(v0[2], v0[3]); w.z = cvt_pk_bf16(v1[0], v1[1]); w.w = cvt_pk_bf16(v1[2], v1[3]);
                    *(u32x4*)(rowp + bj * HALF) = w; } }
    }
};


struct EpiProj {
    static constexpr bool PERM = true, AFTER_DRAIN = false;
    bf16_t* O; int ldc; const float* qgain; const float* kgain; int cfq;
    __device__ __forceinline__ void operator()(const f32x4 (&acc)[2][2][4][2], const Unit& u, int wr, int wc, int fr, int fq) const {
        const int row0 = u.pm * BM + wr * 64 + fr;
        if (u.pn < 3 || u.pn > 5) {
            const int col0 = u.pn * BM + wc * 32 + 8 * fq;
#pragma unroll
            for (int ai = 0; ai < 2; ++ai)
#pragma unroll
                for (int m = 0; m < 4; ++m) { bf16_t* rowp = O + (size_t)(row0 + ai * HALF + m * 16) * ldc + col0;
#pragma unroll
                    for (int bj = 0; bj < 2; ++bj) { const f32x4 v0 = acc[ai][bj][m][0], v1 = acc[ai][bj][m][1];
                        u32x4 w; w.x = cvt_pk_bf16(v0[0], v0[1]); w.y = cvt_pk_bf16(v0[2], v0[3]); w.z = cvt_pk_bf16(v1[0], v1[1]); w.w = cvt_pk_bf16(v1[2], v1[3]);
                        *(u32x4*)(rowp + bj * HALF) = w; } }
        } else {
            const int H = 4 * (u.pn - 3) + wc;
            const float* gp = (H < 6 ? qgain : kgain) + 8 * fq; const float sc = H < 6 ? 0.125f * 1.4426950408889634f : 1.0f;
            f32x4 gv[2][2];
#pragma unroll
            for (int bj = 0; bj < 2; ++bj)
#pragma unroll
                for (int n = 0; n < 2; ++n) gv[bj][n] = *(const f32x4*)(gp + 32 * bj + 4 * n) * sc;
            const int col0 = cfq + H * 64 + 8 * fq;
#pragma unroll
            for (int ai = 0; ai < 2; ++ai)
#pragma unroll
                for (int m = 0; m < 4; ++m) { bf16_t* rowp = O + (size_t)(row0 + ai * HALF + m * 16) * ldc + col0;
                    float ss = 0.f;
#pragma unroll
                    for (int bj = 0; bj < 2; ++bj)
#pragma unroll
                        for (int n = 0; n < 2; ++n) { const f32x4 x = acc[ai][bj][m][n]; ss += (x[0] * x[0] + x[1] * x[1]) + (x[2] * x[2] + x[3] * x[3]); }
                    ss += __shfl_xor(ss, 16); ss += __shfl_xor(ss, 32);
                    const float rs = __builtin_amdgcn_rsqf(ss * (1.0f / 64.0f) + 1e-6f);
#pragma unroll
                    for (int bj = 0; bj < 2; ++bj) { const f32x4 v0 = acc[ai][bj][m][0] * rs * gv[bj][0], v1 = acc[ai][bj][m][1] * rs * gv[bj][1];
                        u32x4 w; w.x = cvt_pk_bf16(v0[0], v0[1]); w.y = cvt_pk_bf16(v0[2], v0[3]); w.z = cvt_pk_bf16(v1[0], v1[1]); w.w = cvt_pk_bf16(v1[2], v1[3]);
                        *(u32x4*)(rowp + 32 * bj) = w; } }
        }
    }
};
struct EpiSwiGLU {
    static constexpr bool PERM = true, AFTER_DRAIN = false;
    bf16_t* O; int ldc;
    __device__ __forceinline__ void operator()(const f32x4 (&acc)[2][2][4][2], const Unit& u, int wr, int wc, int fr, int fq) const {
        const int row0 = u.pm * BM + wr * 64 + fr; const int col0 = u.pn * HALF + wc * 32 + 8 * fq;
#pragma unroll
        for (int ai = 0; ai < 2; ++ai)
#pragma unroll
            for (int m = 0; m < 4; ++m) { bf16_t* rowp = O + (size_t)(row0 + ai * HALF + m * 16) * ldc + col0;
                float o[8];
#pragma unroll
                for (int n = 0; n < 2; ++n)
#pragma unroll
                    for (int j = 0; j < 4; ++j) { const float g = acc[ai][0][m][n][j], up = acc[ai][1][m][n][j];
                        const float sg = g * __builtin_amdgcn_rcpf(1.0f + __builtin_amdgcn_exp2f(-1.4426950408889634f * g)); o[n * 4 + j] = sg * up; }
                u32x4 w; w.x = cvt_pk_bf16(o[0], o[1]); w.y = cvt_pk_bf16(o[2], o[3]); w.z = cvt_pk_bf16(o[4], o[5]); w.w = cvt_pk_bf16(o[6], o[7]);
                *(u32x4*)rowp = w; }
    }
};
struct EpiResid {
    static constexpr bool PERM = false, AFTER_DRAIN = false;
    const float* base; float* out; int ldc; const float* gate; int gstride; int rows_per_batch;
    __device__ __forceinline__ void operator()(const f32x4 (&acc)[2][2][4][2], const Unit& u, int wr, int wc, int fr, int fq) const {
        const int col0 = u.pn * BM + wc * 32 + 4 * fq;
        const float* gp = gate + (size_t)((u.pm * BM) / rows_per_batch) * gstride + col0;
        f32x4 gv[2][2];
#pragma unroll
        for (int bj = 0; bj < 2; ++bj)
#pragma unroll
            for (int n = 0; n < 2; ++n) gv[bj][n] = *(const f32x4*)(gp + bj * HALF + n * 16);
#pragma unroll
        for (int ai = 0; ai < 2; ++ai)
#pragma unroll
            for (int m = 0; m < 4; ++m) { const size_t off = (size_t)(u.pm * BM + ai * HALF + wr * 64 + m * 16 + fr) * ldc + col0;
#pragma unroll
                for (int bj = 0; bj < 2; ++bj)
#pragma unroll
                    for (int n = 0; n < 2; ++n) { const f32x4 bs = *(const f32x4*)(base + off + bj * HALF + n * 16);
                        *(f32x4*)(out + off + bj * HALF + n * 16) = bs + gv[bj][n] * acc[ai][bj][m][n]; } }
    }
};


typedef _Float16 h16x2 __attribute__((ext_vector_type(2)));
__device__ __forceinline__ f32x2 h2f(unsigned w) { return __builtin_convertvector(__builtin_bit_cast(h16x2, w), f32x2); }
__device__ __forceinline__ unsigned f2h(float lo, float hi) { f32x2 v = {lo, hi}; return __builtin_bit_cast(unsigned, __builtin_convertvector(v, h16x2)); }
struct EpiResidB {
    static constexpr bool PERM = true, AFTER_DRAIN = false;
    const float* base32; const bf16_t* base16; bf16_t* out16; float* out32; int ldc; const float* gate; int gstride; int rows_per_batch;
    __device__ __forceinline__ void operator()(const f32x4 (&acc)[2][2][4][2], const Unit& u, int wr, int wc, int fr, int fq) const {
        const int row0 = u.pm * BM + wr * 64 + fr; const int col0 = u.pn * BM + wc * 32 + 8 * fq;
        const float* gp = gate + (size_t)((u.pm * BM) / rows_per_batch) * gstride + col0;
        f32x4 gv[2][2];
#pragma unroll
        for (int bj = 0; bj < 2; ++bj)
#pragma unroll
            for (int n = 0; n < 2; ++n) gv[bj][n] = *(const f32x4*)(gp + bj * HALF + 4 * n);
#pragma unroll
        for (int ai = 0; ai < 2; ++ai)
#pragma unroll
            for (int m = 0; m < 4; ++m) { const size_t off = (size_t)(row0 + ai * HALF + m * 16) * ldc + col0;
#pragma unroll
                for (int bj = 0; bj < 2; ++bj) {
                    f32x4 b0, b1;
                    if (base32) { b0 = *(const f32x4*)(base32 + off + bj * HALF); b1 = *(const f32x4*)(base32 + off + bj * HALF + 4); }
                    else { const u32x4 w = *(const u32x4*)(base16 + off + bj * HALF);
                        const f32x2 p0 = h2f(w.x), p1 = h2f(w.y), p2 = h2f(w.z), p3 = h2f(w.w);
                        b0 = (f32x4){p0.x, p0.y, p1.x, p1.y}; b1 = (f32x4){p2.x, p2.y, p3.x, p3.y}; }
                    const f32x4 v0 = b0 + gv[bj][0] * acc[ai][bj][m][0], v1 = b1 + gv[bj][1] * acc[ai][bj][m][1];
                    if (out32) { *(f32x4*)(out32 + off + bj * HALF) = v0; *(f32x4*)(out32 + off + bj * HALF + 4) = v1; }
                    else { u32x4 w; w.x = f2h(v0[0], v0[1]); w.y = f2h(v0[2], v0[3]); w.z = f2h(v1[0], v1[1]); w.w = f2h(v1[2], v1[3]); *(u32x4*)(out16 + off + bj * HALF) = w; } } }
    }
};

template <class Epi, class Sched, bool ALIGN_EPI = false, bool SP2 = false>
__device__ __forceinline__ void gemm_phase(PG8_LAS unsigned char* lds, const Gemm g, const Sched& S, const Epi& E) {
    int tid = threadIdx.x; asm volatile("" : "+v"(tid)); const int wid = __builtin_amdgcn_readfirstlane(tid >> 6), lane = tid & 63, wr = wid >> 2, wc = wid & 3, fr = lane & 15, fq = lane >> 4;
    const int K = g.K, nt = K / BK;
    unsigned voffA[2], voffB[2];
#pragma unroll
    for (int i = 0; i < 2; ++i) { int R, C; stage_rc(tid * 16 + i * 8192, R, C); const int Rb = Epi::PERM ? ((R & ~31) + perm32(R & 31)) : R;
        voffA[i] = (unsigned)(R * K + C) * 2u; voffB[i] = (unsigned)(Rb * K + C) * 2u; }
    const size_t kstep = (size_t)(BK * 2);
    const size_t hstep = (size_t)HALF * K * 2;
    const size_t tstep = 2 * hstep;
    const unsigned ldsw = (unsigned)wid * 1024u;
    const int aoff = lds_byte(wr * 64 + fr, fq * 8), boff = lds_byte(wc * 32 + fr, fq * 8);
#define PG8_SA(b, h) (((b) * 2 + (h)) * HTB)
#define PG8_SB(b, h) ((4 + (b) * 2 + (h)) * HTB)
#define PG8_STAGE(bufoff, gbase, voff) do { _Pragma("unroll") for (int _i = 0; _i < 2; ++_i) \
        __builtin_amdgcn_global_load_lds((const unsigned*)((const char*)(gbase) + (voff)[_i]), (PG8_LAS unsigned*)(lds + (bufoff) + ldsw + _i * 8192), 16, 0, 0); } while (0)
#define PG8_LDA(dst, b, h) do { _Pragma("unroll") for (int m = 0; m < 4; ++m) _Pragma("unroll") for (int k = 0; k < 2; ++k) dst[m][k] = *(const PG8_LAS bf16x8*)(lds + PG8_SA(b, h) + aoff + m * 2048 + k * 1024); } while (0)
#define PG8_LDB(dst, b, h) do { _Pragma("unroll") for (int n = 0; n < 2; ++n) _Pragma("unroll") for (int k = 0; k < 2; ++k) dst[n][k] = *(const PG8_LAS bf16x8*)(lds + PG8_SB(b, h) + boff + n * 2048 + k * 1024); } while (0)
#define PG8_MMA(ai, bj, At, Bt) do { __builtin_amdgcn_s_setprio(1); _Pragma("unroll") for (int m = 0; m < 4; ++m) _Pragma("unroll") for (int n = 0; n < 2; ++n) _Pragma("unroll") for (int k = 0; k < 2; ++k) \
        acc[ai][bj][m][n] = __builtin_amdgcn_mfma_f32_16x16x32_bf16(Bt[n][k], At[m][k], acc[ai][bj][m][n], 0, 0, 0); __builtin_amdgcn_s_setprio(0); } while (0)
#define PG8_WAIT_V(n) asm volatile("s_waitcnt vmcnt(" #n ")" ::: "memory")
#define PG8_WAIT_L(n) asm volatile("s_waitcnt lgkmcnt(" #n ")" ::: "memory")
#define PG8_BAR __builtin_amdgcn_s_barrier()
#define PG8_SCHED __builtin_amdgcn_sched_barrier(0)
    Unit cur, nxt; int ui = 0;
    if (!S.next(0, cur)) return;
    f32x4 acc[2][2][4][2];
#pragma unroll
    for (int a = 0; a < 2; ++a)
#pragma unroll
        for (int b = 0; b < 2; ++b)
#pragma unroll
            for (int m = 0; m < 4; ++m)
#pragma unroll
                for (int n = 0; n < 2; ++n) acc[a][b][m][n] = (f32x4){0.f, 0.f, 0.f, 0.f};
    bf16x8 At[4][2], B0[2][2], B1[2][2];
    const char* cA = (const char*)g.A + (size_t)cur.pm * tstep; const char* cB = (const char*)g.Bt + (size_t)cur.pn * tstep;
    S.a_ready(cur);
    if constexpr (SP2) {
        PG8_STAGE(PG8_SB(0, 0), cB, voffB); PG8_STAGE(PG8_SB(0, 1), cB + hstep, voffB); PG8_STAGE(PG8_SA(0, 0), cA, voffA); PG8_STAGE(PG8_SA(0, 1), cA + hstep, voffA);
        if (wr == 1) PG8_BAR;
        PG8_WAIT_V(2); PG8_BAR;
        PG8_STAGE(PG8_SB(1, 0), cB + kstep, voffB); PG8_STAGE(PG8_SA(1, 0), cA + kstep, voffA); PG8_STAGE(PG8_SB(1, 1), cB + hstep + kstep, voffB);
        PG8_WAIT_V(6); PG8_BAR;
    } else {
        PG8_STAGE(PG8_SB(0, 0), cB, voffB); PG8_STAGE(PG8_SA(0, 0), cA, voffA); PG8_STAGE(PG8_SB(0, 1), cB + hstep, voffB); PG8_STAGE(PG8_SA(0, 1), cA + hstep, voffA);
        if (wr == 1) PG8_BAR;
        PG8_WAIT_V(4); PG8_BAR;
        PG8_STAGE(PG8_SB(1, 0), cB + kstep, voffB); PG8_STAGE(PG8_SA(1, 0), cA + kstep, voffA); PG8_STAGE(PG8_SB(1, 1), cB + hstep + kstep, voffB);
        PG8_WAIT_V(6); PG8_BAR;
    }
    for (;;) {
        const bool has_next = S.next(ui + 1, nxt);
        const char* nA = has_next ? (const char*)g.A + (size_t)nxt.pm * tstep : cA; const char* nB = has_next ? (const char*)g.Bt + (size_t)nxt.pn * tstep : cB;
        for (int t = 0; t < nt; t += 2) {
            const bool last = (t == nt - 2);
            const char* a1 = cA + (size_t)(t + 1) * kstep;
            const char* a2 = last ? nA : cA + (size_t)(t + 2) * kstep; const char* b2 = last ? nB : cB + (size_t)(t + 2) * kstep;
            const char* a3 = a2 + kstep; const char* b3 = b2 + kstep;
            if (last && has_next) S.a_ready(nxt);
            if constexpr (SP2) {
            PG8_LDB(B0, 0, 0); PG8_LDB(B1, 0, 1); PG8_SCHED; PG8_LDA(At, 0, 0); PG8_STAGE(PG8_SA(1, 1), a1 + hstep, voffA);
            PG8_WAIT_V(8); PG8_WAIT_L(0); PG8_BAR; PG8_MMA(0, 0, At, B0); PG8_MMA(0, 1, At, B1); PG8_BAR; PG8_SCHED;
            PG8_LDA(At, 0, 1); PG8_STAGE(PG8_SB(0, 0), b2, voffB); PG8_STAGE(PG8_SB(0, 1), b2 + hstep, voffB); PG8_STAGE(PG8_SA(0, 0), a2, voffA);
            PG8_WAIT_V(8); PG8_WAIT_L(0); PG8_BAR; PG8_MMA(1, 0, At, B0); PG8_MMA(1, 1, At, B1); PG8_BAR; PG8_SCHED;
            PG8_LDB(B0, 1, 0); PG8_LDB(B1, 1, 1); PG8_SCHED; PG8_LDA(At, 1, 0); PG8_STAGE(PG8_SA(0, 1), a2 + hstep, voffA);
            PG8_WAIT_V(8); PG8_WAIT_L(0); PG8_BAR; PG8_MMA(0, 0, At, B0); PG8_MMA(0, 1, At, B1); PG8_BAR; PG8_SCHED;
            PG8_LDA(At, 1, 1); PG8_STAGE(PG8_SB(1, 0), b3, voffB); PG8_STAGE(PG8_SB(1, 1), b3 + hstep, voffB); PG8_STAGE(PG8_SA(1, 0), a3, voffA);
            PG8_WAIT_V(8); PG8_WAIT_L(0); PG8_BAR; PG8_MMA(1, 0, At, B0); PG8_MMA(1, 1, At, B1); PG8_BAR; PG8_SCHED;
            } else {
            PG8_LDB(B0, 0, 0); PG8_SCHED; PG8_LDA(At, 0, 0); PG8_STAGE(PG8_SA(1, 1), a1 + hstep, voffA);
            PG8_WAIT_L(8); PG8_BAR; PG8_WAIT_L(0); PG8_MMA(0, 0, At, B0); PG8_BAR; PG8_SCHED;
            PG8_LDB(B1, 0, 1); PG8_STAGE(PG8_SB(0, 0), b2, voffB);
            PG8_BAR; PG8_WAIT_L(0); PG8_MMA(0, 1, At, B1); PG8_BAR;
            PG8_LDA(At, 0, 1); PG8_STAGE(PG8_SA(0, 0), a2, voffA);
            PG8_BAR; PG8_WAIT_L(0); PG8_MMA(1, 0, At, B0); PG8_BAR; PG8_SCHED;
            PG8_STAGE(PG8_SB(0, 1), b2 + hstep, voffB);
            PG8_WAIT_V(6); PG8_BAR; PG8_MMA(1, 1, At, B1); PG8_BAR;
            PG8_LDB(B0, 1, 0); PG8_SCHED; PG8_LDA(At, 1, 0); PG8_STAGE(PG8_SA(0, 1), a2 + hstep, voffA);
            PG8_WAIT_L(8); PG8_BAR; PG8_WAIT_L(0); PG8_MMA(0, 0, At, B0); PG8_BAR; PG8_SCHED;
            PG8_LDB(B1, 1, 1); PG8_STAGE(PG8_SB(1, 0), b3, voffB);
            PG8_BAR; PG8_WAIT_L(0); PG8_MMA(0, 1, At, B1); PG8_BAR;
            PG8_LDA(At, 1, 1); PG8_STAGE(PG8_SA(1, 0), a3, voffA);
            PG8_BAR; PG8_WAIT_L(0); PG8_MMA(1, 0, At, B0); PG8_BAR; PG8_SCHED;
            PG8_STAGE(PG8_SB(1, 1), b3 + hstep, voffB);
            PG8_WAIT_V(6); PG8_BAR; PG8_MMA(1, 1, At, B1); PG8_BAR;
            }
        }
        if constexpr (ALIGN_EPI) { if (wr == 0) PG8_BAR; }
        if constexpr (!Epi::AFTER_DRAIN) { E(acc, cur, wr, wc, fr, fq); S.done(cur); }
        if (!has_next) break;
#pragma unroll
        for (int a = 0; a < 2; ++a)
#pragma unroll
            for (int b = 0; b < 2; ++b)
#pragma unroll
                for (int m = 0; m < 4; ++m)
#pragma unroll
                    for (int n = 0; n < 2; ++n) acc[a][b][m][n] = (f32x4){0.f, 0.f, 0.f, 0.f};
        cur = nxt; cA = nA; cB = nB; ++ui;
        if constexpr (ALIGN_EPI) { if (wr == 1) PG8_BAR; }
    }
    PG8_WAIT_V(0);
    if constexpr (!ALIGN_EPI) { if (wr == 0) PG8_BAR; }
    PG8_BAR;
    if constexpr (Epi::AFTER_DRAIN) { E.fused(acc, cur, wr, wc, fr, fq, lds, wid, lane); S.done(cur); }
#undef PG8_SA
#undef PG8_SB
#undef PG8_STAGE
#undef PG8_LDA
#undef PG8_LDB
#undef PG8_MMA
#undef PG8_WAIT_V
#undef PG8_WAIT_L
#undef PG8_BAR
#undef PG8_SCHED
}
}

#ifndef PG8_SP2
#define PG8_SP2 true
#endif
#ifndef PG8_ALIGN
#define PG8_ALIGN true
#endif
#include <hip/hip_bf16.h>
#include <cmath>
namespace attn_body {
using bf16=__hip_bfloat16;
using bf16x8=__attribute__((ext_vector_type(8)))short;
using s16x4=__attribute__((ext_vector_type(4)))short;
using f32x16=__attribute__((ext_vector_type(16)))float;
using u32x4=__attribute__((ext_vector_type(4)))unsigned;
constexpr int BATCH=4,NHEAD=6,SEQ=8192,D=64,DM=3072,ODM=1024;
constexpr int NW=8,QBLK=32,QB=QBLK*NW,KVBLK=64,NQB=SEQ/QB;
constexpr int ATTN_PITCH=DM, ATTN_UNIT_ROWS=QB;
__device__ __forceinline__ int crow(int r,int hi){return (r&3)+8*(r>>2)+4*hi;}
#define SBAR() __builtin_amdgcn_sched_barrier(0)
__device__ __forceinline__ void cmask(f32x16&p0,f32x16&p1,int jb,int qrel,int hi){
  const float NEG=-INFINITY; int kb=64*jb+4*hi;
  #pragma unroll
  for(int r=0;r<16;++r){int kv=kb+(r&3)+8*(r>>2); if(kv>qrel)p0[r]=NEG; if(kv+32>qrel)p1[r]=NEG;}
}

constexpr int NSLOT=3, SLOTB=8192;
constexpr int LDS_K=0, LDS_V=NSLOT*SLOTB, LDS_WS=2*NSLOT*SLOTB, LDS_OST=LDS_WS+NW*64*4, LDS_CKS=LDS_OST+NW*4096, LDS_BYTES=LDS_CKS+SEQ*4;
constexpr float C2=0.125f*1.4426950408889634f;
__device__ __forceinline__ void glds16(const void*gsrc,unsigned lds_dst){unsigned keep;
  asm volatile("s_mov_b32 %0, m0\n\ts_mov_b32 m0, %2\n\ts_nop 0\n\tglobal_load_lds_dwordx4 %1, off\n\ts_mov_b32 m0, %0":"=&s"(keep):"v"(gsrc),"s"(lds_dst):"memory");}
__device__ __forceinline__ float max3f(float a,float b,float c){float r;asm("v_max3_f32 %0, %1, %2, %3":"=v"(r):"v"(a),"v"(b),"v"(c));return r;}
__device__ __forceinline__ float max2f(float a,float b){float r;asm("v_max_f32_e32 %0, %1, %2":"=v"(r):"v"(a),"v"(b));return r;}
__device__ __forceinline__ float fadd_s(float a,float b){float r;asm("v_add_f32_e32 %0, %1, %2":"=v"(r):"v"(a),"v"(b));return r;}
__device__ __forceinline__ float fsub_s(float a,float b){float r;asm("v_sub_f32_e32 %0, %1, %2":"=v"(r):"v"(a),"v"(b));return r;}
typedef float f32x2_t __attribute__((ext_vector_type(2))); typedef __bf16 bf16x2_t __attribute__((ext_vector_type(2)));
__device__ __forceinline__ unsigned cvtpk_s(float lo,float hi){f32x2_t v={lo,hi};bf16x2_t b=__builtin_convertvector(v,bf16x2_t);return __builtin_bit_cast(unsigned,b);}
#define WAIT_BAR(N) asm volatile("s_waitcnt vmcnt(" #N ") lgkmcnt(0)\n\ts_barrier":::"memory")

__device__ __forceinline__ void qkt(f32x16&p0,f32x16&p1,const char*Kslot,const bf16x8*qr,const f32x16&negm,int r32,int hi){
  const char*kb=Kslot+hi*1024+r32*16;
  #pragma unroll
  for(int d0=0;d0<4;++d0){
    const bf16x8 b0=*reinterpret_cast<const bf16x8*>(kb+d0*2048);
    const bf16x8 b1=*reinterpret_cast<const bf16x8*>(kb+d0*2048+512);
    if(d0==0){p0=__builtin_amdgcn_mfma_f32_32x32x16_bf16(b0,qr[0],negm,0,0,0);p1=__builtin_amdgcn_mfma_f32_32x32x16_bf16(b1,qr[0],negm,0,0,0);}
    else{p0=__builtin_amdgcn_mfma_f32_32x32x16_bf16(b0,qr[d0],p0,0,0,0);p1=__builtin_amdgcn_mfma_f32_32x32x16_bf16(b1,qr[d0],p1,0,0,0);}}
}
typedef __attribute__((address_space(3))) const char* lds_cptr;
typedef short v4i16_t __attribute__((ext_vector_type(4)));
__device__ __forceinline__ void kload8(bf16x8*kf,lds_cptr kp){
  kf[0]=*(const __attribute__((address_space(3))) bf16x8*)(kp);      kf[1]=*(const __attribute__((address_space(3))) bf16x8*)(kp+512);
  kf[2]=*(const __attribute__((address_space(3))) bf16x8*)(kp+2048); kf[3]=*(const __attribute__((address_space(3))) bf16x8*)(kp+2560);
  kf[4]=*(const __attribute__((address_space(3))) bf16x8*)(kp+4096); kf[5]=*(const __attribute__((address_space(3))) bf16x8*)(kp+4608);
  kf[6]=*(const __attribute__((address_space(3))) bf16x8*)(kp+6144); kf[7]=*(const __attribute__((address_space(3))) bf16x8*)(kp+6656);
}
__device__ __forceinline__ void kload2(bf16x8*kf,lds_cptr kp,int j){ kf[2*j]=*(const __attribute__((address_space(3))) bf16x8*)(kp+j*2048); kf[2*j+1]=*(const __attribute__((address_space(3))) bf16x8*)(kp+j*2048+512); }
__device__ __forceinline__ s16x4 vtr(lds_cptr p){ return __builtin_bit_cast(s16x4,__builtin_amdgcn_ds_read_tr16_b64_v4i16((__attribute__((address_space(3))) v4i16_t*)p)); }
__device__ __forceinline__ float rowmax(const f32x16&p0,const f32x16&p1){
  float a=max3f(p0[0],p0[1],p1[0]),b=max3f(p0[2],p0[3],p1[1]);a=max3f(a,p1[2],p1[3]);
  #pragma unroll
  for(int r=4;r<16;r+=4){a=max3f(a,p0[r],p0[r+1]);b=max3f(b,p0[r+2],p0[r+3]);a=max3f(a,p1[r],p1[r+1]);b=max3f(b,p1[r+2],p1[r+3]);}
  const float m=max2f(a,b);
  auto rr=__builtin_amdgcn_permlane32_swap(__float_as_uint(m),__float_as_uint(m),false,false);
  return max2f(__uint_as_float(rr[0]),__uint_as_float(rr[1]));
}
__device__ __forceinline__ void pv(f32x16*o,int vb,bf16x8 pa0,bf16x8 pa1,bf16x8 pa2,bf16x8 pa3){
  #pragma unroll
  for(int d0=0;d0<2;++d0){s16x4 lo[4],hi[4];
    #pragma unroll
    for(int ks=0;ks<4;++ks){
      asm volatile("ds_read_b64_tr_b16 %0,%1 offset:%c2":"=&v"(lo[ks]):"v"(vb),"i"(d0*4096+ks*1024):"memory");
      asm volatile("ds_read_b64_tr_b16 %0,%1 offset:%c2":"=&v"(hi[ks]):"v"(vb),"i"(d0*4096+ks*1024+512):"memory");}
    asm volatile("s_waitcnt lgkmcnt(0)":::"memory");SBAR();
    #define PK(k) (bf16x8){lo[k][0],lo[k][1],lo[k][2],lo[k][3],hi[k][0],hi[k][1],hi[k][2],hi[k][3]}
    o[d0]=__builtin_amdgcn_mfma_f32_32x32x16_bf16(pa0,PK(0),o[d0],0,0,0);
    o[d0]=__builtin_amdgcn_mfma_f32_32x32x16_bf16(pa1,PK(1),o[d0],0,0,0);
    o[d0]=__builtin_amdgcn_mfma_f32_32x32x16_bf16(pa2,PK(2),o[d0],0,0,0);
    o[d0]=__builtin_amdgcn_mfma_f32_32x32x16_bf16(pa3,PK(3),o[d0],0,0,0);
    #undef PK
  }
}

#ifndef ATTN_STORE16
#define ATTN_STORE16(p,v) (*(u32x4*)(p)=(v))
#endif
template<int THRL> __device__ __forceinline__ void attn_unit(int b,int h,int qb,const bf16*Q,const bf16*__restrict__ K,const bf16*__restrict__ V,bf16*O,const float*__restrict__ CUMh,const float*__restrict__ qgain,const float skip_th,char*shm){
  int tid=threadIdx.x; asm volatile("":"+v"(tid)); const int lane=tid&63,r32=lane&31,hi=lane>>5; const int wid=__builtin_amdgcn_readfirstlane(tid>>6);
  const long rowbase=(long)b*SEQ; const int q0=qb*QB;
  const bf16*Qw=Q+(rowbase+q0+wid*QBLK)*DM+h*D;
  const bf16*Kh=K+rowbase*DM+h*D,*Vh=V+rowbase*DM+h*D;
  const float cref=CUMh[q0]; int ts=0;
  { const int tmax=(q0+QB)/KVBLK-4;
    for(int t0=0;t0<tmax;t0+=64){ const int t=t0+lane; bool sk=false; if(t<tmax) sk=(CUMh[64*t+63]-cref)*1.4426950408889634f>skip_th; ts+=__popcll(__ballot(sk)); }
    ts=__builtin_amdgcn_readfirstlane(ts)&~1; }
  Kh+=(long)ts*KVBLK*DM; Vh+=(long)ts*KVBLK*DM;
  const unsigned lds0=(unsigned)(uintptr_t)shm;
  float*wsf=(float*)(shm+LDS_WS)+wid*64;
  const bf16*ksrc=Kh+(long)lane*DM+wid*8;
  const bf16*vsrc=Vh+(long)(16*(wid&3)+(lane>>2))*DM+(wid>>2)*32+(lane&3)*8;
  const unsigned kdst=lds0+LDS_K+wid*1024, vdst=lds0+LDS_V+wid*1024;
  #define DMA_K(t,slot) glds16(ksrc+(long)(t)*KVBLK*DM,(unsigned)__builtin_amdgcn_readfirstlane(kdst+(slot)))
  #define DMA_V(t,slot) glds16(vsrc+(long)(t)*KVBLK*DM,(unsigned)__builtin_amdgcn_readfirstlane(vdst+(slot)))
  const int vb0=(int)(lds0+LDS_V)+((lane>>4)&1)*32+(lane&3)*8+(4*hi+((lane&15)>>2))*64;
  const char*Kbase=shm+LDS_K; bf16x8 kf[8];
  const lds_cptr shm3=(lds_cptr)shm; const lds_cptr kp0=shm3+LDS_K+hi*1024+r32*16; const lds_cptr vp0=shm3+LDS_V+((lane>>4)&1)*32+(lane&3)*8+(4*hi+((lane&15)>>2))*64;
  const int NT=(q0+QB)/KVBLK-ts;
  DMA_K(0,0);DMA_V(0,0);DMA_K(1,SLOTB);
  bf16x8 qr[4];
  #pragma unroll
  for(int d0=0;d0<4;++d0)qr[d0]=*reinterpret_cast<const bf16x8*>(&Qw[(long)r32*DM+d0*16+hi*8]);
  {
    __attribute__((address_space(3))) float*ckw=(__attribute__((address_space(3))) float*)(shm3+LDS_CKS); const int nkv=q0+QB-ts*KVBLK; const float*cums=CUMh+ts*KVBLK;
    for(int i=tid*4;i<nkv;i+=NW*64*4){ const float4 c4=*reinterpret_cast<const float4*>(cums+i);
      ckw[i]=(c4.x-cref)*1.4426950408889634f; ckw[i+1]=(c4.y-cref)*1.4426950408889634f; ckw[i+2]=(c4.z-cref)*1.4426950408889634f; ckw[i+3]=(c4.w-cref)*1.4426950408889634f; }
  }
  float mhat=0.f,l_reg=0.f;f32x16 o[2];o[0]=f32x16{};o[1]=f32x16{};f32x16 negm=f32x16{};asm volatile("":"+v"(negm));
  const int qrel=wid*QBLK+r32;
  #define CMASK(P0,P1,t) do{int jb_=(t)-(NT-4); if(jb_>=0)cmask(P0,P1,jb_,qrel,hi);}while(0)
  bool resc=false;
  #define START(P0,P1) do{ const float rm=rowmax(P0,P1); resc=false; \
    { const float dl=rm; mhat=fadd_s(mhat,dl); \
      _Pragma("unroll") for(int r=0;r<16;++r){P0[r]=fsub_s(P0[r],dl);P1[r]=fsub_s(P1[r],dl);} \
      _Pragma("unroll") for(int r=0;r<16;++r)negm[r]=-mhat; asm volatile("":"+v"(negm)); } \
    _Pragma("unroll") for(int r=0;r<16;++r)P0[r]=__builtin_amdgcn_exp2f(P0[r]); }while(0)
  #define RESC() do{ if(resc){ asm volatile("s_waitcnt lgkmcnt(0)":::"memory"); \
      _Pragma("unroll") for(int d_=0;d_<2;++d_) _Pragma("unroll") for(int r=0;r<16;++r)o[d_][r]*=wsf[crow(r,hi)]; } }while(0)
  typedef float f32x4_t __attribute__((ext_vector_type(4)));
  #define BIAS(P0,P1,t) do{ const __attribute__((address_space(3))) float*ck_=(const __attribute__((address_space(3))) float*)(shm3+LDS_CKS)+(t)*64+4*hi; \
    _Pragma("unroll") for(int g_=0;g_<4;++g_){ const f32x4_t a_=*(const __attribute__((address_space(3))) f32x4_t*)(ck_+8*g_), b_=*(const __attribute__((address_space(3))) f32x4_t*)(ck_+32+8*g_); \
      _Pragma("unroll") for(int j_=0;j_<4;++j_){ float t0_=P0[4*g_+j_]-a_[j_]; asm volatile("":"+v"(t0_)); P0[4*g_+j_]=t0_; float t1_=P1[4*g_+j_]-b_[j_]; asm volatile("":"+v"(t1_)); P1[4*g_+j_]=t1_; } } }while(0)
  f32x16 pA0,pA1,pB0,pB1;
  int sl_prev=0,sl_cur=0,sl_next=SLOTB;
  #define ROT() do{sl_prev=sl_cur;sl_cur=sl_next;sl_next=(sl_next==(NSLOT-1)*SLOTB)?0:sl_next+SLOTB;}while(0)
  DMA_K(2,2*SLOTB);
  WAIT_BAR(3);
  qkt(pA0,pA1,Kbase,qr,negm,r32,hi);asm volatile("s_nop 15\n\ts_nop 7":"+v"(pA0),"+v"(pA1));BIAS(pA0,pA1,0);CMASK(pA0,pA1,0);
  START(pA0,pA1);
  _Pragma("unroll") for(int r=0;r<16;++r)pA1[r]=__builtin_amdgcn_exp2f(pA1[r]);
  WAIT_BAR(0);
  DMA_K(3,0);DMA_V(1,SLOTB);
  ROT();
  kload8(kf,kp0+sl_cur);
  WAIT_BAR(2);
  s16x4 vlo[8],vhi[8]; u32x4 pw0,pw1,pw2,pw3;
  #define PKW(P,B) cvtpk_s(P[B],P[B+1])
  #define PAF(k) __builtin_bit_cast(bf16x8,pw##k)
  #define VFR(i) (bf16x8){vlo[i][0],vlo[i][1],vlo[i][2],vlo[i][3],vhi[i][0],vhi[i][1],vhi[i][2],vhi[i][3]}
  #define PIN(x) asm volatile("":"+v"(x))
  #define MX3(a,b,c) __builtin_fmaxf(__builtin_fmaxf((a),(b)),(c))
  #define GAPA(MF,A0,A1,A2,A3,W0,W1,PW) do{ MF; sacc+=A0; sacc+=A1; sacc+=A2; sacc+=A3; PIN(sacc); W0; W1; PIN(PW); SBAR(); }while(0)
  #define EX(v) __builtin_amdgcn_exp2f(v)
  #define GAPB(MF,X,B) do{ MF; X[B]=EX(X[B]); X[B+1]=EX(X[B+1]); X[B+2]=EX(X[B+2]); X[B+3]=EX(X[B+3]); PIN(X); SBAR(); }while(0)
  #define VRD(i) do{ vlo[i]=vtr(vp_+(((i)>>2)*4096+((i)&3)*1024)); vhi[i]=vtr(vp_+(((i)>>2)*4096+((i)&3)*1024+512)); }while(0)
  #define KRD(G,j) do{ if(G){ kload2(kf,kp0+sl_next,j); SBAR(); } }while(0)
  #define STEP(C0,C1,P0,P1,t,GK,GV,GL) do{ SBAR(); \
    const lds_cptr vp_=vp0+sl_prev; \
    VRD(0); SBAR(); float sacc=(P0[0]+P0[1]); \
    GAPA(C0=__builtin_amdgcn_mfma_f32_32x32x16_bf16(kf[0],qr[0],negm,0,0,0), P0[2],P0[3],P0[4],P0[5],     pw0[0]=PKW(P0,0), pw0[1]=PKW(P0,2), pw0); \
    VRD(4); SBAR(); GAPA(C1=__builtin_amdgcn_mfma_f32_32x32x16_bf16(kf[1],qr[0],negm,0,0,0), P0[6],P0[7],P0[8],P0[9],     pw0[2]=PKW(P0,4), pw0[3]=PKW(P0,6), pw0); \
    VRD(1); SBAR(); GAPA(C0=__builtin_amdgcn_mfma_f32_32x32x16_bf16(kf[2],qr[1],C0,0,0,0),   P0[10],P0[11],P0[12],P0[13], pw1[0]=PKW(P0,8), pw1[1]=PKW(P0,10), pw1); \
    VRD(5); SBAR(); GAPA(C1=__builtin_amdgcn_mfma_f32_32x32x16_bf16(kf[3],qr[1],C1,0,0,0),   P0[14],P0[15],P1[0],P1[1],   pw1[2]=PKW(P0,12),pw1[3]=PKW(P0,14), pw1); \
    VRD(2); SBAR(); GAPA(C0=__builtin_amdgcn_mfma_f32_32x32x16_bf16(kf[4],qr[2],C0,0,0,0),   P1[2],P1[3],P1[4],P1[5],     pw2[0]=PKW(P1,0), pw2[1]=PKW(P1,2), pw2); \
    VRD(6); SBAR(); GAPA(C1=__builtin_amdgcn_mfma_f32_32x32x16_bf16(kf[5],qr[2],C1,0,0,0),   P1[6],P1[7],P1[8],P1[9],     pw2[2]=PKW(P1,4), pw2[3]=PKW(P1,6), pw2); \
    VRD(3); SBAR(); GAPA(C0=__builtin_amdgcn_mfma_f32_32x32x16_bf16(kf[6],qr[3],C0,0,0,0),   P1[10],P1[11],P1[12],P1[13], pw3[0]=PKW(P1,8), pw3[1]=PKW(P1,10), pw3); \
    VRD(7); SBAR(); GAPA(C1=__builtin_amdgcn_mfma_f32_32x32x16_bf16(kf[7],qr[3],C1,0,0,0),   P1[14],P1[15],0.f,0.f,       pw3[2]=PKW(P1,12),pw3[3]=PKW(P1,14), pw3); \
    l_reg+=sacc; \
    if(GK){DMA_K((t)+3,sl_cur);} if(GV){DMA_V((t)+1,sl_next);} \
    BIAS(C0,C1,t); CMASK(C0,C1,t); \
    { float a=MX3(C0[0],C0[1],C1[0]),b=MX3(C0[2],C0[3],C1[1]); a=MX3(a,C1[2],C1[3]); \
      _Pragma("unroll") for(int r=4;r<16;r+=4){a=MX3(a,C0[r],C0[r+1]);b=MX3(b,C0[r+2],C0[r+3]);a=MX3(a,C1[r],C1[r+1]);b=MX3(b,C1[r+2],C1[r+3]);} \
      float rm=__builtin_fmaxf(a,b); { auto rr=__builtin_amdgcn_permlane32_swap(__float_as_uint(rm),__float_as_uint(rm),false,false); rm=__builtin_fmaxf(__uint_as_float(rr[0]),__uint_as_float(rr[1])); } \
      resc=false; \
      if(__builtin_expect(__any(rm>(float)THRL),0)){ const float dl=__builtin_fmaxf(rm,0.f); mhat+=dl; \
        _Pragma("unroll") for(int r=0;r<16;++r){C0[r]-=dl;C1[r]-=dl;} \
        _Pragma("unroll") for(int r=0;r<16;++r)negm[r]=-mhat; asm volatile("":"+v"(negm)); \
        const float f=__builtin_amdgcn_exp2f(-dl); l_reg*=f; if(hi==0)wsf[r32]=f; resc=true; } } \
    SBAR(); \
    GAPB(o[0]=__builtin_amdgcn_mfma_f32_32x32x16_bf16(PAF(0),VFR(0),o[0],0,0,0), C0,0); \
    GAPB(o[1]=__builtin_amdgcn_mfma_f32_32x32x16_bf16(PAF(0),VFR(4),o[1],0,0,0), C0,4); \
    KRD(GL,0); GAPB(o[0]=__builtin_amdgcn_mfma_f32_32x32x16_bf16(PAF(1),VFR(1),o[0],0,0,0), C0,8); \
    KRD(GL,1); GAPB(o[1]=__builtin_amdgcn_mfma_f32_32x32x16_bf16(PAF(1),VFR(5),o[1],0,0,0), C0,12); \
    KRD(GL,2); GAPB(o[0]=__builtin_amdgcn_mfma_f32_32x32x16_bf16(PAF(2),VFR(2),o[0],0,0,0), C1,0); \
    KRD(GL,3); GAPB(o[1]=__builtin_amdgcn_mfma_f32_32x32x16_bf16(PAF(2),VFR(6),o[1],0,0,0), C1,4); \
    GAPB(o[0]=__builtin_amdgcn_mfma_f32_32x32x16_bf16(PAF(3),VFR(3),o[0],0,0,0), C1,8); \
    GAPB(o[1]=__builtin_amdgcn_mfma_f32_32x32x16_bf16(PAF(3),VFR(7),o[1],0,0,0), C1,12); \
    }while(0)
  int t=1;
  #undef CMASK
  #define CMASK(P0,P1,t) do{}while(0)
  for(;t+5<NT;t+=2){
    STEP(pB0,pB1,pA0,pA1,t,true,true,true);     WAIT_BAR(2); RESC(); ROT();
    STEP(pA0,pA1,pB0,pB1,t+1,true,true,true);   WAIT_BAR(2); RESC(); ROT();
  }
  #undef CMASK
  #define CMASK(P0,P1,t) do{int jb_=(t)-(NT-4); if(jb_>=0)cmask(P0,P1,jb_,qrel,hi);}while(0)
  #define ENDW(tt) do{ if((tt)+3<NT){WAIT_BAR(2);} else if((tt)+2<NT){WAIT_BAR(1);} else {WAIT_BAR(0);} }while(0)
  for(;t+1<NT;t+=2){
    STEP(pB0,pB1,pA0,pA1,t,(t+3<NT),(t+1<NT),(t+1<NT));       ENDW(t);   RESC(); ROT();
    STEP(pA0,pA1,pB0,pB1,t+1,(t+4<NT),(t+2<NT),(t+2<NT));     ENDW(t+1); RESC(); ROT();
  }
  STEP(pB0,pB1,pA0,pA1,NT-1,false,false,false); RESC();
  { float sacc=pB0[0]+pB0[1]; _Pragma("unroll") for(int r=2;r<16;++r)sacc+=pB0[r]; _Pragma("unroll") for(int r=0;r<16;++r)sacc+=pB1[r]; l_reg+=sacc;
    pw0=(u32x4){PKW(pB0,0),PKW(pB0,2),PKW(pB0,4),PKW(pB0,6)};pw1=(u32x4){PKW(pB0,8),PKW(pB0,10),PKW(pB0,12),PKW(pB0,14)};pw2=(u32x4){PKW(pB1,0),PKW(pB1,2),PKW(pB1,4),PKW(pB1,6)};pw3=(u32x4){PKW(pB1,8),PKW(pB1,10),PKW(pB1,12),PKW(pB1,14)};
    SBAR(); pv(o,vb0+sl_cur,PAF(0),PAF(1),PAF(2),PAF(3)); }
  #undef PKW
  #undef PAF
  #undef VFR
  #undef PIN
  #undef MX3
  #undef GAPA
  #undef GAPB
  #undef EX
  #undef VRD
  #undef KRD
  #undef STEP
  #undef ENDW
  {auto rr=__builtin_amdgcn_permlane32_swap(__float_as_uint(l_reg),__float_as_uint(l_reg),false,false);l_reg=__uint_as_float(rr[0])+__uint_as_float(rr[1]);}
  if(hi==0)wsf[32+r32]=l_reg;asm volatile("s_waitcnt lgkmcnt(0)":::"memory");
  float rli[16];
  #pragma unroll
  for(int r=0;r<16;++r)rli[r]=__builtin_amdgcn_rcpf(wsf[32+crow(r,hi)]);
  bf16*Ow=O+(rowbase+q0+wid*QBLK)*ODM+h*D;
  { bf16*stg=(bf16*)(shm+LDS_OST)+wid*2048;
    #pragma unroll
    for(int r=0;r<16;++r){const int orow=crow(r,hi);
      #pragma unroll
      for(int d0=0;d0<2;++d0)stg[orow*64+d0*32+r32]=__float2bfloat16(o[d0][r]*rli[r]);}
    asm volatile("s_waitcnt lgkmcnt(0)":::"memory");
    #pragma unroll
    for(int i=0;i<4;++i){const int row=i*8+(lane>>3),ch=lane&7; const u32x4 v=*(const u32x4*)(stg+row*64+ch*8); ATTN_STORE16(Ow+(long)row*ODM+ch*8,v);} }
  asm volatile("s_waitcnt lgkmcnt(0)\n\ts_barrier":::"memory");
  #undef DMA_K
  #undef DMA_V
  #undef CMASK
  #undef START
  #undef RESC
  #undef ROT
  #undef BIAS
}
constexpr int ATTN_LDS_BYTES=LDS_BYTES;
#undef SBAR
#undef WAIT_BAR
}

#define LAS __attribute__((address_space(3)))
typedef unsigned short bfr;
typedef float f32x4v __attribute__((ext_vector_type(4)));
typedef unsigned u32x4v __attribute__((ext_vector_type(4)));
typedef unsigned u32x2v __attribute__((ext_vector_type(2)));
typedef short bf16x8v __attribute__((ext_vector_type(8)));

constexpr int NB = 4, SEQ = 8192, DMODEL = 1024, DEPTH = 4, MROWS = NB * SEQ;
constexpr int NPROJ = 3072, DIN = 2966, DFF = 2816, NGU = 5632, NMOD = 6144, DMIX = 1024;
constexpr int C_LX = 0, C_LG = 384, C_FQ = 768, C_FK = 1152, C_FV = 1536, C_GQ = 1920, C_GK = 2176, C_GV = 2432, C_GG = 2688, C_GL = 2944, C_FF = 2960;
constexpr float EPS = 1e-6f, LOG2E = 1.4426950408889634f;

constexpr size_t MiB = 1u << 20;
constexpr size_t WS_CTL = 0, CTL_BYTES = 65536;
constexpr int CW_BAR = 1024;
constexpr size_t WS_MOD = 1 * MiB;
constexpr size_t WS_CUM = 2 * MiB;
constexpr size_t WS_DEC = 3 * MiB;
constexpr size_t WS_SUMA = 4 * MiB, WS_SUMH = 5 * MiB;
constexpr size_t WS_LRUW = 6 * MiB;
constexpr size_t WS_WIN = 8 * MiB, WS_WOUT = 32 * MiB, WS_WGU = 40 * MiB, WS_WDN = 84 * MiB;
constexpr size_t WIN_L = (size_t)NPROJ * 1024 * 2, WOUT_L = (size_t)1024 * 1024 * 2, WGU_L = (size_t)NGU * 1024 * 2, WDN_L = (size_t)1024 * DFF * 2;
constexpr size_t WS_PROJ = 106 * MiB;
constexpr size_t WS_MIX = 298 * MiB;
constexpr size_t WS_HN = 362 * MiB;
constexpr size_t WS_HL = 362 * MiB, WS_ACUM = 386 * MiB, WS_QDEC = 410 * MiB;
constexpr size_t WS_OINTRA = 426 * MiB;
constexpr size_t WS_KV = 442 * MiB;
constexpr size_t WS_ST = 474 * MiB;
constexpr size_t WS_END = 490 * MiB;
static_assert(WS_WDN + 4 * WDN_L <= WS_PROJ && WS_WGU + 4 * WGU_L <= WS_WDN && WS_WIN + 4 * WIN_L <= WS_WOUT && WS_WOUT + 4 * WOUT_L <= WS_WGU, "ws map");

constexpr int RING_BYTES = 131072, MISC_OFF = RING_BYTES, LDS_BYTES = 147456;
static_assert(attn_body::ATTN_LDS_BYTES <= RING_BYTES, "attention LDS");

__device__ __forceinline__ float bf2f(bfr h) { return __uint_as_float((unsigned)h << 16); }
typedef float f32x2v_ __attribute__((ext_vector_type(2))); typedef __bf16 bf16x2v_ __attribute__((ext_vector_type(2)));
__device__ __forceinline__ unsigned pk2(float lo, float hi) { f32x2v_ v = {lo, hi}; bf16x2v_ b = __builtin_convertvector(v, bf16x2v_); return __builtin_bit_cast(unsigned, b); }
__device__ __forceinline__ bfr f2bf(float f) { return (bfr)(pk2(f, f) & 0xffffu); }
__device__ __forceinline__ float wave_sum(float v) {
#pragma unroll
    for (int o = 1; o < 64; o <<= 1) v += __shfl_xor(v, o);
    return v;
}
__device__ __forceinline__ float sigmoidf_(float x) { return __builtin_amdgcn_rcpf(1.0f + __expf(-x)); }
__device__ __forceinline__ float log_sigmoid_(float z) { return fminf(z, 0.f) - __logf(1.0f + __expf(-fabsf(z))); }
__device__ __forceinline__ float gelu_tanh_(float y) { const float z = 0.7978845608028654f * (y + 0.044715f * y * y * y); const float t = 1.0f - 2.0f * __builtin_amdgcn_rcpf(__expf(2.0f * z) + 1.0f); return 0.5f * y * (1.0f + t); }
__device__ __forceinline__ float silu_(float g) { return g * __builtin_amdgcn_rcpf(1.0f + __expf(-g)); }

struct Params { const float* in[23]; float* out; unsigned char* ws; };

__device__ __forceinline__ int map_in(int n) {
    if (n >= 768 && n < 1536) {
        const int c = n & 255, s_ = (c & 127) >> 5, d = (c & 31) + 32 * (c >> 7), H = 4 * ((n >> 8) - 3) + s_;
        return 768 + H * 64 + d; }
    if (n < 1920) return n;
    if (n < 2688) return n + 6;
    if (n < 2944) return n - 2688 + 2710;
    if (n < 2960) return n - 2944 + 2694;
    if (n < 2966) return n - 2960 + 1920;
    return -1;
}
__device__ __forceinline__ int map_gu(int n) { const int pn = n >> 8, r = n & 255; return r < 128 ? pn * 128 + r : DFF + pn * 128 + (r - 128); }
template <int MODE> __device__ __forceinline__ void transpose_item(const float* __restrict__ W, int K, int N, int NP, bfr* __restrict__ WT, LAS float* scr, int item, int lane) {
    const int nblk = NP / 32, kb = item / nblk, nb = item % nblk, k0 = 64 * kb, n0 = 32 * nb;
    const int nme = n0 + (lane & 31);
    const int nsrc = MODE == 0 ? nme : (MODE == 1 ? map_in(nme) : map_gu(nme));
#pragma unroll 8
    for (int i = 0; i < 32; ++i) { const int kk = 2 * i + (lane >> 5); scr[kk * 33 + (lane & 31)] = nsrc >= 0 ? W[(size_t)(k0 + kk) * N + nsrc] : 0.f; }
    asm volatile("s_waitcnt lgkmcnt(0)" ::: "memory");
    const int c = lane & 7;
#pragma unroll
    for (int j = 0; j < 4; ++j) { const int n = (lane >> 3) + 8 * j; const LAS float* s = scr + (8 * c) * 33 + n;
        u32x4v o; o.x = pk2(s[0 * 33], s[1 * 33]); o.y = pk2(s[2 * 33], s[3 * 33]); o.z = pk2(s[4 * 33], s[5 * 33]); o.w = pk2(s[6 * 33], s[7 * 33]);
        *(u32x4v*)(WT + (size_t)(n0 + n) * K + k0 + 8 * c) = o; }
    asm volatile("s_waitcnt lgkmcnt(0)" ::: "memory");
}
__device__ __forceinline__ void p0_prologue(const Params& P, LAS unsigned char* lds, int tid, int lane, int wid, int G) {
    asm volatile("" : "+v"(tid), "+v"(lane), "+s"(wid));
    unsigned char* ws = P.ws;
    {
        LAS float* CA = (LAS float*)lds;
        LAS float* RED = (LAS float*)(lds + 16384);
        const float* c = P.in[1];
        for (int i = tid; i < NB * DMODEL; i += 512) CA[i] = silu_(c[i]);
        __syncthreads();
        const int kp = tid >> 5, col = tid & 31;
        float* MOD = (float*)(ws + WS_MOD);
        for (int it = blockIdx.x; it < DEPTH * (NMOD / 32); it += G) {
            const int l = it / (NMOD / 32), c0 = (it % (NMOD / 32)) * 32;
            const float* w = P.in[4] + ((size_t)l * DMODEL + kp * 64) * NMOD + c0 + col;
            float a0 = 0.f, a1 = 0.f, a2 = 0.f, a3 = 0.f;
#pragma unroll 8
            for (int k = 0; k < 64; ++k) { const float wv = w[(size_t)k * NMOD]; const int kk = kp * 64 + k;
                a0 += CA[kk] * wv; a1 += CA[1024 + kk] * wv; a2 += CA[2048 + kk] * wv; a3 += CA[3072 + kk] * wv; }
            RED[(kp * 4 + 0) * 32 + col] = a0; RED[(kp * 4 + 1) * 32 + col] = a1; RED[(kp * 4 + 2) * 32 + col] = a2; RED[(kp * 4 + 3) * 32 + col] = a3;
            __syncthreads();
            if (tid < 128) { const int b = tid >> 5; float s = P.in[5][(size_t)l * NMOD + c0 + col];
#pragma unroll
                for (int q = 0; q < 16; ++q) s += RED[(q * 4 + b) * 32 + col];
                MOD[((size_t)l * NB + b) * NMOD + c0 + col] = s; }
            __syncthreads();
        }
    }
    __syncthreads();
    {
        bfr* LW = (bfr*)(ws + WS_LRUW);
        for (int i = blockIdx.x * 512 + tid; i < DEPTH * 6 * 2 * 4096; i += G * 512) {
            const int d = i & 63, e = (i >> 6) & 63, mat = (i >> 12) & 1, ln = i >> 13;
            const float* src = mat ? P.in[11] : P.in[9];
            LW[i] = f2bf(src[(size_t)ln * 4096 + d * 64 + e]);
        }
    }
    {
        LAS float* scr = (LAS float*)(lds + wid * 16384);
        const int gw = blockIdx.x * 8 + wid, NGW = G * 8;
        constexpr int I_IN = 16 * (NPROJ / 32), I_OUT = 16 * 32, I_GU = 16 * (NGU / 32), I_DN = (DFF / 64) * 32, I_L = I_IN + I_OUT + I_GU + I_DN;
        for (int it = gw; it < DEPTH * I_L; it += NGW) {
            const int l = it / I_L; int r = it % I_L;
            if (r < I_IN) { transpose_item<1>(P.in[6] + (size_t)l * DMODEL * DIN, DMODEL, DIN, NPROJ, (bfr*)(ws + WS_WIN + l * WIN_L), scr, r, lane); continue; } r -= I_IN;
            if (r < I_OUT) { transpose_item<0>(P.in[20] + (size_t)l * DMIX * DMODEL, DMIX, DMODEL, DMODEL, (bfr*)(ws + WS_WOUT + l * WOUT_L), scr, r, lane); continue; } r -= I_OUT;
            if (r < I_GU) { transpose_item<2>(P.in[21] + (size_t)l * DMODEL * NGU, DMODEL, NGU, NGU, (bfr*)(ws + WS_WGU + l * WGU_L), scr, r, lane); continue; } r -= I_GU;
            transpose_item<0>(P.in[22] + (size_t)l * DFF * DMODEL, DFF, DMODEL, DMODEL, (bfr*)(ws + WS_WDN + l * WDN_L), scr, r, lane);
        }
    }
}

__device__ __forceinline__ void norm_phase(const float* __restrict__ x, const bfr* __restrict__ x16, const float* __restrict__ gain, const float* __restrict__ modl, int shift_off, int scale_off, bfr* __restrict__ HN, int gw, int NGW, int lane) {
    asm volatile("" : "+v"(lane), "+s"(gw));
    const bool xloc = (NGW % 64) == 0;
    const int xq = xloc ? (gw >> 3) & 7 : 0, wloc = xloc ? ((gw >> 6) << 3) + (gw & 7) : gw, nwl = xloc ? NGW / 8 : NGW, rbase = xq * (MROWS / 8), rcnt = xloc ? MROWS / 8 : MROWS;
    for (int r = wloc; r < rcnt; r += nwl) {
        const int m = rbase + r;
        f32x4v v[4]; float s = 0.f;
        if (x16) {
            const u32x2v* xr = (const u32x2v*)(x16 + (size_t)m * DMODEL) + lane;
#pragma unroll
            for (int j = 0; j < 4; ++j) { const u32x2v w = xr[64 * j]; const pg8::f32x2 a = pg8::h2f(w.x), b = pg8::h2f(w.y); v[j] = (f32x4v){a.x, a.y, b.x, b.y}; }
        } else {
            const f32x4v* xr = (const f32x4v*)(x + (size_t)m * DMODEL) + lane;
#pragma unroll
            for (int j = 0; j < 4; ++j) v[j] = xr[64 * j];
        }
#pragma unroll
        for (int j = 0; j < 4; ++j) s += (v[j].x * v[j].x + v[j].y * v[j].y) + (v[j].z * v[j].z + v[j].w * v[j].w);
        const float rstd = 1.0f / sqrtf(wave_sum(s) * (1.0f / DMODEL) + EPS);
        const float* mb = modl + (size_t)(m / SEQ) * NMOD;
        u32x2v* o8 = (u32x2v*)(HN + (size_t)m * DMODEL) + lane;
#pragma unroll
        for (int j = 0; j < 4; ++j) { const int col = 4 * lane + 256 * j;
            const f32x4v g = *(const f32x4v*)(gain + col), sc = *(const f32x4v*)(mb + scale_off + col), sh = *(const f32x4v*)(mb + shift_off + col);
            const f32x4v h = v[j] * rstd * g * (sc + 1.0f) + sh;
            u32x2v w; w.x = pk2(h.x, h.y); w.y = pk2(h.z, h.w); o8[64 * j] = w; }
    }
}

struct LayerPtrs {
    const float *conv_w, *conv_b, *b_r, *b_i, *lam, *fox_bf, *qgain, *kgain, *w_alpha, *b_alpha, *ogain;
    const bfr* lruw;
};

constexpr int LRU_LC = 128, LRU_NCH = SEQ / LRU_LC;
__device__ __forceinline__ void lru_local_item(int idx, const LayerPtrs& L, unsigned char* ws, LAS unsigned char* lds, int tid, int lane, int wid) {
    asm volatile("" : "+v"(tid), "+v"(lane), "+s"(wid));
    const int n = idx % 6, c = (idx / 6) % LRU_NCH, b = idx / (6 * LRU_NCH);
    const int ch = tid & 63, tg = wid;
    const bfr* PROJ = (const bfr*)(ws + WS_PROJ);
    LAS bfr* XA = (LAS bfr*)lds;
    LAS float* RI = (LAS float*)(lds + 18432);
    LAS float* SEG = (LAS float*)(lds + 18432 + 65536);
    const int cg_ = n * 64 + ch;
    const int mat = wid >> 2, fr = lane & 15, fq = lane >> 4;
    const bfr* wt = L.lruw + (size_t)(n * 2 + mat) * 4096;
    bf16x8v bfrag[4][2];
#pragma unroll
    for (int te = 0; te < 4; ++te) { bfrag[te][0] = *(const bf16x8v*)(wt + (16 * te + fr) * 64 + 8 * fq); bfrag[te][1] = *(const bf16x8v*)(wt + (16 * te + fr) * 64 + 32 + 8 * fq); }
    const float lam = L.lam[cg_], br = L.b_r[cg_], bi = L.b_i[cg_];
    float xa[16];
    {
        float raw[19];
#pragma unroll
        for (int j = 0; j < 19; ++j) { const int tt = c * LRU_LC + 16 * tg - 3 + j; raw[j] = tt >= 0 ? bf2f(PROJ[((size_t)b * SEQ + tt) * NPROJ + C_LX + cg_]) : 0.f; }
        const float w0 = L.conv_w[cg_], w1 = L.conv_w[384 + cg_], w2 = L.conv_w[768 + cg_], w3 = L.conv_w[1152 + cg_], cb = L.conv_b[cg_];
#pragma unroll
        for (int i = 0; i < 16; ++i) { xa[i] = cb + w0 * raw[i] + w1 * raw[i + 1] + w2 * raw[i + 2] + w3 * raw[i + 3]; XA[(16 * tg + i) * 72 + ch] = f2bf(xa[i]); }
    }
    __syncthreads();
    {
#pragma unroll
        for (int q = 0; q < 2; ++q) {
            const int tr = 2 * (wid & 3) + q;
            const bf16x8v a0 = *(const LAS bf16x8v*)(XA + (16 * tr + fr) * 72 + 8 * fq), a1 = *(const LAS bf16x8v*)(XA + (16 * tr + fr) * 72 + 32 + 8 * fq);
#pragma unroll
            for (int te = 0; te < 4; ++te) {
                f32x4v acc = {0.f, 0.f, 0.f, 0.f};
                acc = __builtin_amdgcn_mfma_f32_16x16x32_bf16(a0, bfrag[te][0], acc, 0, 0, 0);
                acc = __builtin_amdgcn_mfma_f32_16x16x32_bf16(a1, bfrag[te][1], acc, 0, 0, 0);
#pragma unroll
                for (int r = 0; r < 4; ++r) RI[(mat * LRU_LC + 16 * tr + 4 * fq + r) * 64 + 16 * te + fr] = acc[r];
            }
        }
    }
    __syncthreads();
    float hs[16], ps[16];
    {
        const float e_ = __expf(-fabsf(lam));
        const float sp = fmaxf(-lam, 0.f) + (e_ < 0.03125f ? e_ * (1.0f - e_ * (0.5f - e_ * (0.33333334f - 0.25f * e_))) : __logf(1.0f + e_));
        float h = 0.f, p = 1.f;
#pragma unroll
        for (int i = 0; i < 16; ++i) {
            const float r = sigmoidf_(RI[(16 * tg + i) * 64 + ch] + br), ig = sigmoidf_(RI[(LRU_LC + 16 * tg + i) * 64 + ch] + bi);
            const float la = -8.0f * r * sp; const float a = __expf(la); const float mult = __builtin_amdgcn_sqrtf(fmaxf(1.0f - a * a, 0.f));
            h = a * h + mult * ig * xa[i]; p *= a; hs[i] = h; ps[i] = p;
        }
        SEG[(tg * 2 + 0) * 64 + ch] = p; SEG[(tg * 2 + 1) * 64 + ch] = h;
    }
    __syncthreads();
    {
        float carry = 0.f, pref = 1.f;
        for (int g = 0; g < tg; ++g) { const float pg = SEG[(g * 2) * 64 + ch], hg = SEG[(g * 2 + 1) * 64 + ch]; carry = pg * carry + hg; pref *= pg; }
        bfr* HL = (bfr*)(ws + WS_HL); bfr* AC = (bfr*)(ws + WS_ACUM);
        const size_t m0 = (size_t)b * SEQ + c * LRU_LC + 16 * tg;
        float hl = 0.f, ac = 0.f;
#pragma unroll
        for (int i = 0; i < 16; ++i) { hl = hs[i] + ps[i] * carry; ac = ps[i] * pref; HL[(m0 + i) * 384 + cg_] = f2bf(hl); AC[(m0 + i) * 384 + cg_] = f2bf(ac); }
        if (tg == 7) { ((float*)(ws + WS_SUMA))[((size_t)b * LRU_NCH + c) * 384 + cg_] = ac; ((float*)(ws + WS_SUMH))[((size_t)b * LRU_NCH + c) * 384 + cg_] = hl; }
    }
    __syncthreads();
}
__device__ __forceinline__ void knorm_item(int idx, const LayerPtrs& L, unsigned char* ws, int tid) {
    asm volatile("" : "+v"(tid));
    bfr* PROJ = (bfr*)(ws + WS_PROJ);
    const int part = tid & 7, hr = tid >> 3;
    const f32x4v g0 = *(const f32x4v*)(L.kgain + part * 8), g1 = *(const f32x4v*)(L.kgain + part * 8 + 4);
#pragma unroll
    for (int p = 0; p < 6; ++p) {
        const int R = p * 64 + hr, tok = R / 6, head = R % 6;
        u32x4v* ptr = (u32x4v*)(PROJ + ((size_t)idx * 64 + tok) * NPROJ + C_FK + head * 64 + part * 8);
        const u32x4v w = *ptr;
        float f[8];
        f[0] = __uint_as_float(w.x << 16); f[1] = __uint_as_float(w.x & 0xffff0000u); f[2] = __uint_as_float(w.y << 16); f[3] = __uint_as_float(w.y & 0xffff0000u);
        f[4] = __uint_as_float(w.z << 16); f[5] = __uint_as_float(w.z & 0xffff0000u); f[6] = __uint_as_float(w.w << 16); f[7] = __uint_as_float(w.w & 0xffff0000u);
        float ss = 0.f;
#pragma unroll
        for (int j = 0; j < 8; ++j) ss += f[j] * f[j];
        ss += __shfl_xor(ss, 1); ss += __shfl_xor(ss, 2); ss += __shfl_xor(ss, 4);
        const float rs = 1.0f / sqrtf(ss * (1.0f / 64.0f) + EPS);
        u32x4v o; o.x = pk2(f[0] * rs * g0.x, f[1] * rs * g0.y); o.y = pk2(f[2] * rs * g0.z, f[3] * rs * g0.w); o.z = pk2(f[4] * rs * g1.x, f[5] * rs * g1.y); o.w = pk2(f[6] * rs * g1.z, f[7] * rs * g1.w);
        *ptr = o;
    }
}
__device__ __forceinline__ void cum_item(int idx, const LayerPtrs& L, unsigned char* ws, LAS unsigned char* lds, int tid, int lane, int wid) {
    asm volatile("" : "+v"(tid), "+v"(lane), "+s"(wid));
    const int b = idx / 6, h = idx % 6;
    const bfr* PROJ = (const bfr*)(ws + WS_PROJ);
    LAS float* WT = (LAS float*)lds;
    const float bf = L.fox_bf[h];
    float loc[16]; float run = 0.f;
#pragma unroll
    for (int i = 0; i < 16; ++i) { const float z = bf2f(PROJ[((size_t)b * SEQ + 16 * tid + i) * NPROJ + C_FF + h]) + bf; run += log_sigmoid_(z); loc[i] = run; }
    float inc = run;
#pragma unroll
    for (int o = 1; o < 64; o <<= 1) { const float t = __shfl_up(inc, o); if (lane >= o) inc += t; }
    if (lane == 63) WT[wid] = inc;
    __syncthreads();
    float base = inc - run;
    for (int w = 0; w < wid; ++w) base += WT[w];
    float* CUM = (float*)(ws + WS_CUM) + ((size_t)b * 6 + h) * SEQ + 16 * tid;
#pragma unroll
    for (int i = 0; i < 16; i += 4) *(f32x4v*)(CUM + i) = (f32x4v){loc[i] + base, loc[i + 1] + base, loc[i + 2] + base, loc[i + 3] + base};
    __syncthreads();
}
__device__ __forceinline__ void gla_local_item(int idx, const LayerPtrs& L, unsigned char* ws, LAS unsigned char* lds, int tid, int lane, int wid) {
    asm volatile("" : "+v"(tid), "+v"(lane), "+s"(wid));
    const int bh = idx >> 6, np = idx & 63, b = bh >> 2, h = bh & 3;
    const int d = tid & 63, tg = wid, fr = lane & 15, fq = lane >> 4;
    const bfr* PROJ = (const bfr*)(ws + WS_PROJ);
    constexpr int CCB = 49152;
    float qf[2][8], kf[2][8]; bfr vb[2][8];
#pragma unroll
    for (int cc = 0; cc < 2; ++cc)
#pragma unroll
        for (int i = 0; i < 8; ++i) { const size_t m = (size_t)b * SEQ + (2 * np + cc) * 64 + 8 * tg + i;
            qf[cc][i] = bf2f(PROJ[m * NPROJ + C_GQ + h * 64 + d]); kf[cc][i] = bf2f(PROJ[m * NPROJ + C_GK + h * 64 + d]); vb[cc][i] = PROJ[m * NPROJ + C_GV + h * 64 + d]; }
    float bc[2][8];
    {
        float wal[16];
#pragma unroll
        for (int r = 0; r < 16; ++r) wal[r] = L.w_alpha[r * 256 + h * 64 + d];
        const float bal = L.b_alpha[h * 64 + d];
#pragma unroll
        for (int cc = 0; cc < 2; ++cc) {
            LAS float* SEGB = (LAS float*)(lds + cc * CCB);
            const size_t m0 = (size_t)b * SEQ + (2 * np + cc) * 64;
            float run = 0.f;
#pragma unroll
            for (int i = 0; i < 8; ++i) {
                const u32x4v* lp = (const u32x4v*)(PROJ + (m0 + 8 * tg + i) * NPROJ + C_GL);
                const u32x4v l0 = lp[0], l1 = lp[1];
                float z = bal;
                z += __uint_as_float(l0.x << 16) * wal[0] + __uint_as_float(l0.x & 0xffff0000u) * wal[1] + __uint_as_float(l0.y << 16) * wal[2] + __uint_as_float(l0.y & 0xffff0000u) * wal[3];
                z += __uint_as_float(l0.z << 16) * wal[4] + __uint_as_float(l0.z & 0xffff0000u) * wal[5] + __uint_as_float(l0.w << 16) * wal[6] + __uint_as_float(l0.w & 0xffff0000u) * wal[7];
                z += __uint_as_float(l1.x << 16) * wal[8] + __uint_as_float(l1.x & 0xffff0000u) * wal[9] + __uint_as_float(l1.y << 16) * wal[10] + __uint_as_float(l1.y & 0xffff0000u) * wal[11];
                z += __uint_as_float(l1.z << 16) * wal[12] + __uint_as_float(l1.z & 0xffff0000u) * wal[13] + __uint_as_float(l1.w << 16) * wal[14] + __uint_as_float(l1.w & 0xffff0000u) * wal[15];
                run += log_sigmoid_(z) * (1.0f / 16.0f); bc[cc][i] = run;
            }
            SEGB[tg * 64 + d] = run;
        }
    }
    __syncthreads();
#pragma unroll
    for (int cc = 0; cc < 2; ++cc) {
        LAS float* SEGB = (LAS float*)(lds + cc * CCB);
        LAS bfr* QD = (LAS bfr*)(lds + cc * CCB + 2048); LAS bfr* KD = QD + 4608; LAS bfr* KTET = KD + 4608; LAS bfr* VT = KTET + 4608;
        const size_t m0 = (size_t)b * SEQ + (2 * np + cc) * 64;
        float off = 0.f, total = 0.f;
#pragma unroll
        for (int g = 0; g < 8; ++g) { const float sg = SEGB[g * 64 + d]; total += sg; if (g < tg) off += sg; }
        bfr* QDEC = (bfr*)(ws + WS_QDEC);
        unsigned kt[4], vv[4];
#pragma unroll
        for (int i = 0; i < 8; ++i) {
            const size_t m = m0 + 8 * tg + i; const float bcum = bc[cc][i] + off;
            const float q = qf[cc][i], k = kf[cc][i]; const bfr v = vb[cc][i];
            const bfr qd = f2bf(q * 0.125f * __expf(bcum)), kd = f2bf(k * __expf(-bcum)), kte = f2bf(k * __expf(total - bcum));
            QD[(8 * tg + i) * 72 + d] = qd; KD[(8 * tg + i) * 72 + d] = kd; QDEC[m * 256 + h * 64 + d] = qd;
            if (i & 1) { kt[i >> 1] |= (unsigned)kte << 16; vv[i >> 1] |= (unsigned)v << 16; } else { kt[i >> 1] = kte; vv[i >> 1] = v; }
        }
        *(LAS u32x4v*)(KTET + d * 72 + 8 * tg) = (u32x4v){kt[0], kt[1], kt[2], kt[3]};
        *(LAS u32x4v*)(VT + d * 72 + 8 * tg) = (u32x4v){vv[0], vv[1], vv[2], vv[3]};
        if (tg == 0) ((float*)(ws + WS_DEC))[((size_t)bh * 128 + 2 * np + cc) * 64 + d] = __expf(total);
    }
    __syncthreads();
#pragma unroll
    for (int cc = 0; cc < 2; ++cc) {
        LAS bfr* QD = (LAS bfr*)(lds + cc * CCB + 2048); LAS bfr* KD = QD + 4608; LAS bfr* ATT = QD + 4 * 4608;
        const int ti = wid & 3;
#pragma unroll
        for (int q = 0; q < 2; ++q) {
            const int tj = 2 * (wid >> 2) + q;
            f32x4v acc = {0.f, 0.f, 0.f, 0.f};
            if (tj <= ti) {
                const bf16x8v a0 = *(const LAS bf16x8v*)(QD + (16 * ti + fr) * 72 + 8 * fq), a1 = *(const LAS bf16x8v*)(QD + (16 * ti + fr) * 72 + 32 + 8 * fq);
                const bf16x8v b0 = *(const LAS bf16x8v*)(KD + (16 * tj + fr) * 72 + 8 * fq), b1 = *(const LAS bf16x8v*)(KD + (16 * tj + fr) * 72 + 32 + 8 * fq);
                acc = __builtin_amdgcn_mfma_f32_16x16x32_bf16(a0, b0, acc, 0, 0, 0);
                acc = __builtin_amdgcn_mfma_f32_16x16x32_bf16(a1, b1, acc, 0, 0, 0);
            }
#pragma unroll
            for (int r = 0; r < 4; ++r) { const int i = 16 * ti + 4 * fq + r, j = 16 * tj + fr; ATT[i * 72 + j] = f2bf(j <= i ? acc[r] : 0.f); }
        }
    }
    __syncthreads();
#pragma unroll
    for (int cc = 0; cc < 2; ++cc) {
        LAS bfr* QD = (LAS bfr*)(lds + cc * CCB + 2048); LAS bfr* KTET = QD + 2 * 4608; LAS bfr* VT = QD + 3 * 4608; LAS bfr* ATT = QD + 4 * 4608;
        const size_t m0 = (size_t)b * SEQ + (2 * np + cc) * 64;
        const int mat = wid >> 2, t4 = wid & 3;
        if (mat == 0) {
            bfr* OI = (bfr*)(ws + WS_OINTRA);
            const bf16x8v b0 = *(const LAS bf16x8v*)(ATT + (16 * t4 + fr) * 72 + 8 * fq), b1 = *(const LAS bf16x8v*)(ATT + (16 * t4 + fr) * 72 + 32 + 8 * fq);
#pragma unroll
            for (int tv = 0; tv < 4; ++tv) {
                const bf16x8v a0 = *(const LAS bf16x8v*)(VT + (16 * tv + fr) * 72 + 8 * fq), a1 = *(const LAS bf16x8v*)(VT + (16 * tv + fr) * 72 + 32 + 8 * fq);
                f32x4v acc = {0.f, 0.f, 0.f, 0.f};
                acc = __builtin_amdgcn_mfma_f32_16x16x32_bf16(a0, b0, acc, 0, 0, 0);
                acc = __builtin_amdgcn_mfma_f32_16x16x32_bf16(a1, b1, acc, 0, 0, 0);
                u32x2v w; w.x = pk2(acc[0], acc[1]); w.y = pk2(acc[2], acc[3]);
                *(u32x2v*)(OI + (m0 + 16 * t4 + fr) * 256 + h * 64 + 16 * tv + 4 * fq) = w;
            }
        } else {
            float* KV = (float*)(ws + WS_KV) + ((size_t)bh * 128 + 2 * np + cc) * 4096;
            const bf16x8v a0 = *(const LAS bf16x8v*)(KTET + (16 * t4 + fr) * 72 + 8 * fq), a1 = *(const LAS bf16x8v*)(KTET + (16 * t4 + fr) * 72 + 32 + 8 * fq);
#pragma unroll
            for (int tv = 0; tv < 4; ++tv) {
                const bf16x8v b0 = *(const LAS bf16x8v*)(VT + (16 * tv + fr) * 72 + 8 * fq), b1 = *(const LAS bf16x8v*)(VT + (16 * tv + fr) * 72 + 32 + 8 * fq);
                f32x4v acc = {0.f, 0.f, 0.f, 0.f};
                acc = __builtin_amdgcn_mfma_f32_16x16x32_bf16(a0, b0, acc, 0, 0, 0);
                acc = __builtin_amdgcn_mfma_f32_16x16x32_bf16(a1, b1, acc, 0, 0, 0);
                *(f32x4v*)(KV + (16 * tv + fr) * 64 + 16 * t4 + 4 * fq) = acc;
            }
        }
    }
    __syncthreads();
}

__device__ __forceinline__ void gla_scan_item(int idx, unsigned char* ws, int tid) {
    asm volatile("" : "+v"(tid));
    const int bh = idx >> 3, e = (idx & 7) * 512 + tid, d = e & 63;
    const float* KV = (const float*)(ws + WS_KV) + (size_t)bh * 128 * 4096 + e;
    const float* DEC = (const float*)(ws + WS_DEC) + (size_t)bh * 128 * 64 + d;
    bfr* ST = (bfr*)(ws + WS_ST) + (size_t)bh * 128 * 4096 + e;
    float s = 0.f;
#pragma unroll 16
    for (int n = 0; n < 128; ++n) { const float kvv = KV[(size_t)n * 4096], dc = DEC[n * 64]; ST[(size_t)n * 4096] = f2bf(s); s = dc * s + kvv; }
}
__device__ __forceinline__ void lru_out_item(int q, unsigned char* ws, LAS unsigned char* lds, int tid, int wid) {
    asm volatile("" : "+v"(tid), "+s"(wid));
    const int b = q / 96, rem = q % 96, n = rem / 16, cgp = rem % 16;
    const int ch = tid & 63, tg = wid, cg_ = n * 64 + ch;
    const float* SA = (const float*)(ws + WS_SUMA) + (size_t)b * LRU_NCH * 384 + cg_;
    const float* SH = (const float*)(ws + WS_SUMH) + (size_t)b * LRU_NCH * 384 + cg_;
    LAS float* COMP = (LAS float*)lds;
    {
        const int nprev = 4 * cgp;
        float pw = 1.f, hw = 0.f;
        for (int j = (tg * nprev) >> 3; j < ((tg + 1) * nprev) >> 3; ++j) { const float a = SA[j * 384], hh = SH[j * 384]; hw = a * hw + hh; pw *= a; }
        COMP[(tg * 2) * 64 + ch] = pw; COMP[(tg * 2 + 1) * 64 + ch] = hw;
    }
    __syncthreads();
    float carry = 0.f;
#pragma unroll
    for (int g = 0; g < 8; ++g) carry = COMP[(g * 2) * 64 + ch] * carry + COMP[(g * 2 + 1) * 64 + ch];
    const bfr* HL = (const bfr*)(ws + WS_HL); const bfr* AC = (const bfr*)(ws + WS_ACUM); const bfr* PROJ = (const bfr*)(ws + WS_PROJ); bfr* MIX = (bfr*)(ws + WS_MIX);
    for (int cc = 0; cc < 4; ++cc) {
        const int c = cgp * 4 + cc;
        const size_t m0 = (size_t)b * SEQ + c * LRU_LC + 16 * tg;
        const float sa = SA[c * 384], sh = SH[c * 384];
#pragma unroll
        for (int i = 0; i < 16; ++i) { const size_t m = m0 + i;
            const float hh = bf2f(HL[m * 384 + cg_]) + bf2f(AC[m * 384 + cg_]) * carry; const float y = bf2f(PROJ[m * NPROJ + C_LG + cg_]);
            MIX[m * DMIX + cg_] = f2bf(hh * gelu_tanh_(y)); }
        carry = sa * carry + sh;
    }
}
__device__ __forceinline__ void gla_out_item(int idx, const LayerPtrs& L, unsigned char* ws, int lane) {
    asm volatile("" : "+v"(lane));
    const int bh = idx >> 7, n = idx & 127, b = bh >> 2, h = bh & 3, fr = lane & 15, fq = lane >> 4;
    const size_t m0 = (size_t)b * SEQ + n * 64;
    const bfr* ST = (const bfr*)(ws + WS_ST) + (size_t)idx * 4096; const bfr* QDEC = (const bfr*)(ws + WS_QDEC); const bfr* OI = (const bfr*)(ws + WS_OINTRA);
    const bfr* PROJ = (const bfr*)(ws + WS_PROJ); bfr* MIX = (bfr*)(ws + WS_MIX);
    bf16x8v st[4][2];
#pragma unroll
    for (int tv = 0; tv < 4; ++tv)
#pragma unroll
        for (int ks = 0; ks < 2; ++ks) st[tv][ks] = *(const bf16x8v*)(ST + (16 * tv + fr) * 64 + 32 * ks + 8 * fq);
    f32x4v gn[4];
#pragma unroll
    for (int tv = 0; tv < 4; ++tv) gn[tv] = *(const f32x4v*)(L.ogain + 16 * tv + 4 * fq);
#pragma unroll
    for (int ti = 0; ti < 4; ++ti) {
        const size_t m = m0 + 16 * ti + fr;
        const bf16x8v q0 = *(const bf16x8v*)(QDEC + m * 256 + h * 64 + 8 * fq), q1 = *(const bf16x8v*)(QDEC + m * 256 + h * 64 + 32 + 8 * fq);
        f32x4v o[4]; float ss = 0.f;
#pragma unroll
        for (int tv = 0; tv < 4; ++tv) {
            f32x4v acc = {0.f, 0.f, 0.f, 0.f};
            acc = __builtin_amdgcn_mfma_f32_16x16x32_bf16(st[tv][0], q0, acc, 0, 0, 0);
            acc = __builtin_amdgcn_mfma_f32_16x16x32_bf16(st[tv][1], q1, acc, 0, 0, 0);
            const u32x2v w = *(const u32x2v*)(OI + m * 256 + h * 64 + 16 * tv + 4 * fq);
            acc[0] += __uint_as_float(w.x << 16); acc[1] += __uint_as_float(w.x & 0xffff0000u); acc[2] += __uint_as_float(w.y << 16); acc[3] += __uint_as_float(w.y & 0xffff0000u);
            o[tv] = acc; ss += (acc[0] * acc[0] + acc[1] * acc[1]) + (acc[2] * acc[2] + acc[3] * acc[3]);
        }
        ss += __shfl_xor(ss, 16); ss += __shfl_xor(ss, 32);
        const float rs = 1.0f / sqrtf(ss * (1.0f / 64.0f) + EPS);
#pragma unroll
        for (int tv = 0; tv < 4; ++tv) {
            const u32x2v gw = *(const u32x2v*)(PROJ + m * NPROJ + C_GG + h * 64 + 16 * tv + 4 * fq);
            const float g0 = __uint_as_float(gw.x << 16), g1 = __uint_as_float(gw.x & 0xffff0000u), g2 = __uint_as_float(gw.y << 16), g3 = __uint_as_float(gw.y & 0xffff0000u);
            u32x2v w; w.x = pk2(o[tv][0] * rs * gn[tv][0] * silu_(g0), o[tv][1] * rs * gn[tv][1] * silu_(g1)); w.y = pk2(o[tv][2] * rs * gn[tv][2] * silu_(g2), o[tv][3] * rs * gn[tv][3] * silu_(g3));
            *(u32x2v*)(MIX + m * DMIX + 768 + h * 64 + 16 * tv + 4 * fq) = w;
        }
    }
}

#define XB_TMO      128
#define XB_XCNT(j)  (256  + 64 * (j))
#define XB_XSUB(j)  (1280 + 64 * (j))
#define XB_XGEN(j)  (2304 + 64 * (j))
#define XB_TOP      3328
#define XB_TOPGEN   3392
#define XCD_BAR_WORDS 3456
#define XB_SPIN_CAP (1u << 18)

__device__ __forceinline__ unsigned xb_ld(unsigned* p)              { return __hip_atomic_load(p, __ATOMIC_RELAXED, __HIP_MEMORY_SCOPE_AGENT); }
__device__ __forceinline__ unsigned xb_add(unsigned* p, unsigned v) { return __hip_atomic_fetch_add(p, v, __ATOMIC_RELAXED, __HIP_MEMORY_SCOPE_AGENT); }
__device__ __forceinline__ unsigned xb_xcc_id() { return (unsigned)__builtin_amdgcn_s_getreg((3 << 11) | 20) & 0xFu; }
#define XB_SPIN(cond, bar) do { unsigned _sp = 0; while (cond) { __builtin_amdgcn_s_sleep(1); \
    if ((++_sp & 255u) == 0u) { if (xb_ld(&(bar)[XB_TMO])) break; if (_sp > XB_SPIN_CAP) { atomicAdd(&(bar)[XB_TMO], 1u); break; } } } } while (0)

struct XcdBarrier {
    unsigned* bar; unsigned x;
    volatile LAS unsigned* st;
};

__device__ __forceinline__ XcdBarrier xcd_barrier_post(unsigned* bar, volatile LAS unsigned* st) {
    XcdBarrier b; b.bar = bar; b.x = xb_xcc_id(); b.st = st;
    if (threadIdx.x == 0) (void)xb_add(&bar[XB_XCNT(b.x)], 1u);
    return b;
}
__device__ __forceinline__ void xcd_barrier_complete(unsigned* bar, unsigned x, unsigned& nloc, unsigned& nx) {
    const unsigned G = gridDim.x * gridDim.y * gridDim.z;
    unsigned sum, cnt, mine, sp = 0u;
    for (;;) {
        sum = 0u; cnt = 0u; mine = 0u;
#pragma unroll
        for (unsigned j = 0; j < 16; ++j) { const unsigned c = xb_ld(&bar[XB_XCNT(j)]); sum += c; cnt += (c > 0u) ? 1u : 0u; mine = (j == x) ? c : mine; }
        if (sum == G) break;
        __builtin_amdgcn_s_sleep(1);
        if ((++sp & 255u) == 0u) { if (xb_ld(&bar[XB_TMO])) break; if (sp > XB_SPIN_CAP) { atomicAdd(&bar[XB_TMO], 1u); break; } }
    }
    nloc = mine > 0u ? mine : 1u; nx = cnt > 0u ? cnt : 1u;
}

__device__ __forceinline__ void xcd_barrier(const XcdBarrier& b) {
    asm volatile("s_waitcnt vmcnt(0)" ::: "memory");
    __syncthreads();
    if (threadIdx.x == 0) {
        unsigned* bar = b.bar;
        __builtin_amdgcn_s_waitcnt(0);
        unsigned nloc = b.st[0], nx = b.st[1];
        if (nloc == 0u) { xcd_barrier_complete(bar, b.x, nloc, nx); b.st[0] = nloc; b.st[1] = nx; }
        const unsigned old = xb_add(&bar[XB_XSUB(b.x)], 1u);
        const unsigned gen = old / nloc;
        if (old + 1u == (gen + 1u) * nloc) {
            __builtin_amdgcn_fence(__ATOMIC_RELEASE, "agent");
            asm volatile("s_waitcnt vmcnt(0)" ::: "memory");
            const unsigned og = xb_add(&bar[XB_TOP], 1u);
            const unsigned tg = og / nx;
            if (og + 1u == (tg + 1u) * nx) xb_add(&bar[XB_TOPGEN], 1u);
            else XB_SPIN(xb_ld(&bar[XB_TOPGEN]) == tg, bar);
            __builtin_amdgcn_fence(__ATOMIC_ACQUIRE, "agent");
            xb_add(&bar[XB_XGEN(b.x)], 1u);
            asm volatile("s_waitcnt vmcnt(0)" ::: "memory");
        } else {
            XB_SPIN(xb_ld(&bar[XB_XGEN(b.x)]) == gen, bar);
            __builtin_amdgcn_fence(__ATOMIC_ACQUIRE, "agent");
            asm volatile("s_waitcnt vmcnt(0)" ::: "memory");
        }
    }
    __syncthreads();
}

#ifdef EXP_P2
#define EXP_KN_ONCE (rep_ == 0)
#else
#define EXP_KN_ONCE true
#endif
#define XBAR1() do { XcdBarrier b_; b_.bar = (unsigned*)P.ws + CW_BAR; b_.x = xb_xcc_id(); b_.st = (volatile LAS unsigned*)(lds + MISC_OFF + 32); xcd_barrier(b_); } while (0)
#ifdef EXP_SYNC
#define GSYNC() do { XBAR1(); XBAR1(); } while (0)
#else
#define GSYNC() XBAR1()
#endif
__global__ void __launch_bounds__(512, 2) hybrid_fwd(Params P) {
    extern __shared__ __attribute__((aligned(16))) unsigned char lds_raw[];
    cg::grid_group grid = cg::this_grid();
    LAS unsigned char* lds = (LAS unsigned char*)lds_raw;
    const int tid = threadIdx.x, lane = tid & 63, wid = __builtin_amdgcn_readfirstlane(tid >> 6);
    const int G = gridDim.x, gw = blockIdx.x * 8 + wid, NGW = G * 8;
    unsigned char* ws = P.ws;
    unsigned* ctl = (unsigned*)(ws + WS_CTL);
    volatile LAS int* slot = (volatile LAS int*)(lds + MISC_OFF);
    const float* MOD = (const float*)(ws + WS_MOD);
    bfr* XB = (bfr*)P.out;
    bfr* HN = (bfr*)(ws + WS_HN); bfr* PROJ = (bfr*)(ws + WS_PROJ); bfr* MIX = (bfr*)(ws + WS_MIX); bfr* GB = (bfr*)(ws + WS_PROJ);

    if (tid < 16) ((LAS unsigned*)(lds + MISC_OFF))[tid] = 0u;
    __syncthreads();
    (void)xcd_barrier_post(ctl + CW_BAR, (volatile LAS unsigned*)(lds + MISC_OFF + 32));
    p0_prologue(P, lds, tid, lane, wid, G);
#ifdef EXP_P0
    __syncthreads(); p0_prologue(P, lds, tid, lane, wid, G);
#endif
    grid.sync();

    for (int l = 0; l < DEPTH; ++l) {
        const float* modl = MOD + (size_t)l * NB * NMOD;
        bfr* XBm = l < DEPTH - 1 ? XB : (bfr*)(ws + WS_OINTRA);
        LayerPtrs L;
        L.conv_w = P.in[7] + (size_t)l * 4 * 384; L.conv_b = P.in[8] + (size_t)l * 384; L.b_r = P.in[10] + (size_t)l * 384; L.b_i = P.in[12] + (size_t)l * 384; L.lam = P.in[13] + (size_t)l * 384;
        L.fox_bf = P.in[14] + (size_t)l * 6; L.qgain = P.in[15] + (size_t)l * 64; L.kgain = P.in[16] + (size_t)l * 64;
        L.w_alpha = P.in[17] + (size_t)l * 16 * 256; L.b_alpha = P.in[18] + (size_t)l * 256; L.ogain = P.in[19] + (size_t)l * 64;
        L.lruw = (const bfr*)(ws + WS_LRUW) + (size_t)l * 6 * 2 * 4096;

        norm_phase(P.in[0], l == 0 ? (const bfr*)nullptr : XB, P.in[2] + (size_t)l * DMODEL, modl, 0, 1024, HN, gw, NGW, lane);
        GSYNC();
        {
            pg8::Gemm g{HN, (const bfr*)(ws + WS_WIN + l * WIN_L), MROWS, NPROJ, DMODEL}; pg8::StaticOrder S; S.init(MROWS, NPROJ, G, (int)blockIdx.x);
            pg8::EpiProj E{PROJ, NPROJ, L.qgain, L.kgain, C_FQ};
            pg8::gemm_phase<pg8::EpiProj, pg8::StaticOrder, PG8_ALIGN, PG8_SP2>(lds, g, S, E);
#ifdef EXP_G16
            __syncthreads(); pg8::gemm_phase<pg8::EpiBf16<0>, pg8::StaticOrder, PG8_ALIGN, PG8_SP2>(lds, g, S, E);
#endif
        }
        GSYNC();
        {
            constexpr int N_CUM = 24, N_GLA = 1024, N_LL = 6 * LRU_NCH * NB, N_KN = 0, N_P2 = N_CUM + N_GLA + N_LL + N_KN;
#ifdef EXP_P2
          for (int rep_ = 0; rep_ < 2; ++rep_) {
            unsigned* ctr = ctl + 64 * l + 16 + 8 * rep_;
#else
            unsigned* ctr = ctl + 64 * l + 16;
#endif
            int cur = blockIdx.x, itn = 0;
            while (cur < N_P2) {
                if (tid == 0) slot[itn & 1] = (int)atomicAdd(ctr, 1u) + G;
                if (cur < N_CUM) cum_item(cur, L, ws, lds, tid, lane, wid);
                else if (cur < N_CUM + N_GLA) gla_local_item(cur - N_CUM, L, ws, lds, tid, lane, wid);
                else if (cur < N_CUM + N_GLA + N_LL) lru_local_item(cur - N_CUM - N_GLA, L, ws, lds, tid, lane, wid);
                __syncthreads();
                cur = slot[itn & 1]; ++itn;
            }
#ifdef EXP_P2
            __syncthreads();
          }
#endif
        }
        GSYNC();
        {
            constexpr int N_ATT = 768, N_SCAN = 128, N_LRU = 384, N_GO = 256, N_ALL = N_ATT + N_SCAN + N_LRU + N_GO;
            unsigned* sdone = ctl + 64 * l + 48;
#ifdef EXP_P3
          for (int rep_ = 0; rep_ < 2; ++rep_) {
            unsigned* ctr = ctl + 64 * l + 32 * rep_;
#else
            unsigned* ctr = ctl + 64 * l;
#endif
            float skip_th;
            { int ln_ = lane; asm volatile("" : "+v"(ln_)); float gq = fabsf(L.qgain[ln_]), gk = fabsf(L.kgain[ln_]);
#pragma unroll
              for (int o = 1; o < 64; o <<= 1) { gq = fmaxf(gq, __shfl_xor(gq, o)); gk = fmaxf(gk, __shfl_xor(gk, o)); }
              skip_th = 150.0f + 2.0f * 11.7f * gq * gk; }
            int cur = blockIdx.x, itn = 0;
            while (cur < N_ALL) {
                if (tid == 0) slot[itn & 1] = (int)atomicAdd(ctr, 1u) + G;
                if (cur < N_SCAN) {
                    gla_scan_item(cur, ws, tid);
                    __syncthreads();
                    if (tid == 0) { __builtin_amdgcn_fence(__ATOMIC_RELEASE, "agent"); asm volatile("s_waitcnt vmcnt(0)" ::: "memory"); __hip_atomic_fetch_add(sdone + (cur >> 3), 1u, __ATOMIC_RELAXED, __HIP_MEMORY_SCOPE_AGENT); }
                } else if (cur < N_SCAN + N_ATT) {
                    const int ua = cur - N_SCAN; const int qb = 31 - ua / 24, bh = ua % 24, b = bh / 6, h = bh % 6;
                    attn_body::attn_unit<96>(b, h, qb, (const attn_body::bf16*)(PROJ + C_FQ), (const attn_body::bf16*)(PROJ + C_FK), (const attn_body::bf16*)(PROJ + C_FV), (attn_body::bf16*)(MIX + 384),
                                            (const float*)(ws + WS_CUM) + (size_t)bh * SEQ, L.qgain, skip_th, (char*)lds_raw);
                } else if (cur < N_SCAN + N_ATT + N_LRU) {
                    lru_out_item(cur - N_ATT - N_SCAN, ws, lds, tid, wid);
                } else {
                    const int gi = (cur - N_SCAN - N_ATT - N_LRU) * 8;
                    if (tid == 0) { unsigned sp = 0; while (__hip_atomic_load(sdone + (gi >> 7), __ATOMIC_RELAXED, __HIP_MEMORY_SCOPE_AGENT) < 8u) { __builtin_amdgcn_s_sleep(2); if (++sp > (1u << 22)) break; }
                        __builtin_amdgcn_fence(__ATOMIC_ACQUIRE, "agent"); asm volatile("s_waitcnt vmcnt(0)" ::: "memory"); }
                    __syncthreads();
                    gla_out_item(gi + wid, L, ws, lane);
                }
                __syncthreads();
                cur = slot[itn & 1]; ++itn;
            }
#ifdef EXP_P3
            __syncthreads();
          }
#endif
        }
        GSYNC();
        {
            pg8::Gemm g{MIX, (const bfr*)(ws + WS_WOUT + l * WOUT_L), MROWS, DMODEL, DMIX}; pg8::StaticOrder S; S.init(MROWS, DMODEL, G, (int)blockIdx.x);
            pg8::EpiResidB E{l == 0 ? P.in[0] : (const float*)nullptr, XB, XBm, (float*)nullptr, DMODEL, modl + 2048, NMOD, SEQ};
            pg8::gemm_phase<pg8::EpiResidB, pg8::StaticOrder, PG8_ALIGN, PG8_SP2>(lds, g, S, E);
        }
        GSYNC();
        norm_phase(P.in[0], XBm, P.in[3] + (size_t)l * DMODEL, modl, 3072, 4096, HN, gw, NGW, lane);
        GSYNC();
        {
            pg8::Gemm g{HN, (const bfr*)(ws + WS_WGU + l * WGU_L), MROWS, NGU, DMODEL}; pg8::StaticOrder S; S.init(MROWS, NGU, G, (int)blockIdx.x);
            pg8::EpiSwiGLU E{GB, DFF};
            pg8::gemm_phase<pg8::EpiSwiGLU, pg8::StaticOrder, PG8_ALIGN, PG8_SP2>(lds, g, S, E);
#ifdef EXP_G16
            __syncthreads(); pg8::gemm_phase<pg8::EpiSwiGLU, pg8::StaticOrder, PG8_ALIGN, PG8_SP2>(lds, g, S, E);
#endif
        }
        GSYNC();
        {
            pg8::Gemm g{GB, (const bfr*)(ws + WS_WDN + l * WDN_L), MROWS, DMODEL, DFF}; pg8::StaticOrder S; S.init(MROWS, DMODEL, G, (int)blockIdx.x);
            pg8::EpiResidB E{(const float*)nullptr, XBm, l < DEPTH - 1 ? XB : (bfr*)nullptr, l < DEPTH - 1 ? (float*)nullptr : P.out, DMODEL, modl + 5120, NMOD, SEQ};
            pg8::gemm_phase<pg8::EpiResidB, pg8::StaticOrder, PG8_ALIGN, PG8_SP2>(lds, g, S, E);
        }
        if (l < DEPTH - 1) GSYNC();
    }
}

extern "C" void kernel_launch(void* const* d_in, const int* in_sizes, int n_in, void* d_out, int out_size, void* d_ws, size_t ws_size, hipStream_t stream) {
    static int grid = 0;
    if (grid == 0) {
        if (n_in != 23 || out_size != MROWS * DMODEL || ws_size < WS_END) { fprintf(stderr, "kernel_launch: unexpected shapes (n_in %d out %d ws %zu)\n", n_in, out_size, ws_size); grid = -1; return; }
        int dev = 0, cus = 0, per_cu = 0;
        if (hipGetDevice(&dev) != hipSuccess || hipDeviceGetAttribute(&cus, hipDeviceAttributeMultiprocessorCount, dev) != hipSuccess) { grid = -1; return; }
        if (hipFuncSetAttribute((const void*)hybrid_fwd, hipFuncAttributeMaxDynamicSharedMemorySize, LDS_BYTES) != hipSuccess) { fprintf(stderr, "kernel_launch: hipFuncSetAttribute failed\n"); grid = -1; return; }
        if (hipOccupancyMaxActiveBlocksPerMultiprocessor(&per_cu, (const void*)hybrid_fwd, 512, LDS_BYTES) != hipSuccess || per_cu < 1) { fprintf(stderr, "kernel_launch: occupancy query says %d\n", per_cu); per_cu = 1; }
        (void)hipGetLastError();
        grid = cus;
    }
    if (grid < 0) return;
    (void)hipMemsetAsync((char*)d_ws + WS_CTL, 0, CTL_BYTES, stream);
    Params p{};
    for (int i = 0; i < 23; ++i) p.in[i] = (const float*)d_in[i];
    p.out = (float*)d_out; p.ws = (unsigned char*)d_ws;
    void* args[] = {&p};
    hipError_t e = hipLaunchCooperativeKernel((const void*)hybrid_fwd, dim3(grid), dim3(512), args, LDS_BYTES, stream);
    if (e != hipSuccess) fprintf(stderr, "kernel_launch: cooperative launch failed: %s (grid %d)\n", hipGetErrorString(e), grid);
}
```

```cpp
#include <hip/hip_runtime.h>
#include <hip/hip_cooperative_groups.h>
#include <hip/hip_bf16.h>
#include <cstdio>
#include <cstdint>
#include <cmath>
namespace cg = cooperative_groups;
namespace pg8 {
#define PG8_LAS __attribute__((address_space(3)))
typedef unsigned short bf16_t;
typedef short bf16x8 __attribute__((ext_vector_type(8)));
typedef float f32x4 __attribute__((ext_vector_type(4)));
typedef unsigned u32x4 __attribute__((ext_vector_type(4)));
constexpr int BM = 256, BK = 64, HALF = 128, HTB = HALF * BK * 2  , STAGE_BYTES = 8 * HTB, NXCD = 8, WGM = 8;

__host__ __device__ __forceinline__ int lds_byte(int r, int c) { const int st = (r >> 4) * 2 + (c >> 5), rr = r & 15, cc = c & 31, ob = rr * 64 + cc * 2; return st * 1024 + (ob ^ (((ob >> 9) & 1) << 5)); }
__host__ __device__ __forceinline__ void stage_rc(int b, int& R, int& C) { const int st = b / 1024, sb = b % 1024, swz = sb ^ (((sb >> 9) & 1) << 5); R = (st >> 1) * 16 + swz / 64; C = (st & 1) * 32 + (swz % 64) / 2; }
__host__ __device__ __forceinline__ int perm32(int rho) { const int n = rho >> 4, i = rho & 15; return 8 * (i >> 2) + 4 * n + (i & 3); }

struct Unit { int pm, pn; };
struct Gemm { const bf16_t* A; const bf16_t* Bt; int M, N, K; };

struct StaticOrder {
    int nM, nN, nwg, G, c;
    __host__ __device__ void init(int M, int N, int G_, int c_) { nM = M / BM; nN = N / BM; nwg = nM * nN; G = G_; c = c_; }
    __host__ __device__ bool next(int i, Unit& u) const {
        const long L = (long)i * G + c; if (L >= nwg) return false;
        int wgid = (int)L; { const int q = nwg / NXCD, r = nwg % NXCD, xcd = wgid % NXCD, off = wgid / NXCD; wgid = (xcd < r ? xcd * (q + 1) : r * (q + 1) + (xcd - r) * q) + off; }
        const int nig = WGM * nN, gid = wgid / nig, fm = gid * WGM, gsz = (nM - fm) < WGM ? (nM - fm) : WGM;
        u.pm = fm + ((wgid % nig) % gsz); u.pn = (wgid % nig) / gsz; return true;
    }
    __device__ __forceinline__ void a_ready(const Unit&) const {}
    __device__ __forceinline__ void done(const Unit&) const {}
};

__device__ __forceinline__ unsigned cvt_pk_bf16(float lo, float hi) { unsigned r; asm volatile("v_cvt_pk_bf16_f32 %0, %1, %2" : "=v"(r) : "v"(lo), "v"(hi)); return r; }
typedef float f32x2 __attribute__((ext_vector_type(2)));
__device__ __forceinline__ f32x2 gelu_pk(f32x2 v) {
    const f32x2 av = __builtin_elementwise_abs(v), d = av * 0.2316418882f + 1.0f;
    f32x2 t; t.x = __builtin_amdgcn_rcpf(d.x); t.y = __builtin_amdgcn_rcpf(d.y);
    f32x2 q = t * 0.5307027145f + (-0.7265760135f); q = q * t + 0.7107068705f; q = q * t + (-0.142248368f); q = q * t + 0.127414796f; q = q * t;
    const f32x2 s = (v * v) * (-0.72134752044f);
    f32x2 e; e.x = __builtin_amdgcn_exp2f(s.x); e.y = __builtin_amdgcn_exp2f(s.y);
    const f32x2 m = v * (q * e), r = v - m;
    f32x2 o; o.x = v.x < 0.f ? m.x : r.x; o.y = v.y < 0.f ? m.y : r.y; return o;
}

template <int ACT  > struct EpiBf16 {
    static constexpr bool PERM = true, AFTER_DRAIN = false; static_assert(ACT == 0 || ACT == 1, "EpiBf16: ACT is 0 (none) or 1 (gelu_pk)");
    bf16_t* O; int ldc; const float* bias; int split_cols; size_t split_stride; float scale0;
    __device__ __forceinline__ void operator()(const f32x4 (&acc)[2][2][4][2], const Unit& u, int wr, int wc, int fr, int fq) const {
        const int row0 = u.pm * BM + wr * 64 + fr; int colt = u.pn * BM; bf16_t* base = O;
        float sc = 1.f; if (split_cols) { const int t = colt / split_cols; base += (size_t)t * split_stride; colt -= t * split_cols; if (t == 0) sc = scale0; }
        const int col0 = colt + wc * 32 + 8 * fq, bcol0 = u.pn * BM + wc * 32 + 8 * fq;
        f32x4 bv[2][2];
#pragma unroll
        for (int bj = 0; bj < 2; ++bj)
#pragma unroll
            for (int n = 0; n < 2; ++n) bv[bj][n] = bias ? *(const f32x4*)(bias + bcol0 + bj * HALF + 4 * n) : (f32x4){0.f, 0.f, 0.f, 0.f};
#pragma unroll
        for (int ai = 0; ai < 2; ++ai)
#pragma unroll
            for (int m = 0; m < 4; ++m) { bf16_t* rowp = base + (size_t)(row0 + ai * HALF + m * 16) * ldc + col0;
#pragma unroll
                for (int bj = 0; bj < 2; ++bj) { f32x4 v0 = acc[ai][bj][m][0] + bv[bj][0], v1 = acc[ai][bj][m][1] + bv[bj][1];
                    if (ACT == 1) { f32x2 a = gelu_pk((f32x2){v0[0], v0[1]}), b = gelu_pk((f32x2){v0[2], v0[3]}), c = gelu_pk((f32x2){v1[0], v1[1]}), d = gelu_pk((f32x2){v1[2], v1[3]});
                        v0 = (f32x4){a.x, a.y, b.x, b.y}; v1 = (f32x4){c.x, c.y, d.x, d.y}; }
                    v0 = v0 * sc; v1 = v1 * sc; u32x4 w; w.x = cvt_pk_bf16(v0[0], v0[1]); w.y = cvt_pk_bf16(v0[2], v0[3]); w.z = cvt_pk_bf16(v1[0], v1[1]); w.w = cvt_pk_bf16(v1[2], v1[3]);
                    *(u32x4*)(rowp + bj * HALF) = w; } }
    }
};


struct EpiProj {
    static constexpr bool PERM = true, AFTER_DRAIN = false;
    bf16_t* O; int ldc; const float* qgain; const float* kgain; int cfq;
    __device__ __forceinline__ void operator()(const f32x4 (&acc)[2][2][4][2], const Unit& u, int wr, int wc, int fr, int fq) const {
        const int row0 = u.pm * BM + wr * 64 + fr;
        if (u.pn < 3 || u.pn > 5) {
            const int col0 = u.pn * BM + wc * 32 + 8 * fq;
#pragma unroll
            for (int ai = 0; ai < 2; ++ai)
#pragma unroll
                for (int m = 0; m < 4; ++m) { bf16_t* rowp = O + (size_t)(row0 + ai * HALF + m * 16) * ldc + col0;
#pragma unroll
                    for (int bj = 0; bj < 2; ++bj) { const f32x4 v0 = acc[ai][bj][m][0], v1 = acc[ai][bj][m][1];
                        u32x4 w; w.x = cvt_pk_bf16(v0[0], v0[1]); w.y = cvt_pk_bf16(v0[2], v0[3]); w.z = cvt_pk_bf16(v1[0], v1[1]); w.w = cvt_pk_bf16(v1[2], v1[3]);
                        *(u32x4*)(rowp + bj * HALF) = w; } }
        } else {
            const int H = 4 * (u.pn - 3) + wc;
            const float* gp = (H < 6 ? qgain : kgain) + 8 * fq; const float sc = H < 6 ? 0.125f * 1.4426950408889634f : 1.0f;
            f32x4 gv[2][2];
#pragma unroll
            for (int bj = 0; bj < 2; ++bj)
#pragma unroll
                for (int n = 0; n < 2; ++n) gv[bj][n] = *(const f32x4*)(gp + 32 * bj + 4 * n) * sc;
            const int col0 = cfq + H * 64 + 8 * fq;
#pragma unroll
            for (int ai = 0; ai < 2; ++ai)
#pragma unroll
                for (int m = 0; m < 4; ++m) { bf16_t* rowp = O + (size_t)(row0 + ai * HALF + m * 16) * ldc + col0;
                    float ss = 0.f;
#pragma unroll
                    for (int bj = 0; bj < 2; ++bj)
#pragma unroll
                        for (int n = 0; n < 2; ++n) { const f32x4 x = acc[ai][bj][m][n]; ss += (x[0] * x[0] + x[1] * x[1]) + (x[2] * x[2] + x[3] * x[3]); }
                    ss += __shfl_xor(ss, 16); ss += __shfl_xor(ss, 32);
                    const float rs = __builtin_amdgcn_rsqf(ss * (1.0f / 64.0f) + 1e-6f);
#pragma unroll
                    for (int bj = 0; bj < 2; ++bj) { const f32x4 v0 = acc[ai][bj][m][0] * rs * gv[bj][0], v1 = acc[ai][bj][m][1] * rs * gv[bj][1];
                        u32x4 w; w.x = cvt_pk_bf16(v0[0], v0[1]); w.y = cvt_pk_bf16(v0[2], v0[3]); w.z = cvt_pk_bf16(v1[0], v1[1]); w.w = cvt_pk_bf16(v1[2], v1[3]);
                        *(u32x4*)(rowp + 32 * bj) = w; } }
        }
    }
};
struct EpiSwiGLU {
    static constexpr bool PERM = true, AFTER_DRAIN = false;
    bf16_t* O; int ldc;
    __device__ __forceinline__ void operator()(const f32x4 (&acc)[2][2][4][2], const Unit& u, int wr, int wc, int fr, int fq) const {
        const int row0 = u.pm * BM + wr * 64 + fr; const int col0 = u.pn * HALF + wc * 32 + 8 * fq;
#pragma unroll
        for (int ai = 0; ai < 2; ++ai)
#pragma unroll
            for (int m = 0; m < 4; ++m) { bf16_t* rowp = O + (size_t)(row0 + ai * HALF + m * 16) * ldc + col0;
                float o[8];
#pragma unroll
                for (int n = 0; n < 2; ++n)
#pragma unroll
                    for (int j = 0; j < 4; ++j) { const float g = acc[ai][0][m][n][j], up = acc[ai][1][m][n][j];
                        const float sg = g * __builtin_amdgcn_rcpf(1.0f + __builtin_amdgcn_exp2f(-1.4426950408889634f * g)); o[n * 4 + j] = sg * up; }
                u32x4 w; w.x = cvt_pk_bf16(o[0], o[1]); w.y = cvt_pk_bf16(o[2], o[3]); w.z = cvt_pk_bf16(o[4], o[5]); w.w = cvt_pk_bf16(o[6], o[7]);
                *(u32x4*)rowp = w; }
    }
};
struct EpiResid {
    static constexpr bool PERM = false, AFTER_DRAIN = false;
    const float* base; float* out; int ldc; const float* gate; int gstride; int rows_per_batch;
    __device__ __forceinline__ void operator()(const f32x4 (&acc)[2][2][4][2], const Unit& u, int wr, int wc, int fr, int fq) const {
        const int col0 = u.pn * BM + wc * 32 + 4 * fq;
        const float* gp = gate + (size_t)((u.pm * BM) / rows_per_batch) * gstride + col0;
        f32x4 gv[2][2];
#pragma unroll
        for (int bj = 0; bj < 2; ++bj)
#pragma unroll
            for (int n = 0; n < 2; ++n) gv[bj][n] = *(const f32x4*)(gp + bj * HALF + n * 16);
#pragma unroll
        for (int ai = 0; ai < 2; ++ai)
#pragma unroll
            for (int m = 0; m < 4; ++m) { const size_t off = (size_t)(u.pm * BM + ai * HALF + wr * 64 + m * 16 + fr) * ldc + col0;
#pragma unroll
                for (int bj = 0; bj < 2; ++bj)
#pragma unroll
                    for (int n = 0; n < 2; ++n) { const f32x4 bs = *(const f32x4*)(base + off + bj * HALF + n * 16);
                        *(f32x4*)(out + off + bj * HALF + n * 16) = bs + gv[bj][n] * acc[ai][bj][m][n]; } }
    }
};


typedef _Float16 h16x2 __attribute__((ext_vector_type(2)));
__device__ __forceinline__ f32x2 h2f(unsigned w) { return __builtin_convertvector(__builtin_bit_cast(h16x2, w), f32x2); }
__device__ __forceinline__ unsigned f2h(float lo, float hi) { f32x2 v = {lo, hi}; return __builtin_bit_cast(unsigned, __builtin_convertvector(v, h16x2)); }
struct EpiResidB {
    static constexpr bool PERM = true, AFTER_DRAIN = false;
    const float* base32; const bf16_t* base16; bf16_t* out16; float* out32; int ldc; const float* gate; int gstride; int rows_per_batch;
    __device__ __forceinline__ void operator()(const f32x4 (&acc)[2][2][4][2], const Unit& u, int wr, int wc, int fr, int fq) const {
        const int row0 = u.pm * BM + wr * 64 + fr; const int col0 = u.pn * BM + wc * 32 + 8 * fq;
        const float* gp = gate + (size_t)((u.pm * BM) / rows_per_batch) * gstride + col0;
        f32x4 gv[2][2];
#pragma unroll
        for (int bj = 0; bj < 2; ++bj)
#pragma unroll
            for (int n = 0; n < 2; ++n) gv[bj][n] = *(const f32x4*)(gp + bj * HALF + 4 * n);
#pragma unroll
        for (int ai = 0; ai < 2; ++ai)
#pragma unroll
            for (int m = 0; m < 4; ++m) { const size_t off = (size_t)(row0 + ai * HALF + m * 16) * ldc + col0;
#pragma unroll
                for (int bj = 0; bj < 2; ++bj) {
                    f32x4 b0, b1;
                    if (base32) { b0 = *(const f32x4*)(base32 + off + bj * HALF); b1 = *(const f32x4*)(base32 + off + bj * HALF + 4); }
                    else { const u32x4 w = *(const u32x4*)(base16 + off + bj * HALF);
                        const f32x2 p0 = h2f(w.x), p1 = h2f(w.y), p2 = h2f(w.z), p3 = h2f(w.w);
                        b0 = (f32x4){p0.x, p0.y, p1.x, p1.y}; b1 = (f32x4){p2.x, p2.y, p3.x, p3.y}; }
                    const f32x4 v0 = b0 + gv[bj][0] * acc[ai][bj][m][0], v1 = b1 + gv[bj][1] * acc[ai][bj][m][1];
                    if (out32) { *(f32x4*)(out32 + off + bj * HALF) = v0; *(f32x4*)(out32 + off + bj * HALF + 4) = v1; }
                    else { u32x4 w; w.x = f2h(v0[0], v0[1]); w.y = f2h(v0[2], v0[3]); w.z = f2h(v1[0], v1[1]); w.w = f2h(v1[2], v1[3]); *(u32x4*)(out16 + off + bj * HALF) = w; } } }
    }
};

template <class Epi, class Sched, bool ALIGN_EPI = false, bool SP2 = false>
__device__ __forceinline__ void gemm_phase(PG8_LAS unsigned char* lds, const Gemm g, const Sched& S, const Epi& E) {
    int tid = threadIdx.x; asm volatile("" : "+v"(tid)); const int wid = __builtin_amdgcn_readfirstlane(tid >> 6), lane = tid & 63, wr = wid >> 2, wc = wid & 3, fr = lane & 15, fq = lane >> 4;
    const int K = g.K, nt = K / BK;
    unsigned voffA[2], voffB[2];
#pragma unroll
    for (int i = 0; i < 2; ++i) { int R, C; stage_rc(tid * 16 + i * 8192, R, C); const int Rb = Epi::PERM ? ((R & ~31) + perm32(R & 31)) : R;
        voffA[i] = (unsigned)(R * K + C) * 2u; voffB[i] = (unsigned)(Rb * K + C) * 2u; }
    const size_t kstep = (size_t)(BK * 2);
    const size_t hstep = (size_t)HALF * K * 2;
    const size_t tstep = 2 * hstep;
    const unsigned ldsw = (unsigned)wid * 1024u;
    const int aoff = lds_byte(wr * 64 + fr, fq * 8), boff = lds_byte(wc * 32 + fr, fq * 8);
#define PG8_SA(b, h) (((b) * 2 + (h)) * HTB)
#define PG8_SB(b, h) ((4 + (b) * 2 + (h)) * HTB)
#define PG8_STAGE(bufoff, gbase, voff) do { _Pragma("unroll") for (int _i = 0; _i < 2; ++_i) \
        __builtin_amdgcn_global_load_lds((const unsigned*)((const char*)(gbase) + (voff)[_i]), (PG8_LAS unsigned*)(lds + (bufoff) + ldsw + _i * 8192), 16, 0, 0); } while (0)
#define PG8_LDA(dst, b, h) do { _Pragma("unroll") for (int m = 0; m < 4; ++m) _Pragma("unroll") for (int k = 0; k < 2; ++k) dst[m][k] = *(const PG8_LAS bf16x8*)(lds + PG8_SA(b, h) + aoff + m * 2048 + k * 1024); } while (0)
#define PG8_LDB(dst, b, h) do { _Pragma("unroll") for (int n = 0; n < 2; ++n) _Pragma("unroll") for (int k = 0; k < 2; ++k) dst[n][k] = *(const PG8_LAS bf16x8*)(lds + PG8_SB(b, h) + boff + n * 2048 + k * 1024); } while (0)
#define PG8_MMA(ai, bj, At, Bt) do { __builtin_amdgcn_s_setprio(1); _Pragma("unroll") for (int m = 0; m < 4; ++m) _Pragma("unroll") for (int n = 0; n < 2; ++n) _Pragma("unroll") for (int k = 0; k < 2; ++k) \
        acc[ai][bj][m][n] = __builtin_amdgcn_mfma_f32_16x16x32_bf16(Bt[n][k], At[m][k], acc[ai][bj][m][n], 0, 0, 0); __builtin_amdgcn_s_setprio(0); } while (0)
#define PG8_WAIT_V(n) asm volatile("s_waitcnt vmcnt(" #n ")" ::: "memory")
#define PG8_WAIT_L(n) asm volatile("s_waitcnt lgkmcnt(" #n ")" ::: "memory")
#define PG8_BAR __builtin_amdgcn_s_barrier()
#define PG8_SCHED __builtin_amdgcn_sched_barrier(0)
    Unit cur, nxt; int ui = 0;
    if (!S.next(0, cur)) return;
    f32x4 acc[2][2][4][2];
#pragma unroll
    for (int a = 0; a < 2; ++a)
#pragma unroll
        for (int b = 0; b < 2; ++b)
#pragma unroll
            for (int m = 0; m < 4; ++m)
#pragma unroll
                for (int n = 0; n < 2; ++n) acc[a][b][m][n] = (f32x4){0.f, 0.f, 0.f, 0.f};
    bf16x8 At[4][2], B0[2][2], B1[2][2];
    const char* cA = (const char*)g.A + (size_t)cur.pm * tstep; const char* cB = (const char*)g.Bt + (size_t)cur.pn * tstep;
    S.a_ready(cur);
    if constexpr (SP2) {
        PG8_STAGE(PG8_SB(0, 0), cB, voffB); PG8_STAGE(PG8_SB(0, 1), cB + hstep, voffB); PG8_STAGE(PG8_SA(0, 0), cA, voffA); PG8_STAGE(PG8_SA(0, 1), cA + hstep, voffA);
        if (wr == 1) PG8_BAR;
        PG8_WAIT_V(2); PG8_BAR;
        PG8_STAGE(PG8_SB(1, 0), cB + kstep, voffB); PG8_STAGE(PG8_SA(1, 0), cA + kstep, voffA); PG8_STAGE(PG8_SB(1, 1), cB + hstep + kstep, voffB);
        PG8_WAIT_V(6); PG8_BAR;
    } else {
        PG8_STAGE(PG8_SB(0, 0), cB, voffB); PG8_STAGE(PG8_SA(0, 0), cA, voffA); PG8_STAGE(PG8_SB(0, 1), cB + hstep, voffB); PG8_STAGE(PG8_SA(0, 1), cA + hstep, voffA);
        if (wr == 1) PG8_BAR;
        PG8_WAIT_V(4); PG8_BAR;
        PG8_STAGE(PG8_SB(1, 0), cB + kstep, voffB); PG8_STAGE(PG8_SA(1, 0), cA + kstep, voffA); PG8_STAGE(PG8_SB(1, 1), cB + hstep + kstep, voffB);
        PG8_WAIT_V(6); PG8_BAR;
    }
    for (;;) {
        const bool has_next = S.next(ui + 1, nxt);
        const char* nA = has_next ? (const char*)g.A + (size_t)nxt.pm * tstep : cA; const char* nB = has_next ? (const char*)g.Bt + (size_t)nxt.pn * tstep : cB;
        for (int t = 0; t < nt; t += 2) {
            const bool last = (t == nt - 2);
            const char* a1 = cA + (size_t)(t + 1) * kstep;
            const char* a2 = last ? nA : cA + (size_t)(t + 2) * kstep; const char* b2 = last ? nB : cB + (size_t)(t + 2) * kstep;
            const char* a3 = a2 + kstep; const char* b3 = b2 + kstep;
            if (last && has_next) S.a_ready(nxt);
            if constexpr (SP2) {
            PG8_LDB(B0, 0, 0); PG8_LDB(B1, 0, 1); PG8_SCHED; PG8_LDA(At, 0, 0); PG8_STAGE(PG8_SA(1, 1), a1 + hstep, voffA);
            PG8_WAIT_V(8); PG8_WAIT_L(0); PG8_BAR; PG8_MMA(0, 0, At, B0); PG8_MMA(0, 1, At, B1); PG8_BAR; PG8_SCHED;
            PG8_LDA(At, 0, 1); PG8_STAGE(PG8_SB(0, 0), b2, voffB); PG8_STAGE(PG8_SB(0, 1), b2 + hstep, voffB); PG8_STAGE(PG8_SA(0, 0), a2, voffA);
            PG8_WAIT_V(8); PG8_WAIT_L(0); PG8_BAR; PG8_MMA(1, 0, At, B0); PG8_MMA(1, 1, At, B1); PG8_BAR; PG8_SCHED;
            PG8_LDB(B0, 1, 0); PG8_LDB(B1, 1, 1); PG8_SCHED; PG8_LDA(At, 1, 0); PG8_STAGE(PG8_SA(0, 1), a2 + hstep, voffA);
            PG8_WAIT_V(8); PG8_WAIT_L(0); PG8_BAR; PG8_MMA(0, 0, At, B0); PG8_MMA(0, 1, At, B1); PG8_BAR; PG8_SCHED;
            PG8_LDA(At, 1, 1); PG8_STAGE(PG8_SB(1, 0), b3, voffB); PG8_STAGE(PG8_SB(1, 1), b3 + hstep, voffB); PG8_STAGE(PG8_SA(1, 0), a3, voffA);
            PG8_WAIT_V(8); PG8_WAIT_L(0); PG8_BAR; PG8_MMA(1, 0, At, B0); PG8_MMA(1, 1, At, B1); PG8_BAR; PG8_SCHED;
            } else {
            PG8_LDB(B0, 0, 0); PG8_SCHED; PG8_LDA(At, 0, 0); PG8_STAGE(PG8_SA(1, 1), a1 + hstep, voffA);
            PG8_WAIT_L(8); PG8_BAR; PG8_WAIT_L(0); PG8_MMA(0, 0, At, B0); PG8_BAR; PG8_SCHED;
            PG8_LDB(B1, 0, 1); PG8_STAGE(PG8_SB(0, 0), b2, voffB);
            PG8_BAR; PG8_WAIT_L(0); PG8_MMA(0, 1, At, B1); PG8_BAR;
            PG8_LDA(At, 0, 1); PG8_STAGE(PG8_SA(0, 0), a2, voffA);
            PG8_BAR; PG8_WAIT_L(0); PG8_MMA(1, 0, At, B0); PG8_BAR; PG8_SCHED;
            PG8_STAGE(PG8_SB(0, 1), b2 + hstep, voffB);
            PG8_WAIT_V(6); PG8_BAR; PG8_MMA(1, 1, At, B1); PG8_BAR;
            PG8_LDB(B0, 1, 0); PG8_SCHED; PG8_LDA(At, 1, 0); PG8_STAGE(PG8_SA(0, 1), a2 + hstep, voffA);
            PG8_WAIT_L(8); PG8_BAR; PG8_WAIT_L(0); PG8_MMA(0, 0, At, B0); PG8_BAR; PG8_SCHED;
            PG8_LDB(B1, 1, 1); PG8_STAGE(PG8_SB(1, 0), b3, voffB);
            PG8_BAR; PG8_WAIT_L(0); PG8_MMA(0, 1, At, B1); PG8_BAR;
            PG8_LDA(At, 1, 1); PG8_STAGE(PG8_SA(1, 0), a3, voffA);
            PG8_BAR; PG8_WAIT_L(0); PG8_MMA(1, 0, At, B0); PG8_BAR; PG8_SCHED;
            PG8_STAGE(PG8_SB(1, 1), b3 + hstep, voffB);
            PG8_WAIT_V(6); PG8_BAR; PG8_MMA(1, 1, At, B1); PG8_BAR;
            }
        }
        if constexpr (ALIGN_EPI) { if (wr == 0) PG8_BAR; }
        if constexpr (!Epi::AFTER_DRAIN) { E(acc, cur, wr, wc, fr, fq); S.done(cur); }
        if (!has_next) break;
#pragma unroll
        for (int a = 0; a < 2; ++a)
#pragma unroll
            for (int b = 0; b < 2; ++b)
#pragma unroll
                for (int m = 0; m < 4; ++m)
#pragma unroll
                    for (int n = 0; n < 2; ++n) acc[a][b][m][n] = (f32x4){0.f, 0.f, 0.f, 0.f};
        cur = nxt; cA = nA; cB = nB; ++ui;
        if constexpr (ALIGN_EPI) { if (wr == 1) PG8_BAR; }
    }
    PG8_WAIT_V(0);
    if constexpr (!ALIGN_EPI) { if (wr == 0) PG8_BAR; }
    PG8_BAR;
    if constexpr (Epi::AFTER_DRAIN) { E.fused(acc, cur, wr, wc, fr, fq, lds, wid, lane); S.done(cur); }
#undef PG8_SA
#undef PG8_SB
#undef PG8_STAGE
#undef PG8_LDA
#undef PG8_LDB
#undef PG8_MMA
#undef PG8_WAIT_V
#undef PG8_WAIT_L
#undef PG8_BAR
#undef PG8_SCHED
}
}

#ifndef PG8_SP2
#define PG8_SP2 true
#endif
#ifndef PG8_ALIGN
#define PG8_ALIGN true
#endif
#include <hip/hip_bf16.h>
#include <cmath>
namespace attn_body {
using bf16=__hip_bfloat16;
using bf16x8=__attribute__((ext_vector_type(8)))short;
using s16x4=__attribute__((ext_vector_type(4)))short;
using f32x16=__attribute__((ext_vector_type(16)))float;
using u32x4=__attribute__((ext_vector_type(4)))unsigned;
constexpr int BATCH=4,NHEAD=6,SEQ=8192,D=64,DM=3072,ODM=1024;
constexpr int NW=8,QBLK=32,QB=QBLK*NW,KVBLK=64,NQB=SEQ/QB;
constexpr int ATTN_PITCH=DM, ATTN_UNIT_ROWS=QB;
__device__ __forceinline__ int crow(int r,int hi){return (r&3)+8*(r>>2)+4*hi;}
#define SBAR() __builtin_amdgcn_sched_barrier(0)
__device__ __forceinline__ void cmask(f32x16&p0,f32x16&p1,int jb,int qrel,int hi){
  const float NEG=-INFINITY; int kb=64*jb+4*hi;
  #pragma unroll
  for(int r=0;r<16;++r){int kv=kb+(r&3)+8*(r>>2); if(kv>qrel)p0[r]=NEG; if(kv+32>qrel)p1[r]=NEG;}
}

constexpr int NSLOT=3, SLOTB=8192;
constexpr int LDS_K=0, LDS_V=NSLOT*SLOTB, LDS_WS=2*NSLOT*SLOTB, LDS_OST=LDS_WS+NW*64*4, LDS_CKS=LDS_OST+NW*4096, LDS_BYTES=LDS_CKS+SEQ*4;
constexpr float C2=0.125f*1.4426950408889634f;
__device__ __forceinline__ void glds16(const void*gsrc,unsigned lds_dst){unsigned keep;
  asm volatile("s_mov_b32 %0, m0\n\ts_mov_b32 m0, %2\n\ts_nop 0\n\tglobal_load_lds_dwordx4 %1, off\n\ts_mov_b32 m0, %0":"=&s"(keep):"v"(gsrc),"s"(lds_dst):"memory");}
__device__ __forceinline__ float max3f(float a,float b,float c){float r;asm("v_max3_f32 %0, %1, %2, %3":"=v"(r):"v"(a),"v"(b),"v"(c));return r;}
__device__ __forceinline__ float max2f(float a,float b){float r;asm("v_max_f32_e32 %0, %1, %2":"=v"(r):"v"(a),"v"(b));return r;}
__device__ __forceinline__ float fadd_s(float a,float b){float r;asm("v_add_f32_e32 %0, %1, %2":"=v"(r):"v"(a),"v"(b));return r;}
__device__ __forceinline__ float fsub_s(float a,float b){float r;asm("v_sub_f32_e32 %0, %1, %2":"=v"(r):"v"(a),"v"(b));return r;}
typedef float f32x2_t __attribute__((ext_vector_type(2))); typedef __bf16 bf16x2_t __attribute__((ext_vector_type(2)));
__device__ __forceinline__ unsigned cvtpk_s(float lo,float hi){f32x2_t v={lo,hi};bf16x2_t b=__builtin_convertvector(v,bf16x2_t);return __builtin_bit_cast(unsigned,b);}
#define WAIT_BAR(N) asm volatile("s_waitcnt vmcnt(" #N ") lgkmcnt(0)\n\ts_barrier":::"memory")

__device__ __forceinline__ void qkt(f32x16&p0,f32x16&p1,const char*Kslot,const bf16x8*qr,const f32x16&negm,int r32,int hi){
  const char*kb=Kslot+hi*1024+r32*16;
  #pragma unroll
  for(int d0=0;d0<4;++d0){
    const bf16x8 b0=*reinterpret_cast<const bf16x8*>(kb+d0*2048);
    const bf16x8 b1=*reinterpret_cast<const bf16x8*>(kb+d0*2048+512);
    if(d0==0){p0=__builtin_amdgcn_mfma_f32_32x32x16_bf16(b0,qr[0],negm,0,0,0);p1=__builtin_amdgcn_mfma_f32_32x32x16_bf16(b1,qr[0],negm,0,0,0);}
    else{p0=__builtin_amdgcn_mfma_f32_32x32x16_bf16(b0,qr[d0],p0,0,0,0);p1=__builtin_amdgcn_mfma_f32_32x32x16_bf16(b1,qr[d0],p1,0,0,0);}}
}
typedef __attribute__((address_space(3))) const char* lds_cptr;
typedef short v4i16_t __attribute__((ext_vector_type(4)));
__device__ __forceinline__ void kload8(bf16x8*kf,lds_cptr kp){
  kf[0]=*(const __attribute__((address_space(3))) bf16x8*)(kp);      kf[1]=*(const __attribute__((address_space(3))) bf16x8*)(kp+512);
  kf[2]=*(const __attribute__((address_space(3))) bf16x8*)(kp+2048); kf[3]=*(const __attribute__((address_space(3))) bf16x8*)(kp+2560);
  kf[4]=*(const __attribute__((address_space(3))) bf16x8*)(kp+4096); kf[5]=*(const __attribute__((address_space(3))) bf16x8*)(kp+4608);
  kf[6]=*(const __attribute__((address_space(3))) bf16x8*)(kp+6144); kf[7]=*(const __attribute__((address_space(3))) bf16x8*)(kp+6656);
}
__device__ __forceinline__ void kload2(bf16x8*kf,lds_cptr kp,int j){ kf[2*j]=*(const __attribute__((address_space(3))) bf16x8*)(kp+j*2048); kf[2*j+1]=*(const __attribute__((address_space(3))) bf16x8*)(kp+j*2048+512); }
__device__ __forceinline__ s16x4 vtr(lds_cptr p){ return __builtin_bit_cast(s16x4,__builtin_amdgcn_ds_read_tr16_b64_v4i16((__attribute__((address_space(3))) v4i16_t*)p)); }
__device__ __forceinline__ float rowmax(const f32x16&p0,const f32x16&p1){
  float a=max3f(p0[0],p0[1],p1[0]),b=max3f(p0[2],p0[3],p1[1]);a=max3f(a,p1[2],p1[3]);
  #pragma unroll
  for(int r=4;r<16;r+=4){a=max3f(a,p0[r],p0[r+1]);b=max3f(b,p0[r+2],p0[r+3]);a=max3f(a,p1[r],p1[r+1]);b=max3f(b,p1[r+2],p1[r+3]);}
  const float m=max2f(a,b);
  auto rr=__builtin_amdgcn_permlane32_swap(__float_as_uint(m),__float_as_uint(m),false,false);
  return max2f(__uint_as_float(rr[0]),__uint_as_float(rr[1]));
}
__device__ __forceinline__ void pv(f32x16*o,int vb,bf16x8 pa0,bf16x8 pa1,bf16x8 pa2,bf16x8 pa3){
  #pragma unroll
  for(int d0=0;d0<2;++d0){s16x4 lo[4],hi[4];
    #pragma unroll
    for(int ks=0;ks<4;++ks){
      asm volatile("ds_read_b64_tr_b16 %0,%1 offset:%c2":"=&v"(lo[ks]):"v"(vb),"i"(d0*4096+ks*1024):"memory");
      asm volatile("ds_read_b64_tr_b16 %0,%1 offset:%c2":"=&v"(hi[ks]):"v"(vb),"i"(d0*4096+ks*1024+512):"memory");}
    asm volatile("s_waitcnt lgkmcnt(0)":::"memory");SBAR();
    #define PK(k) (bf16x8){lo[k][0],lo[k][1],lo[k][2],lo[k][3],hi[k][0],hi[k][1],hi[k][2],hi[k][3]}
    o[d0]=__builtin_amdgcn_mfma_f32_32x32x16_bf16(pa0,PK(0),o[d0],0,0,0);
    o[d0]=__builtin_amdgcn_mfma_f32_32x32x16_bf16(pa1,PK(1),o[d0],0,0,0);
    o[d0]=__builtin_amdgcn_mfma_f32_32x32x16_bf16(pa2,PK(2),o[d0],0,0,0);
    o[d0]=__builtin_amdgcn_mfma_f32_32x32x16_bf16(pa3,PK(3),o[d0],0,0,0);
    #undef PK
  }
}

#ifndef ATTN_STORE16
#define ATTN_STORE16(p,v) (*(u32x4*)(p)=(v))
#endif
template<int THRL> __device__ __forceinline__ void attn_unit(int b,int h,int qb,const bf16*Q,const bf16*__restrict__ K,const bf16*__restrict__ V,bf16*O,const float*__restrict__ CUMh,const float*__restrict__ qgain,const float skip_th,char*shm){
  int tid=threadIdx.x; asm volatile("":"+v"(tid)); const int lane=tid&63,r32=lane&31,hi=lane>>5; const int wid=__builtin_amdgcn_readfirstlane(tid>>6);
  const long rowbase=(long)b*SEQ; const int q0=qb*QB;
  const bf16*Qw=Q+(rowbase+q0+wid*QBLK)*DM+h*D;
  const bf16*Kh=K+rowbase*DM+h*D,*Vh=V+rowbase*DM+h*D;
  const float cref=CUMh[q0]; int ts=0;
  { const int tmax=(q0+QB)/KVBLK-4;
    for(int t0=0;t0<tmax;t0+=64){ const int t=t0+lane; bool sk=false; if(t<tmax) sk=(CUMh[64*t+63]-cref)*1.4426950408889634f>skip_th; ts+=__popcll(__ballot(sk)); }
    ts=__builtin_amdgcn_readfirstlane(ts)&~1; }
  Kh+=(long)ts*KVBLK*DM; Vh+=(long)ts*KVBLK*DM;
  const unsigned lds0=(unsigned)(uintptr_t)shm;
  float*wsf=(float*)(shm+LDS_WS)+wid*64;
  const bf16*ksrc=Kh+(long)lane*DM+wid*8;
  const bf16*vsrc=Vh+(long)(16*(wid&3)+(lane>>2))*DM+(wid>>2)*32+(lane&3)*8;
  const unsigned kdst=lds0+LDS_K+wid*1024, vdst=lds0+LDS_V+wid*1024;
  #define DMA_K(t,slot) glds16(ksrc+(long)(t)*KVBLK*DM,(unsigned)__builtin_amdgcn_readfirstlane(kdst+(slot)))
  #define DMA_V(t,slot) glds16(vsrc+(long)(t)*KVBLK*DM,(unsigned)__builtin_amdgcn_readfirstlane(vdst+(slot)))
  const int vb0=(int)(lds0+LDS_V)+((lane>>4)&1)*32+(lane&3)*8+(4*hi+((lane&15)>>2))*64;
  const char*Kbase=shm+LDS_K; bf16x8 kf[8];
  const lds_cptr shm3=(lds_cptr)shm; const lds_cptr kp0=shm3+LDS_K+hi*1024+r32*16; const lds_cptr vp0=shm3+LDS_V+((lane>>4)&1)*32+(lane&3)*8+(4*hi+((lane&15)>>2))*64;
  const int NT=(q0+QB)/KVBLK-ts;
  DMA_K(0,0);DMA_V(0,0);DMA_K(1,SLOTB);
  bf16x8 qr[4];
  #pragma unroll
  for(int d0=0;d0<4;++d0)qr[d0]=*reinterpret_cast<const bf16x8*>(&Qw[(long)r32*DM+d0*16+hi*8]);
  {
    __attribute__((address_space(3))) float*ckw=(__attribute__((address_space(3))) float*)(shm3+LDS_CKS); const int nkv=q0+QB-ts*KVBLK; const float*cums=CUMh+ts*KVBLK;
    for(int i=tid*4;i<nkv;i+=NW*64*4){ const float4 c4=*reinterpret_cast<const float4*>(cums+i);
      ckw[i]=(c4.x-cref)*1.4426950408889634f; ckw[i+1]=(c4.y-cref)*1.4426950408889634f; ckw[i+2]=(c4.z-cref)*1.4426950408889634f; ckw[i+3]=(c4.w-cref)*1.4426950408889634f; }
  }
  float mhat=0.f,l_reg=0.f;f32x16 o[2];o[0]=f32x16{};o[1]=f32x16{};f32x16 negm=f32x16{};asm volatile("":"+v"(negm));
  const int qrel=wid*QBLK+r32;
  #define CMASK(P0,P1,t) do{int jb_=(t)-(NT-4); if(jb_>=0)cmask(P0,P1,jb_,qrel,hi);}while(0)
  bool resc=false;
  #define START(P0,P1) do{ const float rm=rowmax(P0,P1); resc=false; \
    { const float dl=rm; mhat=fadd_s(mhat,dl); \
      _Pragma("unroll") for(int r=0;r<16;++r){P0[r]=fsub_s(P0[r],dl);P1[r]=fsub_s(P1[r],dl);} \
      _Pragma("unroll") for(int r=0;r<16;++r)negm[r]=-mhat; asm volatile("":"+v"(negm)); } \
    _Pragma("unroll") for(int r=0;r<16;++r)P0[r]=__builtin_amdgcn_exp2f(P0[r]); }while(0)
  #define RESC() do{ if(resc){ asm volatile("s_waitcnt lgkmcnt(0)":::"memory"); \
      _Pragma("unroll") for(int d_=0;d_<2;++d_) _Pragma("unroll") for(int r=0;r<16;++r)o[d_][r]*=wsf[crow(r,hi)]; } }while(0)
  typedef float f32x4_t __attribute__((ext_vector_type(4)));
  #define BIAS(P0,P1,t) do{ const __attribute__((address_space(3))) float*ck_=(const __attribute__((address_space(3))) float*)(shm3+LDS_CKS)+(t)*64+4*hi; \
    _Pragma("unroll") for(int g_=0;g_<4;++g_){ const f32x4_t a_=*(const __attribute__((address_space(3))) f32x4_t*)(ck_+8*g_), b_=*(const __attribute__((address_space(3))) f32x4_t*)(ck_+32+8*g_); \
      _Pragma("unroll") for(int j_=0;j_<4;++j_){ float t0_=P0[4*g_+j_]-a_[j_]; asm volatile("":"+v"(t0_)); P0[4*g_+j_]=t0_; float t1_=P1[4*g_+j_]-b_[j_]; asm volatile("":"+v"(t1_)); P1[4*g_+j_]=t1_; } } }while(0)
  f32x16 pA0,pA1,pB0,pB1;
  int sl_prev=0,sl_cur=0,sl_next=SLOTB;
  #define ROT() do{sl_prev=sl_cur;sl_cur=sl_next;sl_next=(sl_next==(NSLOT-1)*SLOTB)?0:sl_next+SLOTB;}while(0)
  DMA_K(2,2*SLOTB);
  WAIT_BAR(3);
  qkt(pA0,pA1,Kbase,qr,negm,r32,hi);asm volatile("s_nop 15\n\ts_nop 7":"+v"(pA0),"+v"(pA1));BIAS(pA0,pA1,0);CMASK(pA0,pA1,0);
  START(pA0,pA1);
  _Pragma("unroll") for(int r=0;r<16;++r)pA1[r]=__builtin_amdgcn_exp2f(pA1[r]);
  WAIT_BAR(0);
  DMA_K(3,0);DMA_V(1,SLOTB);
  ROT();
  kload8(kf,kp0+sl_cur);
  WAIT_BAR(2);
  s16x4 vlo[8],vhi[8]; u32x4 pw0,pw1,pw2,pw3;
  #define PKW(P,B) cvtpk_s(P[B],P[B+1])
  #define PAF(k) __builtin_bit_cast(bf16x8,pw##k)
  #define VFR(i) (bf16x8){vlo[i][0],vlo[i][1],vlo[i][2],vlo[i][3],vhi[i][0],vhi[i][1],vhi[i][2],vhi[i][3]}
  #define PIN(x) asm volatile("":"+v"(x))
  #define MX3(a,b,c) __builtin_fmaxf(__builtin_fmaxf((a),(b)),(c))
  #define GAPA(MF,A0,A1,A2,A3,W0,W1,PW) do{ MF; sacc+=A0; sacc+=A1; sacc+=A2; sacc+=A3; PIN(sacc); W0; W1; PIN(PW); SBAR(); }while(0)
  #define EX(v) __builtin_amdgcn_exp2f(v)
  #define GAPB(MF,X,B) do{ MF; X[B]=EX(X[B]); X[B+1]=EX(X[B+1]); X[B+2]=EX(X[B+2]); X[B+3]=EX(X[B+3]); PIN(X); SBAR(); }while(0)
  #define VRD(i) do{ vlo[i]=vtr(vp_+(((i)>>2)*4096+((i)&3)*1024)); vhi[i]=vtr(vp_+(((i)>>2)*4096+((i)&3)*1024+512)); }while(0)
  #define KRD(G,j) do{ if(G){ kload2(kf,kp0+sl_next,j); SBAR(); } }while(0)
  #define STEP(C0,C1,P0,P1,t,GK,GV,GL) do{ SBAR(); \
    const lds_cptr vp_=vp0+sl_prev; \
    VRD(0); SBAR(); float sacc=(P0[0]+P0[1]); \
    GAPA(C0=__builtin_amdgcn_mfma_f32_32x32x16_bf16(kf[0],qr[0],negm,0,0,0), P0[2],P0[3],P0[4],P0[5],     pw0[0]=PKW(P0,0), pw0[1]=PKW(P0,2), pw0); \
    VRD(4); SBAR(); GAPA(C1=__builtin_amdgcn_mfma_f32_32x32x16_bf16(kf[1],qr[0],negm,0,0,0), P0[6],P0[7],P0[8],P0[9],     pw0[2]=PKW(P0,4), pw0[3]=PKW(P0,6), pw0); \
    VRD(1); SBAR(); GAPA(C0=__builtin_amdgcn_mfma_f32_32x32x16_bf16(kf[2],qr[1],C0,0,0,0),   P0[10],P0[11],P0[12],P0[13], pw1[0]=PKW(P0,8), pw1[1]=PKW(P0,10), pw1); \
    VRD(5); SBAR(); GAPA(C1=__builtin_amdgcn_mfma_f32_32x32x16_bf16(kf[3],qr[1],C1,0,0,0),   P0[14],P0[15],P1[0],P1[1],   pw1[2]=PKW(P0,12),pw1[3]=PKW(P0,14), pw1); \
    VRD(2); SBAR(); GAPA(C0=__builtin_amdgcn_mfma_f32_32x32x16_bf16(kf[4],qr[2],C0,0,0,0),   P1[2],P1[3],P1[4],P1[5],     pw2[0]=PKW(P1,0), pw2[1]=PKW(P1,2), pw2); \
    VRD(6); SBAR(); GAPA(C1=__builtin_amdgcn_mfma_f32_32x32x16_bf16(kf[5],qr[2],C1,0,0,0),   P1[6],P1[7],P1[8],P1[9],     pw2[2]=PKW(P1,4), pw2[3]=PKW(P1,6), pw2); \
    VRD(3); SBAR(); GAPA(C0=__builtin_amdgcn_mfma_f32_32x32x16_bf16(kf[6],qr[3],C0,0,0,0),   P1[10],P1[11],P1[12],P1[13], pw3[0]=PKW(P1,8), pw3[1]=PKW(P1,10), pw3); \
    VRD(7); SBAR(); GAPA(C1=__builtin_amdgcn_mfma_f32_32x32x16_bf16(kf[7],qr[3],C1,0,0,0),   P1[14],P1[15],0.f,0.f,       pw3[2]=PKW(P1,12),pw3[3]=PKW(P1,14), pw3); \
    l_reg+=sacc; \
    if(GK){DMA_K((t)+3,sl_cur);} if(GV){DMA_V((t)+1,sl_next);} \
    BIAS(C0,C1,t); CMASK(C0,C1,t); \
    { float a=MX3(C0[0],C0[1],C1[0]),b=MX3(C0[2],C0[3],C1[1]); a=MX3(a,C1[2],C1[3]); \
      _Pragma("unroll") for(int r=4;r<16;r+=4){a=MX3(a,C0[r],C0[r+1]);b=MX3(b,C0[r+2],C0[r+3]);a=MX3(a,C1[r],C1[r+1]);b=MX3(b,C1[r+2],C1[r+3]);} \
      float rm=__builtin_fmaxf(a,b); { auto rr=__builtin_amdgcn_permlane32_swap(__float_as_uint(rm),__float_as_uint(rm),false,false); rm=__builtin_fmaxf(__uint_as_float(rr[0]),__uint_as_float(rr[1])); } \
      resc=false; \
      if(__builtin_expect(__any(rm>(float)THRL),0)){ const float dl=__builtin_fmaxf(rm,0.f); mhat+=dl; \
        _Pragma("unroll") for(int r=0;r<16;++r){C0[r]-=dl;C1[r]-=dl;} \
        _Pragma("unroll") for(int r=0;r<16;++r)negm[r]=-mhat; asm volatile("":"+v"(negm)); \
        const float f=__builtin_amdgcn_exp2f(-dl); l_reg*=f; if(hi==0)wsf[r32]=f; resc=true; } } \
    SBAR(); \
    GAPB(o[0]=__builtin_amdgcn_mfma_f32_32x32x16_bf16(PAF(0),VFR(0),o[0],0,0,0), C0,0); \
    GAPB(o[1]=__builtin_amdgcn_mfma_f32_32x32x16_bf16(PAF(0),VFR(4),o[1],0,0,0), C0,4); \
    KRD(GL,0); GAPB(o[0]=__builtin_amdgcn_mfma_f32_32x32x16_bf16(PAF(1),VFR(1),o[0],0,0,0), C0,8); \
    KRD(GL,1); GAPB(o[1]=__builtin_amdgcn_mfma_f32_32x32x16_bf16(PAF(1),VFR(5),o[1],0,0,0), C0,12); \
    KRD(GL,2); GAPB(o[0]=__builtin_amdgcn_mfma_f32_32x32x16_bf16(PAF(2),VFR(2),o[0],0,0,0), C1,0); \
    KRD(GL,3); GAPB(o[1]=__builtin_amdgcn_mfma_f32_32x32x16_bf16(PAF(2),VFR(6),o[1],0,0,0), C1,4); \
    GAPB(o[0]=__builtin_amdgcn_mfma_f32_32x32x16_bf16(PAF(3),VFR(3),o[0],0,0,0), C1,8); \
    GAPB(o[1]=__builtin_amdgcn_mfma_f32_32x32x16_bf16(PAF(3),VFR(7),o[1],0,0,0), C1,12); \
    }while(0)
  int t=1;
  #undef CMASK
  #define CMASK(P0,P1,t) do{}while(0)
  for(;t+5<NT;t+=2){
    STEP(pB0,pB1,pA0,pA1,t,true,true,true);     WAIT_BAR(2); RESC(); ROT();
    STEP(pA0,pA1,pB0,pB1,t+1,true,true,true);   WAIT_BAR(2); RESC(); ROT();
  }
  #undef CMASK
  #define CMASK(P0,P1,t) do{int jb_=(t)-(NT-4); if(jb_>=0)cmask(P0,P1,jb_,qrel,hi);}while(0)
  #define ENDW(tt) do{ if((tt)+3<NT){WAIT_BAR(2);} else if((tt)+2<NT){WAIT_BAR(1);} else {WAIT_BAR(0);} }while(0)
  for(;t+1<NT;t+=2){
    STEP(pB0,pB1,pA0,pA1,t,(t+3<NT),(t+1<NT),(t+1<NT));       ENDW(t);   RESC(); ROT();
    STEP(pA0,pA1,pB0,pB1,t+1,(t+4<NT),(t+2<NT),(t+2<NT));     ENDW(t+1); RESC(); ROT();
  }
  STEP(pB0,pB1,pA0,pA1,NT-1,false,false,false); RESC();
  { float sacc=pB0[0]+pB0[1]; _Pragma("unroll") for(int r=2;r<16;++r)sacc+=pB0[r]; _Pragma("unroll") for(int r=0;r<16;++r)sacc+=pB1[r]; l_reg+=sacc;
    pw0=(u32x4){PKW(pB0,0),PKW(pB0,2),PKW(pB0,4),PKW(pB0,6)};pw1=(u32x4){PKW(pB0,8),PKW(pB0,10),PKW(pB0,12),PKW(pB0,14)};pw2=(u32x4){PKW(pB1,0),PKW(pB1,2),PKW(pB1,4),PKW(pB1,6)};pw3=(u32x4){PKW(pB1,8),PKW(pB1,10),PKW(pB1,12),PKW(pB1,14)};
    SBAR(); pv(o,vb0+sl_cur,PAF(0),PAF(1),PAF(2),PAF(3)); }
  #undef PKW
  #undef PAF
  #undef VFR
  #undef PIN
  #undef MX3
  #undef GAPA
  #undef GAPB
  #undef EX
  #undef VRD
  #undef KRD
  #undef STEP
  #undef ENDW
  {auto rr=__builtin_amdgcn_permlane32_swap(__float_as_uint(l_reg),__float_as_uint(l_reg),false,false);l_reg=__uint_as_float(rr[0])+__uint_as_float(rr[1]);}
  if(hi==0)wsf[32+r32]=l_reg;asm volatile("s_waitcnt lgkmcnt(0)":::"memory");
  float rli[16];
  #pragma unroll
  for(int r=0;r<16;++r)rli[r]=__builtin_amdgcn_rcpf(wsf[32+crow(r,hi)]);
  bf16*Ow=O+(rowbase+q0+wid*QBLK)*ODM+h*D;
  { bf16*stg=(bf16*)(shm+LDS_OST)+wid*2048;
    #pragma unroll
    for(int r=0;r<16;++r){const int orow=crow(r,hi);
      #pragma unroll
      for(int d0=0;d0<2;++d0)stg[orow*64+d0*32+r32]=__float2bfloat16(o[d0][r]*rli[r]);}
    asm volatile("s_waitcnt lgkmcnt(0)":::"memory");
    #pragma unroll
    for(int i=0;i<4;++i){const int row=i*8+(lane>>3),ch=lane&7; const u32x4 v=*(const u32x4*)(stg+row*64+ch*8); ATTN_STORE16(Ow+(long)row*ODM+ch*8,v);} }
  asm volatile("s_waitcnt lgkmcnt(0)\n\ts_barrier":::"memory");
  #undef DMA_K
  #undef DMA_V
  #undef CMASK
  #undef START
  #undef RESC
  #undef ROT
  #undef BIAS
}
constexpr int ATTN_LDS_BYTES=LDS_BYTES;
#undef SBAR
#undef WAIT_BAR
}

#define LAS __attribute__((address_space(3)))
typedef unsigned short bfr;
typedef float f32x4v __attribute__((ext_vector_type(4)));
typedef unsigned u32x4v __attribute__((ext_vector_type(4)));
typedef unsigned u32x2v __attribute__((ext_vector_type(2)));
typedef short bf16x8v __attribute__((ext_vector_type(8)));

constexpr int NB = 4, SEQ = 8192, DMODEL = 1024, DEPTH = 4, MROWS = NB * SEQ;
constexpr int NPROJ = 3072, DIN = 2966, DFF = 2816, NGU = 5632, NMOD = 6144, DMIX = 1024;
constexpr int C_LX = 0, C_LG = 384, C_FQ = 768, C_FK = 1152, C_FV = 1536, C_GQ = 1920, C_GK = 2176, C_GV = 2432, C_GG = 2688, C_GL = 2944, C_FF = 2960;
constexpr float EPS = 1e-6f, LOG2E = 1.4426950408889634f;

constexpr size_t MiB = 1u << 20;
constexpr size_t WS_CTL = 0, CTL_BYTES = 65536;
constexpr int CW_BAR = 1024;
constexpr size_t WS_MOD = 1 * MiB;
constexpr size_t WS_CUM = 2 * MiB;
constexpr size_t WS_DEC = 3 * MiB;
constexpr size_t WS_SUMA = 4 * MiB, WS_SUMH = 5 * MiB;
constexpr size_t WS_LRUW = 6 * MiB;
constexpr size_t WS_WIN = 8 * MiB, WS_WOUT = 32 * MiB, WS_WGU = 40 * MiB, WS_WDN = 84 * MiB;
constexpr size_t WIN_L = (size_t)NPROJ * 1024 * 2, WOUT_L = (size_t)1024 * 1024 * 2, WGU_L = (size_t)NGU * 1024 * 2, WDN_L = (size_t)1024 * DFF * 2;
constexpr size_t WS_PROJ = 106 * MiB;
constexpr size_t WS_MIX = 298 * MiB;
constexpr size_t WS_HN = 362 * MiB;
constexpr size_t WS_HL = 362 * MiB, WS_ACUM = 386 * MiB, WS_QDEC = 410 * MiB;
constexpr size_t WS_OINTRA = 426 * MiB;
constexpr size_t WS_KV = 442 * MiB;
constexpr size_t WS_ST = 474 * MiB;
constexpr size_t WS_END = 490 * MiB;
static_assert(WS_WDN + 4 * WDN_L <= WS_PROJ && WS_WGU + 4 * WGU_L <= WS_WDN && WS_WIN + 4 * WIN_L <= WS_WOUT && WS_WOUT + 4 * WOUT_L <= WS_WGU, "ws map");

constexpr int RING_BYTES = 131072, MISC_OFF = RING_BYTES, LDS_BYTES = 147456;
static_assert(attn_body::ATTN_LDS_BYTES <= RING_BYTES, "attention LDS");

__device__ __forceinline__ float bf2f(bfr h) { return __uint_as_float((unsigned)h << 16); }
typedef float f32x2v_ __attribute__((ext_vector_type(2))); typedef __bf16 bf16x2v_ __attribute__((ext_vector_type(2)));
__device__ __forceinline__ unsigned pk2(float lo, float hi) { f32x2v_ v = {lo, hi}; bf16x2v_ b = __builtin_convertvector(v, bf16x2v_); return __builtin_bit_cast(unsigned, b); }
__device__ __forceinline__ bfr f2bf(float f) { return (bfr)(pk2(f, f) & 0xffffu); }
__device__ __forceinline__ float wave_sum(float v) {
#pragma unroll
    for (int o = 1; o < 64; o <<= 1) v += __shfl_xor(v, o);
    return v;
}
__device__ __forceinline__ float sigmoidf_(float x) { return __builtin_amdgcn_rcpf(1.0f + __expf(-x)); }
__device__ __forceinline__ float log_sigmoid_(float z) { return fminf(z, 0.f) - __logf(1.0f + __expf(-fabsf(z))); }
__device__ __forceinline__ float gelu_tanh_(float y) { const float z = 0.7978845608028654f * (y + 0.044715f * y * y * y); const float t = 1.0f - 2.0f * __builtin_amdgcn_rcpf(__expf(2.0f * z) + 1.0f); return 0.5f * y * (1.0f + t); }
__device__ __forceinline__ float silu_(float g) { return g * __builtin_amdgcn_rcpf(1.0f + __expf(-g)); }

struct Params { const float* in[23]; float* out; unsigned char* ws; };

__device__ __forceinline__ int map_in(int n) {
    if (n >= 768 && n < 1536) {
        const int c = n & 255, s_ = (c & 127) >> 5, d = (c & 31) + 32 * (c >> 7), H = 4 * ((n >> 8) - 3) + s_;
        return 768 + H * 64 + d; }
    if (n < 1920) return n;
    if (n < 2688) return n + 6;
    if (n < 2944) return n - 2688 + 2710;
    if (n < 2960) return n - 2944 + 2694;
    if (n < 2966) return n - 2960 + 1920;
    return -1;
}
__device__ __forceinline__ int map_gu(int n) { const int pn = n >> 8, r = n & 255; return r < 128 ? pn * 128 + r : DFF + pn * 128 + (r - 128); }
template <int MODE> __device__ __forceinline__ void transpose_item(const float* __restrict__ W, int K, int N, int NP, bfr* __restrict__ WT, LAS float* scr, int item, int lane) {
    const int nblk = NP / 32, kb = item / nblk, nb = item % nblk, k0 = 64 * kb, n0 = 32 * nb;
    const int nme = n0 + (lane & 31);
    const int nsrc = MODE == 0 ? nme : (MODE == 1 ? map_in(nme) : map_gu(nme));
#pragma unroll 8
    for (int i = 0; i < 32; ++i) { const int kk = 2 * i + (lane >> 5); scr[kk * 33 + (lane & 31)] = nsrc >= 0 ? W[(size_t)(k0 + kk) * N + nsrc] : 0.f; }
    asm volatile("s_waitcnt lgkmcnt(0)" ::: "memory");
    const int c = lane & 7;
#pragma unroll
    for (int j = 0; j < 4; ++j) { const int n = (lane >> 3) + 8 * j; const LAS float* s = scr + (8 * c) * 33 + n;
        u32x4v o; o.x = pk2(s[0 * 33], s[1 * 33]); o.y = pk2(s[2 * 33], s[3 * 33]); o.z = pk2(s[4 * 33], s[5 * 33]); o.w = pk2(s[6 * 33], s[7 * 33]);
        *(u32x4v*)(WT + (size_t)(n0 + n) * K + k0 + 8 * c) = o; }
    asm volatile("s_waitcnt lgkmcnt(0)" ::: "memory");
}
__device__ __forceinline__ void p0_prologue(const Params& P, LAS unsigned char* lds, int tid, int lane, int wid, int G) {
    asm volatile("" : "+v"(tid), "+v"(lane), "+s"(wid));
    unsigned char* ws = P.ws;
    {
        LAS float* CA = (LAS float*)lds;
        LAS float* RED = (LAS float*)(lds + 16384);
        const float* c = P.in[1];
        for (int i = tid; i < NB * DMODEL; i += 512) CA[i] = silu_(c[i]);
        __syncthreads();
        const int kp = tid >> 5, col = tid & 31;
        float* MOD = (float*)(ws + WS_MOD);
        for (int it = blockIdx.x; it < DEPTH * (NMOD / 32); it += G) {
            const int l = it / (NMOD / 32), c0 = (it % (NMOD / 32)) * 32;
            const float* w = P.in[4] + ((size_t)l * DMODEL + kp * 64) * NMOD + c0 + col;
            float a0 = 0.f, a1 = 0.f, a2 = 0.f, a3 = 0.f;
#pragma unroll 8
            for (int k = 0; k < 64; ++k) { const float wv = w[(size_t)k * NMOD]; const int kk = kp * 64 + k;
                a0 += CA[kk] * wv; a1 += CA[1024 + kk] * wv; a2 += CA[2048 + kk] * wv; a3 += CA[3072 + kk] * wv; }
            RED[(kp * 4 + 0) * 32 + col] = a0; RED[(kp * 4 + 1) * 32 + col] = a1; RED[(kp * 4 + 2) * 32 + col] = a2; RED[(kp * 4 + 3) * 32 + col] = a3;
            __syncthreads();
            if (tid < 128) { const int b = tid >> 5; float s = P.in[5][(size_t)l * NMOD + c0 + col];
#pragma unroll
                for (int q = 0; q < 16; ++q) s += RED[(q * 4 + b) * 32 + col];
                MOD[((size_t)l * NB + b) * NMOD + c0 + col] = s; }
            __syncthreads();
        }
    }
    __syncthreads();
    {
        bfr* LW = (bfr*)(ws + WS_LRUW);
        for (int i = blockIdx.x * 512 + tid; i < DEPTH * 6 * 2 * 4096; i += G * 512) {
            const int d = i & 63, e = (i >> 6) & 63, mat = (i >> 12) & 1, ln = i >> 13;
            const float* src = mat ? P.in[11] : P.in[9];
            LW[i] = f2bf(src[(size_t)ln * 4096 + d * 64 + e]);
        }
    }
    {
        LAS float* scr = (LAS float*)(lds + wid * 16384);
        const int gw = blockIdx.x * 8 + wid, NGW = G * 8;
        constexpr int I_IN = 16 * (NPROJ / 32), I_OUT = 16 * 32, I_GU = 16 * (NGU / 32), I_DN = (DFF / 64) * 32, I_L = I_IN + I_OUT + I_GU + I_DN;
        for (int it = gw; it < DEPTH * I_L; it += NGW) {
            const int l = it / I_L; int r = it % I_L;
            if (r < I_IN) { transpose_item<1>(P.in[6] + (size_t)l * DMODEL * DIN, DMODEL, DIN, NPROJ, (bfr*)(ws + WS_WIN + l * WIN_L), scr, r, lane); continue; } r -= I_IN;
            if (r < I_OUT) { transpose_item<0>(P.in[20] + (size_t)l * DMIX * DMODEL, DMIX, DMODEL, DMODEL, (bfr*)(ws + WS_WOUT + l * WOUT_L), scr, r, lane); continue; } r -= I_OUT;
            if (r < I_GU) { transpose_item<2>(P.in[21] + (size_t)l * DMODEL * NGU, DMODEL, NGU, NGU, (bfr*)(ws + WS_WGU + l * WGU_L), scr, r, lane); continue; } r -= I_GU;
            transpose_item<0>(P.in[22] + (size_t)l * DFF * DMODEL, DFF, DMODEL, DMODEL, (bfr*)(ws + WS_WDN + l * WDN_L), scr, r, lane);
        }
    }
}

__device__ __forceinline__ void norm_phase(const float* __restrict__ x, const bfr* __restrict__ x16, const float* __restrict__ gain, const float* __restrict__ modl, int shift_off, int scale_off, bfr* __restrict__ HN, int gw, int NGW, int lane) {
    asm volatile("" : "+v"(lane), "+s"(gw));
    const bool xloc = (NGW % 64) == 0;
    const int xq = xloc ? (gw >> 3) & 7 : 0, wloc = xloc ? ((gw >> 6) << 3) + (gw & 7) : gw, nwl = xloc ? NGW / 8 : NGW, rbase = xq * (MROWS / 8), rcnt = xloc ? MROWS / 8 : MROWS;
#pragma unroll 4
    for (int r = wloc; r < rcnt; r += nwl) {
        const int m = rbase + r;
        f32x4v v[4]; float s = 0.f;
        if (x16) {
            const u32x2v* xr = (const u32x2v*)(x16 + (size_t)m * DMODEL) + lane;
#pragma unroll
            for (int j = 0; j < 4; ++j) { const u32x2v w = xr[64 * j]; const pg8::f32x2 a = pg8::h2f(w.x), b = pg8::h2f(w.y); v[j] = (f32x4v){a.x, a.y, b.x, b.y}; }
        } else {
            const f32x4v* xr = (const f32x4v*)(x + (size_t)m * DMODEL) + lane;
#pragma unroll
            for (int j = 0; j < 4; ++j) v[j] = xr[64 * j];
        }
#pragma unroll
        for (int j = 0; j < 4; ++j) s += (v[j].x * v[j].x + v[j].y * v[j].y) + (v[j].z * v[j].z + v[j].w * v[j].w);
        const float rstd = 1.0f / sqrtf(wave_sum(s) * (1.0f / DMODEL) + EPS);
        const float* mb = modl + (size_t)(m / SEQ) * NMOD;
        u32x2v* o8 = (u32x2v*)(HN + (size_t)m * DMODEL) + lane;
#pragma unroll
        for (int j = 0; j < 4; ++j) { const int col = 4 * lane + 256 * j;
            const f32x4v g = *(const f32x4v*)(gain + col), sc = *(const f32x4v*)(mb + scale_off + col), sh = *(const f32x4v*)(mb + shift_off + col);
            const f32x4v h = v[j] * rstd * g * (sc + 1.0f) + sh;
            u32x2v w; w.x = pk2(h.x, h.y); w.y = pk2(h.z, h.w); o8[64 * j] = w; }
    }
}

struct LayerPtrs {
    const float *conv_w, *conv_b, *b_r, *b_i, *lam, *fox_bf, *qgain, *kgain, *w_alpha, *b_alpha, *ogain;
    const bfr* lruw;
};

constexpr int LRU_LC = 128, LRU_NCH = SEQ / LRU_LC;
__device__ __forceinline__ void lru_local_item(int idx, const LayerPtrs& L, unsigned char* ws, LAS unsigned char* lds, int tid, int lane, int wid) {
    asm volatile("" : "+v"(tid), "+v"(lane), "+s"(wid));
    const int n = idx % 6, c = (idx / 6) % LRU_NCH, b = idx / (6 * LRU_NCH);
    const int ch = tid & 63, tg = wid;
    const bfr* PROJ = (const bfr*)(ws + WS_PROJ);
    LAS bfr* XA = (LAS bfr*)lds;
    LAS float* RI = (LAS float*)(lds + 18432);
    LAS float* SEG = (LAS float*)(lds + 18432 + 65536);
    const int cg_ = n * 64 + ch;
    const int mat = wid >> 2, fr = lane & 15, fq = lane >> 4;
    const bfr* wt = L.lruw + (size_t)(n * 2 + mat) * 4096;
    bf16x8v bfrag[4][2];
#pragma unroll
    for (int te = 0; te < 4; ++te) { bfrag[te][0] = *(const bf16x8v*)(wt + (16 * te + fr) * 64 + 8 * fq); bfrag[te][1] = *(const bf16x8v*)(wt + (16 * te + fr) * 64 + 32 + 8 * fq); }
    const float lam = L.lam[cg_], br = L.b_r[cg_], bi = L.b_i[cg_];
    float xa[16];
    {
        float raw[19];
#pragma unroll
        for (int j = 0; j < 19; ++j) { const int tt = c * LRU_LC + 16 * tg - 3 + j; raw[j] = tt >= 0 ? bf2f(PROJ[((size_t)b * SEQ + tt) * NPROJ + C_LX + cg_]) : 0.f; }
        const float w0 = L.conv_w[cg_], w1 = L.conv_w[384 + cg_], w2 = L.conv_w[768 + cg_], w3 = L.conv_w[1152 + cg_], cb = L.conv_b[cg_];
#pragma unroll
        for (int i = 0; i < 16; ++i) { xa[i] = cb + w0 * raw[i] + w1 * raw[i + 1] + w2 * raw[i + 2] + w3 * raw[i + 3]; XA[(16 * tg + i) * 72 + ch] = f2bf(xa[i]); }
    }
    __syncthreads();
    {
#pragma unroll
        for (int q = 0; q < 2; ++q) {
            const int tr = 2 * (wid & 3) + q;
            const bf16x8v a0 = *(const LAS bf16x8v*)(XA + (16 * tr + fr) * 72 + 8 * fq), a1 = *(const LAS bf16x8v*)(XA + (16 * tr + fr) * 72 + 32 + 8 * fq);
#pragma unroll
            for (int te = 0; te < 4; ++te) {
                f32x4v acc = {0.f, 0.f, 0.f, 0.f};
                acc = __builtin_amdgcn_mfma_f32_16x16x32_bf16(a0, bfrag[te][0], acc, 0, 0, 0);
                acc = __builtin_amdgcn_mfma_f32_16x16x32_bf16(a1, bfrag[te][1], acc, 0, 0, 0);
#pragma unroll
                for (int r = 0; r < 4; ++r) RI[(mat * LRU_LC + 16 * tr + 4 * fq + r) * 64 + 16 * te + fr] = acc[r];
            }
        }
    }
    __syncthreads();
    float hs[16], ps[16];
    {
        const float e_ = __expf(-fabsf(lam));
        const float sp = fmaxf(-lam, 0.f) + (e_ < 0.03125f ? e_ * (1.0f - e_ * (0.5f - e_ * (0.33333334f - 0.25f * e_))) : __logf(1.0f + e_));
        float h = 0.f, p = 1.f;
#pragma unroll
        for (int i = 0; i < 16; ++i) {
            const float r = sigmoidf_(RI[(16 * tg + i) * 64 + ch] + br), ig = sigmoidf_(RI[(LRU_LC + 16 * tg + i) * 64 + ch] + bi);
            const float la = -8.0f * r * sp; const float a = __expf(la); const float mult = __builtin_amdgcn_sqrtf(fmaxf(1.0f - a * a, 0.f));
            h = a * h + mult * ig * xa[i]; p *= a; hs[i] = h; ps[i] = p;
        }
        SEG[(tg * 2 + 0) * 64 + ch] = p; SEG[(tg * 2 + 1) * 64 + ch] = h;
    }
    __syncthreads();
    {
        float carry = 0.f, pref = 1.f;
        for (int g = 0; g < tg; ++g) { const float pg = SEG[(g * 2) * 64 + ch], hg = SEG[(g * 2 + 1) * 64 + ch]; carry = pg * carry + hg; pref *= pg; }
        bfr* HL = (bfr*)(ws + WS_HL); bfr* AC = (bfr*)(ws + WS_ACUM);
        const size_t m0 = (size_t)b * SEQ + c * LRU_LC + 16 * tg;
        float hl = 0.f, ac = 0.f;
#pragma unroll
        for (int i = 0; i < 16; ++i) { hl = hs[i] + ps[i] * carry; ac = ps[i] * pref; HL[(m0 + i) * 384 + cg_] = f2bf(hl); AC[(m0 + i) * 384 + cg_] = f2bf(ac); }
        if (tg == 7) { ((float*)(ws + WS_SUMA))[((size_t)b * LRU_NCH + c) * 384 + cg_] = ac; ((float*)(ws + WS_SUMH))[((size_t)b * LRU_NCH + c) * 384 + cg_] = hl; }
    }
    __syncthreads();
}
__device__ __forceinline__ void knorm_item(int idx, const LayerPtrs& L, unsigned char* ws, int tid) {
    asm volatile("" : "+v"(tid));
    bfr* PROJ = (bfr*)(ws + WS_PROJ);
    const int part = tid & 7, hr = tid >> 3;
    const f32x4v g0 = *(const f32x4v*)(L.kgain + part * 8), g1 = *(const f32x4v*)(L.kgain + part * 8 + 4);
#pragma unroll
    for (int p = 0; p < 6; ++p) {
        const int R = p * 64 + hr, tok = R / 6, head = R % 6;
        u32x4v* ptr = (u32x4v*)(PROJ + ((size_t)idx * 64 + tok) * NPROJ + C_FK + head * 64 + part * 8);
        const u32x4v w = *ptr;
        float f[8];
        f[0] = __uint_as_float(w.x << 16); f[1] = __uint_as_float(w.x & 0xffff0000u); f[2] = __uint_as_float(w.y << 16); f[3] = __uint_as_float(w.y & 0xffff0000u);
        f[4] = __uint_as_float(w.z << 16); f[5] = __uint_as_float(w.z & 0xffff0000u); f[6] = __uint_as_float(w.w << 16); f[7] = __uint_as_float(w.w & 0xffff0000u);
        float ss = 0.f;
#pragma unroll
        for (int j = 0; j < 8; ++j) ss += f[j] * f[j];
        ss += __shfl_xor(ss, 1); ss += __shfl_xor(ss, 2); ss += __shfl_xor(ss, 4);
        const float rs = 1.0f / sqrtf(ss * (1.0f / 64.0f) + EPS);
        u32x4v o; o.x = pk2(f[0] * rs * g0.x, f[1] * rs * g0.y); o.y = pk2(f[2] * rs * g0.z, f[3] * rs * g0.w); o.z = pk2(f[4] * rs * g1.x, f[5] * rs * g1.y); o.w = pk2(f[6] * rs * g1.z, f[7] * rs * g1.w);
        *ptr = o;
    }
}
__device__ __forceinline__ void cum_item(int idx, const LayerPtrs& L, unsigned char* ws, LAS unsigned char* lds, int tid, int lane, int wid) {
    asm volatile("" : "+v"(tid), "+v"(lane), "+s"(wid));
    const int b = idx / 6, h = idx % 6;
    const bfr* PROJ = (const bfr*)(ws + WS_PROJ);
    LAS float* WT = (LAS float*)lds;
    const float bf = L.fox_bf[h];
    float loc[16]; float run = 0.f;
#pragma unroll
    for (int i = 0; i < 16; ++i) { const float z = bf2f(PROJ[((size_t)b * SEQ + 16 * tid + i) * NPROJ + C_FF + h]) + bf; run += log_sigmoid_(z); loc[i] = run; }
    float inc = run;
#pragma unroll
    for (int o = 1; o < 64; o <<= 1) { const float t = __shfl_up(inc, o); if (lane >= o) inc += t; }
    if (lane == 63) WT[wid] = inc;
    __syncthreads();
    float base = inc - run;
    for (int w = 0; w < wid; ++w) base += WT[w];
    float* CUM = (float*)(ws + WS_CUM) + ((size_t)b * 6 + h) * SEQ + 16 * tid;
#pragma unroll
    for (int i = 0; i < 16; i += 4) *(f32x4v*)(CUM + i) = (f32x4v){loc[i] + base, loc[i + 1] + base, loc[i + 2] + base, loc[i + 3] + base};
    __syncthreads();
}
__device__ __forceinline__ void gla_local_item(int idx, const LayerPtrs& L, unsigned char* ws, LAS unsigned char* lds, int tid, int lane, int wid) {
    asm volatile("" : "+v"(tid), "+v"(lane), "+s"(wid));
    const int bh = idx >> 6, np = idx & 63, b = bh >> 2, h = bh & 3;
    const int d = tid & 63, tg = wid, fr = lane & 15, fq = lane >> 4;
    const bfr* PROJ = (const bfr*)(ws + WS_PROJ);
    constexpr int CCB = 49152;
    float qf[2][8], kf[2][8]; bfr vb[2][8];
#pragma unroll
    for (int cc = 0; cc < 2; ++cc)
#pragma unroll
        for (int i = 0; i < 8; ++i) { const size_t m = (size_t)b * SEQ + (2 * np + cc) * 64 + 8 * tg + i;
            qf[cc][i] = bf2f(PROJ[m * NPROJ + C_GQ + h * 64 + d]); kf[cc][i] = bf2f(PROJ[m * NPROJ + C_GK + h * 64 + d]); vb[cc][i] = PROJ[m * NPROJ + C_GV + h * 64 + d]; }
    float bc[2][8];
    {
        float wal[16];
#pragma unroll
        for (int r = 0; r < 16; ++r) wal[r] = L.w_alpha[r * 256 + h * 64 + d];
        const float bal = L.b_alpha[h * 64 + d];
#pragma unroll
        for (int cc = 0; cc < 2; ++cc) {
            LAS float* SEGB = (LAS float*)(lds + cc * CCB);
            const size_t m0 = (size_t)b * SEQ + (2 * np + cc) * 64;
            float run = 0.f;
#pragma unroll
            for (int i = 0; i < 8; ++i) {
                const u32x4v* lp = (const u32x4v*)(PROJ + (m0 + 8 * tg + i) * NPROJ + C_GL);
                const u32x4v l0 = lp[0], l1 = lp[1];
                float z = bal;
                z += __uint_as_float(l0.x << 16) * wal[0] + __uint_as_float(l0.x & 0xffff0000u) * wal[1] + __uint_as_float(l0.y << 16) * wal[2] + __uint_as_float(l0.y & 0xffff0000u) * wal[3];
                z += __uint_as_float(l0.z << 16) * wal[4] + __uint_as_float(l0.z & 0xffff0000u) * wal[5] + __uint_as_float(l0.w << 16) * wal[6] + __uint_as_float(l0.w & 0xffff0000u) * wal[7];
                z += __uint_as_float(l1.x << 16) * wal[8] + __uint_as_float(l1.x & 0xffff0000u) * wal[9] + __uint_as_float(l1.y << 16) * wal[10] + __uint_as_float(l1.y & 0xffff0000u) * wal[11];
                z += __uint_as_float(l1.z << 16) * wal[12] + __uint_as_float(l1.z & 0xffff0000u) * wal[13] + __uint_as_float(l1.w << 16) * wal[14] + __uint_as_float(l1.w & 0xffff0000u) * wal[15];
                run += log_sigmoid_(z) * (1.0f / 16.0f); bc[cc][i] = run;
            }
            SEGB[tg * 64 + d] = run;
        }
    }
    __syncthreads();
#pragma unroll
    for (int cc = 0; cc < 2; ++cc) {
        LAS float* SEGB = (LAS float*)(lds + cc * CCB);
        LAS bfr* QD = (LAS bfr*)(lds + cc * CCB + 2048); LAS bfr* KD = QD + 4608; LAS bfr* KTET = KD + 4608; LAS bfr* VT = KTET + 4608;
        const size_t m0 = (size_t)b * SEQ + (2 * np + cc) * 64;
        float off = 0.f, total = 0.f;
#pragma unroll
        for (int g = 0; g < 8; ++g) { const float sg = SEGB[g * 64 + d]; total += sg; if (g < tg) off += sg; }
        bfr* QDEC = (bfr*)(ws + WS_QDEC);
        unsigned kt[4], vv[4];
#pragma unroll
        for (int i = 0; i < 8; ++i) {
            const size_t m = m0 + 8 * tg + i; const float bcum = bc[cc][i] + off;
            const float q = qf[cc][i], k = kf[cc][i]; const bfr v = vb[cc][i];
            const bfr qd = f2bf(q * 0.125f * __expf(bcum)), kd = f2bf(k * __expf(-bcum)), kte = f2bf(k * __expf(total - bcum));
            QD[(8 * tg + i) * 72 + d] = qd; KD[(8 * tg + i) * 72 + d] = kd; QDEC[m * 256 + h * 64 + d] = qd;
            if (i & 1) { kt[i >> 1] |= (unsigned)kte << 16; vv[i >> 1] |= (unsigned)v << 16; } else { kt[i >> 1] = kte; vv[i >> 1] = v; }
        }
        *(LAS u32x4v*)(KTET + d * 72 + 8 * tg) = (u32x4v){kt[0], kt[1], kt[2], kt[3]};
        *(LAS u32x4v*)(VT + d * 72 + 8 * tg) = (u32x4v){vv[0], vv[1], vv[2], vv[3]};
        if (tg == 0) ((float*)(ws + WS_DEC))[((size_t)bh * 128 + 2 * np + cc) * 64 + d] = __expf(total);
    }
    __syncthreads();
#pragma unroll
    for (int cc = 0; cc < 2; ++cc) {
        LAS bfr* QD = (LAS bfr*)(lds + cc * CCB + 2048); LAS bfr* KD = QD + 4608; LAS bfr* ATT = QD + 4 * 4608;
        const int ti = wid & 3;
#pragma unroll
        for (int q = 0; q < 2; ++q) {
            const int tj = 2 * (wid >> 2) + q;
            f32x4v acc = {0.f, 0.f, 0.f, 0.f};
            if (tj <= ti) {
                const bf16x8v a0 = *(const LAS bf16x8v*)(QD + (16 * ti + fr) * 72 + 8 * fq), a1 = *(const LAS bf16x8v*)(QD + (16 * ti + fr) * 72 + 32 + 8 * fq);
                const bf16x8v b0 = *(const LAS bf16x8v*)(KD + (16 * tj + fr) * 72 + 8 * fq), b1 = *(const LAS bf16x8v*)(KD + (16 * tj + fr) * 72 + 32 + 8 * fq);
                acc = __builtin_amdgcn_mfma_f32_16x16x32_bf16(a0, b0, acc, 0, 0, 0);
                acc = __builtin_amdgcn_mfma_f32_16x16x32_bf16(a1, b1, acc, 0, 0, 0);
            }
#pragma unroll
            for (int r = 0; r < 4; ++r) { const int i = 16 * ti + 4 * fq + r, j = 16 * tj + fr; ATT[i * 72 + j] = f2bf(j <= i ? acc[r] : 0.f); }
        }
    }
    __syncthreads();
#pragma unroll
    for (int cc = 0; cc < 2; ++cc) {
        LAS bfr* QD = (LAS bfr*)(lds + cc * CCB + 2048); LAS bfr* KTET = QD + 2 * 4608; LAS bfr* VT = QD + 3 * 4608; LAS bfr* ATT = QD + 4 * 4608;
        const size_t m0 = (size_t)b * SEQ + (2 * np + cc) * 64;
        const int mat = wid >> 2, t4 = wid & 3;
        if (mat == 0) {
            bfr* OI = (bfr*)(ws + WS_OINTRA);
            const bf16x8v b0 = *(const LAS bf16x8v*)(ATT + (16 * t4 + fr) * 72 + 8 * fq), b1 = *(const LAS bf16x8v*)(ATT + (16 * t4 + fr) * 72 + 32 + 8 * fq);
#pragma unroll
            for (int tv = 0; tv < 4; ++tv) {
                const bf16x8v a0 = *(const LAS bf16x8v*)(VT + (16 * tv + fr) * 72 + 8 * fq), a1 = *(const LAS bf16x8v*)(VT + (16 * tv + fr) * 72 + 32 + 8 * fq);
                f32x4v acc = {0.f, 0.f, 0.f, 0.f};
                acc = __builtin_amdgcn_mfma_f32_16x16x32_bf16(a0, b0, acc, 0, 0, 0);
                acc = __builtin_amdgcn_mfma_f32_16x16x32_bf16(a1, b1, acc, 0, 0, 0);
                u32x2v w; w.x = pk2(acc[0], acc[1]); w.y = pk2(acc[2], acc[3]);
                *(u32x2v*)(OI + (m0 + 16 * t4 + fr) * 256 + h * 64 + 16 * tv + 4 * fq) = w;
            }
        } else {
            float* KV = (float*)(ws + WS_KV) + ((size_t)bh * 128 + 2 * np + cc) * 4096;
            const bf16x8v a0 = *(const LAS bf16x8v*)(KTET + (16 * t4 + fr) * 72 + 8 * fq), a1 = *(const LAS bf16x8v*)(KTET + (16 * t4 + fr) * 72 + 32 + 8 * fq);
#pragma unroll
            for (int tv = 0; tv < 4; ++tv) {
                const bf16x8v b0 = *(const LAS bf16x8v*)(VT + (16 * tv + fr) * 72 + 8 * fq), b1 = *(const LAS bf16x8v*)(VT + (16 * tv + fr) * 72 + 32 + 8 * fq);
                f32x4v acc = {0.f, 0.f, 0.f, 0.f};
                acc = __builtin_amdgcn_mfma_f32_16x16x32_bf16(a0, b0, acc, 0, 0, 0);
                acc = __builtin_amdgcn_mfma_f32_16x16x32_bf16(a1, b1, acc, 0, 0, 0);
                *(f32x4v*)(KV + (16 * tv + fr) * 64 + 16 * t4 + 4 * fq) = acc;
            }
        }
    }
    __syncthreads();
}

__device__ __forceinline__ void gla_scan_item(int idx, unsigned char* ws, int tid) {
    asm volatile("" : "+v"(tid));
    const int bh = idx >> 3, e = (idx & 7) * 512 + tid, d = e & 63;
    const float* KV = (const float*)(ws + WS_KV) + (size_t)bh * 128 * 4096 + e;
    const float* DEC = (const float*)(ws + WS_DEC) + (size_t)bh * 128 * 64 + d;
    bfr* ST = (bfr*)(ws + WS_ST) + (size_t)bh * 128 * 4096 + e;
    float s = 0.f;
#pragma unroll 16
    for (int n = 0; n < 128; ++n) { const float kvv = KV[(size_t)n * 4096], dc = DEC[n * 64]; ST[(size_t)n * 4096] = f2bf(s); s = dc * s + kvv; }
}
__device__ __forceinline__ void lru_out_item(int q, unsigned char* ws, LAS unsigned char* lds, int tid, int wid) {
    asm volatile("" : "+v"(tid), "+s"(wid));
    const int b = q / 96, rem = q % 96, n = rem / 16, cgp = rem % 16;
    const int ch = tid & 63, tg = wid, cg_ = n * 64 + ch;
    const float* SA = (const float*)(ws + WS_SUMA) + (size_t)b * LRU_NCH * 384 + cg_;
    const float* SH = (const float*)(ws + WS_SUMH) + (size_t)b * LRU_NCH * 384 + cg_;
    LAS float* COMP = (LAS float*)lds;
    {
        const int nprev = 4 * cgp;
        float pw = 1.f, hw = 0.f;
        for (int j = (tg * nprev) >> 3; j < ((tg + 1) * nprev) >> 3; ++j) { const float a = SA[j * 384], hh = SH[j * 384]; hw = a * hw + hh; pw *= a; }
        COMP[(tg * 2) * 64 + ch] = pw; COMP[(tg * 2 + 1) * 64 + ch] = hw;
    }
    __syncthreads();
    float carry = 0.f;
#pragma unroll
    for (int g = 0; g < 8; ++g) carry = COMP[(g * 2) * 64 + ch] * carry + COMP[(g * 2 + 1) * 64 + ch];
    const bfr* HL = (const bfr*)(ws + WS_HL); const bfr* AC = (const bfr*)(ws + WS_ACUM); const bfr* PROJ = (const bfr*)(ws + WS_PROJ); bfr* MIX = (bfr*)(ws + WS_MIX);
    for (int cc = 0; cc < 4; ++cc) {
        const int c = cgp * 4 + cc;
        const size_t m0 = (size_t)b * SEQ + c * LRU_LC + 16 * tg;
        const float sa = SA[c * 384], sh = SH[c * 384];
#pragma unroll
        for (int i = 0; i < 16; ++i) { const size_t m = m0 + i;
            const float hh = bf2f(HL[m * 384 + cg_]) + bf2f(AC[m * 384 + cg_]) * carry; const float y = bf2f(PROJ[m * NPROJ + C_LG + cg_]);
            MIX[m * DMIX + cg_] = f2bf(hh * gelu_tanh_(y)); }
        carry = sa * carry + sh;
    }
}
__device__ __forceinline__ void gla_out_item(int idx, const LayerPtrs& L, unsigned char* ws, int lane) {
    asm volatile("" : "+v"(lane));
    const int bh = idx >> 7, n = idx & 127, b = bh >> 2, h = bh & 3, fr = lane & 15, fq = lane >> 4;
    const size_t m0 = (size_t)b * SEQ + n * 64;
    const bfr* ST = (const bfr*)(ws + WS_ST) + (size_t)idx * 4096; const bfr* QDEC = (const bfr*)(ws + WS_QDEC); const bfr* OI = (const bfr*)(ws + WS_OINTRA);
    const bfr* PROJ = (const bfr*)(ws + WS_PROJ); bfr* MIX = (bfr*)(ws + WS_MIX);
    bf16x8v st[4][2];
#pragma unroll
    for (int tv = 0; tv < 4; ++tv)
#pragma unroll
        for (int ks = 0; ks < 2; ++ks) st[tv][ks] = *(const bf16x8v*)(ST + (16 * tv + fr) * 64 + 32 * ks + 8 * fq);
    f32x4v gn[4];
#pragma unroll
    for (int tv = 0; tv < 4; ++tv) gn[tv] = *(const f32x4v*)(L.ogain + 16 * tv + 4 * fq);
#pragma unroll
    for (int ti = 0; ti < 4; ++ti) {
        const size_t m = m0 + 16 * ti + fr;
        const bf16x8v q0 = *(const bf16x8v*)(QDEC + m * 256 + h * 64 + 8 * fq), q1 = *(const bf16x8v*)(QDEC + m * 256 + h * 64 + 32 + 8 * fq);
        f32x4v o[4]; float ss = 0.f;
#pragma unroll
        for (int tv = 0; tv < 4; ++tv) {
            f32x4v acc = {0.f, 0.f, 0.f, 0.f};
            acc = __builtin_amdgcn_mfma_f32_16x16x32_bf16(st[tv][0], q0, acc, 0, 0, 0);
            acc = __builtin_amdgcn_mfma_f32_16x16x32_bf16(st[tv][1], q1, acc, 0, 0, 0);
            const u32x2v w = *(const u32x2v*)(OI + m * 256 + h * 64 + 16 * tv + 4 * fq);
            acc[0] += __uint_as_float(w.x << 16); acc[1] += __uint_as_float(w.x & 0xffff0000u); acc[2] += __uint_as_float(w.y << 16); acc[3] += __uint_as_float(w.y & 0xffff0000u);
            o[tv] = acc; ss += (acc[0] * acc[0] + acc[1] * acc[1]) + (acc[2] * acc[2] + acc[3] * acc[3]);
        }
        ss += __shfl_xor(ss, 16); ss += __shfl_xor(ss, 32);
        const float rs = 1.0f / sqrtf(ss * (1.0f / 64.0f) + EPS);
#pragma unroll
        for (int tv = 0; tv < 4; ++tv) {
            const u32x2v gw = *(const u32x2v*)(PROJ + m * NPROJ + C_GG + h * 64 + 16 * tv + 4 * fq);
            const float g0 = __uint_as_float(gw.x << 16), g1 = __uint_as_float(gw.x & 0xffff0000u), g2 = __uint_as_float(gw.y << 16), g3 = __uint_as_float(gw.y & 0xffff0000u);
            u32x2v w; w.x = pk2(o[tv][0] * rs * gn[tv][0] * silu_(g0), o[tv][1] * rs * gn[tv][1] * silu_(g1)); w.y = pk2(o[tv][2] * rs * gn[tv][2] * silu_(g2), o[tv][3] * rs * gn[tv][3] * silu_(g3));
            *(u32x2v*)(MIX + m * DMIX + 768 + h * 64 + 16 * tv + 4 * fq) = w;
        }
    }
}

#define XB_TMO      128
#define XB_XCNT(j)  (256  + 64 * (j))
#define XB_XSUB(j)  (1280 + 64 * (j))
#define XB_XGEN(j)  (2304 + 64 * (j))
#define XB_TOP      3328
#define XB_TOPGEN   3392
#define XCD_BAR_WORDS 3456
#define XB_SPIN_CAP (1u << 18)

__device__ __forceinline__ unsigned xb_ld(unsigned* p)              { return __hip_atomic_load(p, __ATOMIC_RELAXED, __HIP_MEMORY_SCOPE_AGENT); }
__device__ __forceinline__ unsigned xb_add(unsigned* p, unsigned v) { return __hip_atomic_fetch_add(p, v, __ATOMIC_RELAXED, __HIP_MEMORY_SCOPE_AGENT); }
__device__ __forceinline__ unsigned xb_xcc_id() { return (unsigned)__builtin_amdgcn_s_getreg((3 << 11) | 20) & 0xFu; }
#define XB_SPIN(cond, bar) do { unsigned _sp = 0; while (cond) { __builtin_amdgcn_s_sleep(1); \
    if ((++_sp & 255u) == 0u) { if (xb_ld(&(bar)[XB_TMO])) break; if (_sp > XB_SPIN_CAP) { atomicAdd(&(bar)[XB_TMO], 1u); break; } } } } while (0)

struct XcdBarrier {
    unsigned* bar; unsigned x;
    volatile LAS unsigned* st;
};

__device__ __forceinline__ XcdBarrier xcd_barrier_post(unsigned* bar, volatile LAS unsigned* st) {
    XcdBarrier b; b.bar = bar; b.x = xb_xcc_id(); b.st = st;
    if (threadIdx.x == 0) (void)xb_add(&bar[XB_XCNT(b.x)], 1u);
    return b;
}
__device__ __forceinline__ void xcd_barrier_complete(unsigned* bar, unsigned x, unsigned& nloc, unsigned& nx) {
    const unsigned G = gridDim.x * gridDim.y * gridDim.z;
    unsigned sum, cnt, mine, sp = 0u;
    for (;;) {
        sum = 0u; cnt = 0u; mine = 0u;
#pragma unroll
        for (unsigned j = 0; j < 16; ++j) { const unsigned c = xb_ld(&bar[XB_XCNT(j)]); sum += c; cnt += (c > 0u) ? 1u : 0u; mine = (j == x) ? c : mine; }
        if (sum == G) break;
        __builtin_amdgcn_s_sleep(1);
        if ((++sp & 255u) == 0u) { if (xb_ld(&bar[XB_TMO])) break; if (sp > XB_SPIN_CAP) { atomicAdd(&bar[XB_TMO], 1u); break; } }
    }
    nloc = mine > 0u ? mine : 1u; nx = cnt > 0u ? cnt : 1u;
}

__device__ __forceinline__ void xcd_barrier(const XcdBarrier& b) {
    asm volatile("s_waitcnt vmcnt(0)" ::: "memory");
    __syncthreads();
    if (threadIdx.x == 0) {
        unsigned* bar = b.bar;
        __builtin_amdgcn_s_waitcnt(0);
        unsigned nloc = b.st[0], nx = b.st[1];
        if (nloc == 0u) { xcd_barrier_complete(bar, b.x, nloc, nx); b.st[0] = nloc; b.st[1] = nx; }
        const unsigned old = xb_add(&bar[XB_XSUB(b.x)], 1u);
        const unsigned gen = old / nloc;
        if (old + 1u == (gen + 1u) * nloc) {
            __builtin_amdgcn_fence(__ATOMIC_RELEASE, "agent");
            asm volatile("s_waitcnt vmcnt(0)" ::: "memory");
            const unsigned og = xb_add(&bar[XB_TOP], 1u);
            const unsigned tg = og / nx;
            if (og + 1u == (tg + 1u) * nx) xb_add(&bar[XB_TOPGEN], 1u);
            else XB_SPIN(xb_ld(&bar[XB_TOPGEN]) == tg, bar);
            __builtin_amdgcn_fence(__ATOMIC_ACQUIRE, "agent");
            xb_add(&bar[XB_XGEN(b.x)], 1u);
            asm volatile("s_waitcnt vmcnt(0)" ::: "memory");
        } else {
            XB_SPIN(xb_ld(&bar[XB_XGEN(b.x)]) == gen, bar);
            __builtin_amdgcn_fence(__ATOMIC_ACQUIRE, "agent");
            asm volatile("s_waitcnt vmcnt(0)" ::: "memory");
        }
    }
    __syncthreads();
}

#ifdef EXP_P2
#define EXP_KN_ONCE (rep_ == 0)
#else
#define EXP_KN_ONCE true
#endif
#define XBAR1() do { XcdBarrier b_; b_.bar = (unsigned*)P.ws + CW_BAR; b_.x = xb_xcc_id(); b_.st = (volatile LAS unsigned*)(lds + MISC_OFF + 32); xcd_barrier(b_); } while (0)
#ifdef EXP_SYNC
#define GSYNC() do { XBAR1(); XBAR1(); } while (0)
#else
#define GSYNC() XBAR1()
#endif
__global__ void __launch_bounds__(512, 2) hybrid_fwd(Params P) {
    extern __shared__ __attribute__((aligned(16))) unsigned char lds_raw[];
    cg::grid_group grid = cg::this_grid();
    LAS unsigned char* lds = (LAS unsigned char*)lds_raw;
    const int tid = threadIdx.x, lane = tid & 63, wid = __builtin_amdgcn_readfirstlane(tid >> 6);
    const int G = gridDim.x, gw = blockIdx.x * 8 + wid, NGW = G * 8;
    unsigned char* ws = P.ws;
    unsigned* ctl = (unsigned*)(ws + WS_CTL);
    volatile LAS int* slot = (volatile LAS int*)(lds + MISC_OFF);
    const float* MOD = (const float*)(ws + WS_MOD);
    bfr* XB = (bfr*)P.out;
    bfr* HN = (bfr*)(ws + WS_HN); bfr* PROJ = (bfr*)(ws + WS_PROJ); bfr* MIX = (bfr*)(ws + WS_MIX); bfr* GB = (bfr*)(ws + WS_PROJ);

    if (tid < 16) ((LAS unsigned*)(lds + MISC_OFF))[tid] = 0u;
    __syncthreads();
    (void)xcd_barrier_post(ctl + CW_BAR, (volatile LAS unsigned*)(lds + MISC_OFF + 32));
    p0_prologue(P, lds, tid, lane, wid, G);
#ifdef EXP_P0
    __syncthreads(); p0_prologue(P, lds, tid, lane, wid, G);
#endif
    grid.sync();

    for (int l = 0; l < DEPTH; ++l) {
        const float* modl = MOD + (size_t)l * NB * NMOD;
        bfr* XBm = l < DEPTH - 1 ? XB : (bfr*)(ws + WS_OINTRA);
        LayerPtrs L;
        L.conv_w = P.in[7] + (size_t)l * 4 * 384; L.conv_b = P.in[8] + (size_t)l * 384; L.b_r = P.in[10] + (size_t)l * 384; L.b_i = P.in[12] + (size_t)l * 384; L.lam = P.in[13] + (size_t)l * 384;
        L.fox_bf = P.in[14] + (size_t)l * 6; L.qgain = P.in[15] + (size_t)l * 64; L.kgain = P.in[16] + (size_t)l * 64;
        L.w_alpha = P.in[17] + (size_t)l * 16 * 256; L.b_alpha = P.in[18] + (size_t)l * 256; L.ogain = P.in[19] + (size_t)l * 64;
        L.lruw = (const bfr*)(ws + WS_LRUW) + (size_t)l * 6 * 2 * 4096;

        norm_phase(P.in[0], l == 0 ? (const bfr*)nullptr : XB, P.in[2] + (size_t)l * DMODEL, modl, 0, 1024, HN, gw, NGW, lane);
        GSYNC();
        {
            pg8::Gemm g{HN, (const bfr*)(ws + WS_WIN + l * WIN_L), MROWS, NPROJ, DMODEL}; pg8::StaticOrder S; S.init(MROWS, NPROJ, G, (int)blockIdx.x);
            pg8::EpiProj E{PROJ, NPROJ, L.qgain, L.kgain, C_FQ};
            pg8::gemm_phase<pg8::EpiProj, pg8::StaticOrder, PG8_ALIGN, PG8_SP2>(lds, g, S, E);
#ifdef EXP_G16
            __syncthreads(); pg8::gemm_phase<pg8::EpiBf16<0>, pg8::StaticOrder, PG8_ALIGN, PG8_SP2>(lds, g, S, E);
#endif
        }
        GSYNC();
        {
            constexpr int N_CUM = 24, N_GLA = 1024, N_LL = 6 * LRU_NCH * NB, N_KN = 0, N_P2 = N_CUM + N_GLA + N_LL + N_KN;
#ifdef EXP_P2
          for (int rep_ = 0; rep_ < 2; ++rep_) {
            unsigned* ctr = ctl + 64 * l + 16 + 8 * rep_;
#else
            unsigned* ctr = ctl + 64 * l + 16;
#endif
            int cur = blockIdx.x, itn = 0;
            while (cur < N_P2) {
                if (tid == 0) slot[itn & 1] = (int)atomicAdd(ctr, 1u) + G;
                if (cur < N_CUM) cum_item(cur, L, ws, lds, tid, lane, wid);
                else if (cur < N_CUM + N_GLA) gla_local_item(cur - N_CUM, L, ws, lds, tid, lane, wid);
                else if (cur < N_CUM + N_GLA + N_LL) lru_local_item(cur - N_CUM - N_GLA, L, ws, lds, tid, lane, wid);
                __syncthreads();
                cur = slot[itn & 1]; ++itn;
            }
#ifdef EXP_P2
            __syncthreads();
          }
#endif
        }
        GSYNC();
        {
            constexpr int N_ATT = 768, N_SCAN = 128, N_LRU = 384, N_GO = 256, N_ALL = N_ATT + N_SCAN + N_LRU + N_GO;
            unsigned* sdone = ctl + 64 * l + 48;
#ifdef EXP_P3
          for (int rep_ = 0; rep_ < 2; ++rep_) {
            unsigned* ctr = ctl + 64 * l + 32 * rep_;
#else
            unsigned* ctr = ctl + 64 * l;
#endif
            float skip_th;
            { int ln_ = lane; asm volatile("" : "+v"(ln_)); float gq = fabsf(L.qgain[ln_]), gk = fabsf(L.kgain[ln_]);
#pragma unroll
              for (int o = 1; o < 64; o <<= 1) { gq = fmaxf(gq, __shfl_xor(gq, o)); gk = fmaxf(gk, __shfl_xor(gk, o)); }
              skip_th = 150.0f + 2.0f * 11.7f * gq * gk; }
            int cur = blockIdx.x, itn = 0;
            while (cur < N_ALL) {
                if (tid == 0) slot[itn & 1] = (int)atomicAdd(ctr, 1u) + G;
                if (cur < N_SCAN) {
                    gla_scan_item(cur, ws, tid);
                    __syncthreads();
                    if (tid == 0) { __builtin_amdgcn_fence(__ATOMIC_RELEASE, "agent"); asm volatile("s_waitcnt vmcnt(0)" ::: "memory"); __hip_atomic_fetch_add(sdone + (cur >> 3), 1u, __ATOMIC_RELAXED, __HIP_MEMORY_SCOPE_AGENT); }
                } else if (cur < N_SCAN + N_ATT) {
                    const int ua = cur - N_SCAN; const int qb = 31 - ua / 24, bh = ua % 24, b = bh / 6, h = bh % 6;
                    attn_body::attn_unit<96>(b, h, qb, (const attn_body::bf16*)(PROJ + C_FQ), (const attn_body::bf16*)(PROJ + C_FK), (const attn_body::bf16*)(PROJ + C_FV), (attn_body::bf16*)(MIX + 384),
                                            (const float*)(ws + WS_CUM) + (size_t)bh * SEQ, L.qgain, skip_th, (char*)lds_raw);
                } else if (cur < N_SCAN + N_ATT + N_LRU) {
                    lru_out_item(cur - N_ATT - N_SCAN, ws, lds, tid, wid);
                } else {
                    const int gi = (cur - N_SCAN - N_ATT - N_LRU) * 8;
                    if (tid == 0) { unsigned sp = 0; while (__hip_atomic_load(sdone + (gi >> 7), __ATOMIC_RELAXED, __HIP_MEMORY_SCOPE_AGENT) < 8u) { __builtin_amdgcn_s_sleep(2); if (++sp > (1u << 22)) break; }
                        __builtin_amdgcn_fence(__ATOMIC_ACQUIRE, "agent"); asm volatile("s_waitcnt vmcnt(0)" ::: "memory"); }
                    __syncthreads();
                    gla_out_item(gi + wid, L, ws, lane);
                }
                __syncthreads();
                cur = slot[itn & 1]; ++itn;
            }
#ifdef EXP_P3
            __syncthreads();
          }
#endif
        }
        GSYNC();
        {
            pg8::Gemm g{MIX, (const bfr*)(ws + WS_WOUT + l * WOUT_L), MROWS, DMODEL, DMIX}; pg8::StaticOrder S; S.init(MROWS, DMODEL, G, (int)blockIdx.x);
            pg8::EpiResidB E{l == 0 ? P.in[0] : (const float*)nullptr, XB, XBm, (float*)nullptr, DMODEL, modl + 2048, NMOD, SEQ};
            pg8::gemm_phase<pg8::EpiResidB, pg8::StaticOrder, PG8_ALIGN, PG8_SP2>(lds, g, S, E);
        }
        GSYNC();
        norm_phase(P.in[0], XBm, P.in[3] + (size_t)l * DMODEL, modl, 3072, 4096, HN, gw, NGW, lane);
        GSYNC();
        {
            pg8::Gemm g{HN, (const bfr*)(ws + WS_WGU + l * WGU_L), MROWS, NGU, DMODEL}; pg8::StaticOrder S; S.init(MROWS, NGU, G, (int)blockIdx.x);
            pg8::EpiSwiGLU E{GB, DFF};
            pg8::gemm_phase<pg8::EpiSwiGLU, pg8::StaticOrder, PG8_ALIGN, PG8_SP2>(lds, g, S, E);
#ifdef EXP_G16
            __syncthreads(); pg8::gemm_phase<pg8::EpiSwiGLU, pg8::StaticOrder, PG8_ALIGN, PG8_SP2>(lds, g, S, E);
#endif
        }
        GSYNC();
        {
            pg8::Gemm g{GB, (const bfr*)(ws + WS_WDN + l * WDN_L), MROWS, DMODEL, DFF}; pg8::StaticOrder S; S.init(MROWS, DMODEL, G, (int)blockIdx.x);
            pg8::EpiResidB E{(const float*)nullptr, XBm, l < DEPTH - 1 ? XB : (bfr*)nullptr, l < DEPTH - 1 ? (float*)nullptr : P.out, DMODEL, modl + 5120, NMOD, SEQ};
            pg8::gemm_phase<pg8::EpiResidB, pg8::StaticOrder, PG8_ALIGN, PG8_SP2>(lds, g, S, E);
        }
        if (l < DEPTH - 1) GSYNC();
    }
}

extern "C" void kernel_launch(void* const* d_in, const int* in_sizes, int n_in, void* d_out, int out_size, void* d_ws, size_t ws_size, hipStream_t stream) {
    static int grid = 0;
    if (grid == 0) {
        if (n_in != 23 || out_size != MROWS * DMODEL || ws_size < WS_END) { fprintf(stderr, "kernel_launch: unexpected shapes (n_in %d out %d ws %zu)\n", n_in, out_size, ws_size); grid = -1; return; }
        int dev = 0, cus = 0, per_cu = 0;
        if (hipGetDevice(&dev) != hipSuccess || hipDeviceGetAttribute(&cus, hipDeviceAttributeMultiprocessorCount, dev) != hipSuccess) { grid = -1; return; }
        if (hipFuncSetAttribute((const void*)hybrid_fwd, hipFuncAttributeMaxDynamicSharedMemorySize, LDS_BYTES) != hipSuccess) { fprintf(stderr, "kernel_launch: hipFuncSetAttribute failed\n"); grid = -1; return; }
        if (hipOccupancyMaxActiveBlocksPerMultiprocessor(&per_cu, (const void*)hybrid_fwd, 512, LDS_BYTES) != hipSuccess || per_cu < 1) { fprintf(stderr, "kernel_launch: occupancy query says %d\n", per_cu); per_cu = 1; }
        (void)hipGetLastError();
        grid = cus;
    }
    if (grid < 0) return;
    (void)hipMemsetAsync((char*)d_ws + WS_CTL, 0, CTL_BYTES, stream);
    Params p{};
    for (int i = 0; i < 23; ++i) p.in[i] = (const float*)d_in[i];
    p.out = (float*)d_out; p.ws = (unsigned char*)d_ws;
    void* args[] = {&p};
    hipError_t e = hipLaunchCooperativeKernel((const void*)hybrid_fwd, dim3(grid), dim3(512), args, LDS_BYTES, stream);
    if (e != hipSuccess) fprintf(stderr, "kernel_launch: cooperative launch failed: %s (grid %d)\n", hipGetErrorString(e), grid);
}
```

```cpp
#include <hip/hip_runtime.h>
#include <hip/hip_cooperative_groups.h>
#include <hip/hip_bf16.h>
#include <cstdio>
#include <cstdint>
#include <cmath>
namespace cg = cooperative_groups;
namespace pg8 {
#define PG8_LAS __attribute__((address_space(3)))
typedef unsigned short bf16_t;
typedef short bf16x8 __attribute__((ext_vector_type(8)));
typedef float f32x4 __attribute__((ext_vector_type(4)));
typedef unsigned u32x4 __attribute__((ext_vector_type(4)));
constexpr int BM = 256, BK = 64, HALF = 128, HTB = HALF * BK * 2  , STAGE_BYTES = 8 * HTB, NXCD = 8, WGM = 8;

__host__ __device__ __forceinline__ int lds_byte(int r, int c) { const int st = (r >> 4) * 2 + (c >> 5), rr = r & 15, cc = c & 31, ob = rr * 64 + cc * 2; return st * 1024 + (ob ^ (((ob >> 9) & 1) << 5)); }
__host__ __device__ __forceinline__ void stage_rc(int b, int& R, int& C) { const int st = b / 1024, sb = b % 1024, swz = sb ^ (((sb >> 9) & 1) << 5); R = (st >> 1) * 16 + swz / 64; C = (st & 1) * 32 + (swz % 64) / 2; }
__host__ __device__ __forceinline__ int perm32(int rho) { const int n = rho >> 4, i = rho & 15; return 8 * (i >> 2) + 4 * n + (i & 3); }

struct Unit { int pm, pn; };
struct Gemm { const bf16_t* A; const bf16_t* Bt; int M, N, K; };

struct StaticOrder {
    int nM, nN, nwg, G, c;
    __host__ __device__ void init(int M, int N, int G_, int c_) { nM = M / BM; nN = N / BM; nwg = nM * nN; G = G_; c = c_; }
    __host__ __device__ bool next(int i, Unit& u) const {
        const long L = (long)i * G + c; if (L >= nwg) return false;
        int wgid = (int)L; { const int q = nwg / NXCD, r = nwg % NXCD, xcd = wgid % NXCD, off = wgid / NXCD; wgid = (xcd < r ? xcd * (q + 1) : r * (q + 1) + (xcd - r) * q) + off; }
        const int nig = WGM * nN, gid = wgid / nig, fm = gid * WGM, gsz = (nM - fm) < WGM ? (nM - fm) : WGM;
        u.pm = fm + ((wgid % nig) % gsz); u.pn = (wgid % nig) / gsz; return true;
    }
    __device__ __forceinline__ void a_ready(const Unit&) const {}
    __device__ __forceinline__ void done(const Unit&) const {}
};

__device__ __forceinline__ unsigned cvt_pk_bf16(float lo, float hi) { unsigned r; asm volatile("v_cvt_pk_bf16_f32 %0, %1, %2" : "=v"(r) : "v"(lo), "v"(hi)); return r; }
typedef float f32x2 __attribute__((ext_vector_type(2)));
__device__ __forceinline__ f32x2 gelu_pk(f32x2 v) {
    const f32x2 av = __builtin_elementwise_abs(v), d = av * 0.2316418882f + 1.0f;
    f32x2 t; t.x = __builtin_amdgcn_rcpf(d.x); t.y = __builtin_amdgcn_rcpf(d.y);
    f32x2 q = t * 0.5307027145f + (-0.7265760135f); q = q * t + 0.7107068705f; q = q * t + (-0.142248368f); q = q * t + 0.127414796f; q = q * t;
    const f32x2 s = (v * v) * (-0.72134752044f);
    f32x2 e; e.x = __builtin_amdgcn_exp2f(s.x); e.y = __builtin_amdgcn_exp2f(s.y);
    const f32x2 m = v * (q * e), r = v - m;
    f32x2 o; o.x = v.x < 0.f ? m.x : r.x; o.y = v.y < 0.f ? m.y : r.y; return o;
}

template <int ACT  > struct EpiBf16 {
    static constexpr bool PERM = true, AFTER_DRAIN = false; static_assert(ACT == 0 || ACT == 1, "EpiBf16: ACT is 0 (none) or 1 (gelu_pk)");
    bf16_t* O; int ldc; const float* bias; int split_cols; size_t split_stride; float scale0;
    __device__ __forceinline__ void operator()(const f32x4 (&acc)[2][2][4][2], const Unit& u, int wr, int wc, int fr, int fq) const {
        const int row0 = u.pm * BM + wr * 64 + fr; int colt = u.pn * BM; bf16_t* base = O;
        float sc = 1.f; if (split_cols) { const int t = colt / split_cols; base += (size_t)t * split_stride; colt -= t * split_cols; if (t == 0) sc = scale0; }
        const int col0 = colt + wc * 32 + 8 * fq, bcol0 = u.pn * BM + wc * 32 + 8 * fq;
        f32x4 bv[2][2];
#pragma unroll
        for (int bj = 0; bj < 2; ++bj)
#pragma unroll
            for (int n = 0; n < 2; ++n) bv[bj][n] = bias ? *(const f32x4*)(bias + bcol0 + bj * HALF + 4 * n) : (f32x4){0.f, 0.f, 0.f, 0.f};
#pragma unroll
        for (int ai = 0; ai < 2; ++ai)
#pragma unroll
            for (int m = 0; m < 4; ++m) { bf16_t* rowp = base + (size_t)(row0 + ai * HALF + m * 16) * ldc + col0;
#pragma unroll
                for (int bj = 0; bj < 2; ++bj) { f32x4 v0 = acc[ai][bj][m][0] + bv[bj][0], v1 = acc[ai][bj][m][1] + bv[bj][1];
                    if (ACT == 1) { f32x2 a = gelu_pk((f32x2){v0[0], v0[1]}), b = gelu_pk((f32x2){v0[2], v0[3]}), c = gelu_pk((f32x2){v1[0], v1[1]}), d = gelu_pk((f32x2){v1[2], v1[3]});
                        v0 = (f32x4){a.x, a.y, b.x, b.y}; v1 = (f32x4){c.x, c.y, d.x, d.y}; }
                    v0 = v0 * sc; v1 = v1 * sc; u32x4 w; w.x = cvt_pk_bf16(v0[0], v0[1]); w.y = cvt_pk_bf16(v0[2], v0[3]); w.z = cvt_pk_bf16(v1[0], v1[1]); w.w = cvt_pk_bf16(v1[2], v1[3]);
                    *(u32x4*)(rowp + bj * HALF) = w; } }
    }
};


struct EpiProj {
    static constexpr bool PERM = true, AFTER_DRAIN = false;
    bf16_t* O; int ldc; const float* qgain; const float* kgain; int cfq;
    __device__ __forceinline__ void operator()(const f32x4 (&acc)[2][2][4][2], const Unit& u, int wr, int wc, int fr, int fq) const {
        const int row0 = u.pm * BM + wr * 64 + fr;
        if (u.pn < 3 || u.pn > 5) {
            const int col0 = u.pn * BM + wc * 32 + 8 * fq;
#pragma unroll
            for (int ai = 0; ai < 2; ++ai)
#pragma unroll
                for (int m = 0; m < 4; ++m) { bf16_t* rowp = O + (size_t)(row0 + ai * HALF + m * 16) * ldc + col0;
#pragma unroll
                    for (int bj = 0; bj < 2; ++bj) { const f32x4 v0 = acc[ai][bj][m][0], v1 = acc[ai][bj][m][1];
                        u32x4 w; w.x = cvt_pk_bf16(v0[0], v0[1]); w.y = cvt_pk_bf16(v0[2], v0[3]); w.z = cvt_pk_bf16(v1[0], v1[1]); w.w = cvt_pk_bf16(v1[2], v1[3]);
                        *(u32x4*)(rowp + bj * HALF) = w; } }
        } else {
            const int H = 4 * (u.pn - 3) + wc;
            const float* gp = (H < 6 ? qgain : kgain) + 8 * fq; const float sc = H < 6 ? 0.125f * 1.4426950408889634f : 1.0f;
            f32x4 gv[2][2];
#pragma unroll
            for (int bj = 0; bj < 2; ++bj)
#pragma unroll
                for (int n = 0; n < 2; ++n) gv[bj][n] = *(const f32x4*)(gp + 32 * bj + 4 * n) * sc;
            const int col0 = cfq + H * 64 + 8 * fq;
#pragma unroll
            for (int ai = 0; ai < 2; ++ai)
#pragma unroll
                for (int m = 0; m < 4; ++m) { bf16_t* rowp = O + (size_t)(row0 + ai * HALF + m * 16) * ldc + col0;
                    float ss = 0.f;
#pragma unroll
                    for (int bj = 0; bj < 2; ++bj)
#pragma unroll
                        for (int n = 0; n < 2; ++n) { const f32x4 x = acc[ai][bj][m][n]; ss += (x[0] * x[0] + x[1] * x[1]) + (x[2] * x[2] + x[3] * x[3]); }
                    ss += __shfl_xor(ss, 16); ss += __shfl_xor(ss, 32);
                    const float rs = __builtin_amdgcn_rsqf(ss * (1.0f / 64.0f) + 1e-6f);
#pragma unroll
                    for (int bj = 0; bj < 2; ++bj) { const f32x4 v0 = acc[ai][bj][m][0] * rs * gv[bj][0], v1 = acc[ai][bj][m][1] * rs * gv[bj][1];
                        u32x4 w; w.x = cvt_pk_bf16(v0[0], v0[1]); w.y = cvt_pk_bf16(v0[2], v0[3]); w.z = cvt_pk_bf16(v1[0], v1[1]); w.w = cvt_pk_bf16(v1[2], v1[3]);
                        *(u32x4*)(rowp + 32 * bj) = w; } }
        }
    }
};
struct EpiSwiGLU {
    static constexpr bool PERM = true, AFTER_DRAIN = false;
    bf16_t* O; int ldc;
    __device__ __forceinline__ void operator()(const f32x4 (&acc)[2][2][4][2], const Unit& u, int wr, int wc, int fr, int fq) const {
        const int row0 = u.pm * BM + wr * 64 + fr; const int col0 = u.pn * HALF + wc * 32 + 8 * fq;
#pragma unroll
        for (int ai = 0; ai < 2; ++ai)
#pragma unroll
            for (int m = 0; m < 4; ++m) { bf16_t* rowp = O + (size_t)(row0 + ai * HALF + m * 16) * ldc + col0;
                float o[8];
#pragma unroll
                for (int n = 0; n < 2; ++n)
#pragma unroll
                    for (int j = 0; j < 4; ++j) { const float g = acc[ai][0][m][n][j], up = acc[ai][1][m][n][j];
                        const float sg = g * __builtin_amdgcn_rcpf(1.0f + __builtin_amdgcn_exp2f(-1.4426950408889634f * g)); o[n * 4 + j] = sg * up; }
                u32x4 w; w.x = cvt_pk_bf16(o[0], o[1]); w.y = cvt_pk_bf16(o[2], o[3]); w.z = cvt_pk_bf16(o[4], o[5]); w.w = cvt_pk_bf16(o[6], o[7]);
                *(u32x4*)rowp = w; }
    }
};
struct EpiResid {
    static constexpr bool PERM = false, AFTER_DRAIN = false;
    const float* base; float* out; int ldc; const float* gate; int gstride; int rows_per_batch;
    __device__ __forceinline__ void operator()(const f32x4 (&acc)[2][2][4][2], const Unit& u, int wr, int wc, int fr, int fq) const {
        const int col0 = u.pn * BM + wc * 32 + 4 * fq;
        const float* gp = gate + (size_t)((u.pm * BM) / rows_per_batch) * gstride + col0;
        f32x4 gv[2][2];
#pragma unroll
        for (int bj = 0; bj < 2; ++bj)
#pragma unroll
            for (int n = 0; n < 2; ++n) gv[bj][n] = *(const f32x4*)(gp + bj * HALF + n * 16);
#pragma unroll
        for (int ai = 0; ai < 2; ++ai)
#pragma unroll
            for (int m = 0; m < 4; ++m) { const size_t off = (size_t)(u.pm * BM + ai * HALF + wr * 64 + m * 16 + fr) * ldc + col0;
#pragma unroll
                for (int bj = 0; bj < 2; ++bj)
#pragma unroll
                    for (int n = 0; n < 2; ++n) { const f32x4 bs = *(const f32x4*)(base + off + bj * HALF + n * 16);
                        *(f32x4*)(out + off + bj * HALF + n * 16) = bs + gv[bj][n] * acc[ai][bj][m][n]; } }
    }
};


typedef _Float16 h16x2 __attribute__((ext_vector_type(2)));
__device__ __forceinline__ f32x2 h2f(unsigned w) { return __builtin_convertvector(__builtin_bit_cast(h16x2, w), f32x2); }
__device__ __forceinline__ unsigned f2h(float lo, float hi) { f32x2 v = {lo, hi}; return __builtin_bit_cast(unsigned, __builtin_convertvector(v, h16x2)); }
struct EpiResidB {
    static constexpr bool PERM = true, AFTER_DRAIN = false;
    const float* base32; const bf16_t* base16; bf16_t* out16; float* out32; int ldc; const float* gate; int gstride; int rows_per_batch;
    __device__ __forceinline__ void operator()(const f32x4 (&acc)[2][2][4][2], const Unit& u, int wr, int wc, int fr, int fq) const {
        const int row0 = u.pm * BM + wr * 64 + fr; const int col0 = u.pn * BM + wc * 32 + 8 * fq;
        const float* gp = gate + (size_t)((u.pm * BM) / rows_per_batch) * gstride + col0;
        f32x4 gv[2][2];
#pragma unroll
        for (int bj = 0; bj < 2; ++bj)
#pragma unroll
            for (int n = 0; n < 2; ++n) gv[bj][n] = *(const f32x4*)(gp + bj * HALF + 4 * n);
#pragma unroll
        for (int ai = 0; ai < 2; ++ai)
#pragma unroll
            for (int m = 0; m < 4; ++m) { const size_t off = (size_t)(row0 + ai * HALF + m * 16) * ldc + col0;
#pragma unroll
                for (int bj = 0; bj < 2; ++bj) {
                    f32x4 b0, b1;
                    if (base32) { b0 = *(const f32x4*)(base32 + off + bj * HALF); b1 = *(const f32x4*)(base32 + off + bj * HALF + 4); }
                    else { const u32x4 w = *(const u32x4*)(base16 + off + bj * HALF);
                        const f32x2 p0 = h2f(w.x), p1 = h2f(w.y), p2 = h2f(w.z), p3 = h2f(w.w);
                        b0 = (f32x4){p0.x, p0.y, p1.x, p1.y}; b1 = (f32x4){p2.x, p2.y, p3.x, p3.y}; }
                    const f32x4 v0 = b0 + gv[bj][0] * acc[ai][bj][m][0], v1 = b1 + gv[bj][1] * acc[ai][bj][m][1];
                    if (out32) { *(f32x4*)(out32 + off + bj * HALF) = v0; *(f32x4*)(out32 + off + bj * HALF + 4) = v1; }
                    else { u32x4 w; w.x = f2h(v0[0], v0[1]); w.y = f2h(v0[2], v0[3]); w.z = f2h(v1[0], v1[1]); w.w = f2h(v1[2], v1[3]); *(u32x4*)(out16 + off + bj * HALF) = w; } } }
    }
};

template <class Epi, class Sched, bool ALIGN_EPI = false, bool SP2 = false>
__device__ __forceinline__ void gemm_phase(PG8_LAS unsigned char* lds, const Gemm g, const Sched& S, const Epi& E) {
    int tid = threadIdx.x; asm volatile("" : "+v"(tid)); const int wid = __builtin_amdgcn_readfirstlane(tid >> 6), lane = tid & 63, wr = wid >> 2, wc = wid & 3, fr = lane & 15, fq = lane >> 4;
    const int K = g.K, nt = K / BK;
    unsigned voffA[2], voffB[2];
#pragma unroll
    for (int i = 0; i < 2; ++i) { int R, C; stage_rc(tid * 16 + i * 8192, R, C); const int Rb = Epi::PERM ? ((R & ~31) + perm32(R & 31)) : R;
        voffA[i] = (unsigned)(R * K + C) * 2u; voffB[i] = (unsigned)(Rb * K + C) * 2u; }
    const size_t kstep = (size_t)(BK * 2);
    const size_t hstep = (size_t)HALF * K * 2;
    const size_t tstep = 2 * hstep;
    const unsigned ldsw = (unsigned)wid * 1024u;
    const int aoff = lds_byte(wr * 64 + fr, fq * 8), boff = lds_byte(wc * 32 + fr, fq * 8);
#define PG8_SA(b, h) (((b) * 2 + (h)) * HTB)
#define PG8_SB(b, h) ((4 + (b) * 2 + (h)) * HTB)
#define PG8_STAGE(bufoff, gbase, voff) do { _Pragma("unroll") for (int _i = 0; _i < 2; ++_i) \
        __builtin_amdgcn_global_load_lds((const unsigned*)((const char*)(gbase) + (voff)[_i]), (PG8_LAS unsigned*)(lds + (bufoff) + ldsw + _i * 8192), 16, 0, 0); } while (0)
#define PG8_LDA(dst, b, h) do { _Pragma("unroll") for (int m = 0; m < 4; ++m) _Pragma("unroll") for (int k = 0; k < 2; ++k) dst[m][k] = *(const PG8_LAS bf16x8*)(lds + PG8_SA(b, h) + aoff + m * 2048 + k * 1024); } while (0)
#define PG8_LDB(dst, b, h) do { _Pragma("unroll") for (int n = 0; n < 2; ++n) _Pragma("unroll") for (int k = 0; k < 2; ++k) dst[n][k] = *(const PG8_LAS bf16x8*)(lds + PG8_SB(b, h) + boff + n * 2048 + k * 1024); } while (0)
#define PG8_MMA(ai, bj, At, Bt) do { __builtin_amdgcn_s_setprio(1); _Pragma("unroll") for (int m = 0; m < 4; ++m) _Pragma("unroll") for (int n = 0; n < 2; ++n) _Pragma("unroll") for (int k = 0; k < 2; ++k) \
        acc[ai][bj][m][n] = __builtin_amdgcn_mfma_f32_16x16x32_bf16(Bt[n][k], At[m][k], acc[ai][bj][m][n], 0, 0, 0); __builtin_amdgcn_s_setprio(0); } while (0)
#define PG8_WAIT_V(n) asm volatile("s_waitcnt vmcnt(" #n ")" ::: "memory")
#define PG8_WAIT_L(n) asm volatile("s_waitcnt lgkmcnt(" #n ")" ::: "memory")
#define PG8_BAR __builtin_amdgcn_s_barrier()
#define PG8_SCHED __builtin_amdgcn_sched_barrier(0)
    Unit cur, nxt; int ui = 0;
    if (!S.next(0, cur)) return;
    f32x4 acc[2][2][4][2];
#pragma unroll
    for (int a = 0; a < 2; ++a)
#pragma unroll
        for (int b = 0; b < 2; ++b)
#pragma unroll
            for (int m = 0; m < 4; ++m)
#pragma unroll
                for (int n = 0; n < 2; ++n) acc[a][b][m][n] = (f32x4){0.f, 0.f, 0.f, 0.f};
    bf16x8 At[4][2], B0[2][2], B1[2][2];
    const char* cA = (const char*)g.A + (size_t)cur.pm * tstep; const char* cB = (const char*)g.Bt + (size_t)cur.pn * tstep;
    S.a_ready(cur);
    if constexpr (SP2) {
        PG8_STAGE(PG8_SB(0, 0), cB, voffB); PG8_STAGE(PG8_SB(0, 1), cB + hstep, voffB); PG8_STAGE(PG8_SA(0, 0), cA, voffA); PG8_STAGE(PG8_SA(0, 1), cA + hstep, voffA);
        if (wr == 1) PG8_BAR;
        PG8_WAIT_V(2); PG8_BAR;
        PG8_STAGE(PG8_SB(1, 0), cB + kstep, voffB); PG8_STAGE(PG8_SA(1, 0), cA + kstep, voffA); PG8_STAGE(PG8_SB(1, 1), cB + hstep + kstep, voffB);
        PG8_WAIT_V(6); PG8_BAR;
    } else {
        PG8_STAGE(PG8_SB(0, 0), cB, voffB); PG8_STAGE(PG8_SA(0, 0), cA, voffA); PG8_STAGE(PG8_SB(0, 1), cB + hstep, voffB); PG8_STAGE(PG8_SA(0, 1), cA + hstep, voffA);
        if (wr == 1) PG8_BAR;
        PG8_WAIT_V(4); PG8_BAR;
        PG8_STAGE(PG8_SB(1, 0), cB + kstep, voffB); PG8_STAGE(PG8_SA(1, 0), cA + kstep, voffA); PG8_STAGE(PG8_SB(1, 1), cB + hstep + kstep, voffB);
        PG8_WAIT_V(6); PG8_BAR;
    }
    for (;;) {
        const bool has_next = S.next(ui + 1, nxt);
        const char* nA = has_next ? (const char*)g.A + (size_t)nxt.pm * tstep : cA; const char* nB = has_next ? (const char*)g.Bt + (size_t)nxt.pn * tstep : cB;
        for (int t = 0; t < nt; t += 2) {
            const bool last = (t == nt - 2);
            const char* a1 = cA + (size_t)(t + 1) * kstep;
            const char* a2 = last ? nA : cA + (size_t)(t + 2) * kstep; const char* b2 = last ? nB : cB + (size_t)(t + 2) * kstep;
            const char* a3 = a2 + kstep; const char* b3 = b2 + kstep;
            if (last && has_next) S.a_ready(nxt);
            if constexpr (SP2) {
            PG8_LDB(B0, 0, 0); PG8_LDB(B1, 0, 1); PG8_SCHED; PG8_LDA(At, 0, 0); PG8_STAGE(PG8_SA(1, 1), a1 + hstep, voffA);
            PG8_WAIT_V(8); PG8_WAIT_L(0); PG8_BAR; PG8_MMA(0, 0, At, B0); PG8_MMA(0, 1, At, B1); PG8_BAR; PG8_SCHED;
            PG8_LDA(At, 0, 1); PG8_STAGE(PG8_SB(0, 0), b2, voffB); PG8_STAGE(PG8_SB(0, 1), b2 + hstep, voffB); PG8_STAGE(PG8_SA(0, 0), a2, voffA);
            PG8_WAIT_V(8); PG8_WAIT_L(0); PG8_BAR; PG8_MMA(1, 0, At, B0); PG8_MMA(1, 1, At, B1); PG8_BAR; PG8_SCHED;
            PG8_LDB(B0, 1, 0); PG8_LDB(B1, 1, 1); PG8_SCHED; PG8_LDA(At, 1, 0); PG8_STAGE(PG8_SA(0, 1), a2 + hstep, voffA);
            PG8_WAIT_V(8); PG8_WAIT_L(0); PG8_BAR; PG8_MMA(0, 0, At, B0); PG8_MMA(0, 1, At, B1); PG8_BAR; PG8_SCHED;
            PG8_LDA(At, 1, 1); PG8_STAGE(PG8_SB(1, 0), b3, voffB); PG8_STAGE(PG8_SB(1, 1), b3 + hstep, voffB); PG8_STAGE(PG8_SA(1, 0), a3, voffA);
            PG8_WAIT_V(8); PG8_WAIT_L(0); PG8_BAR; PG8_MMA(1, 0, At, B0); PG8_MMA(1, 1, At, B1); PG8_BAR; PG8_SCHED;
            } else {
            PG8_LDB(B0, 0, 0); PG8_SCHED; PG8_LDA(At, 0, 0); PG8_STAGE(PG8_SA(1, 1), a1 + hstep, voffA);
            PG8_WAIT_L(8); PG8_BAR; PG8_WAIT_L(0); PG8_MMA(0, 0, At, B0); PG8_BAR; PG8_SCHED;
            PG8_LDB(B1, 0, 1); PG8_STAGE(PG8_SB(0, 0), b2, voffB);
            PG8_BAR; PG8_WAIT_L(0); PG8_MMA(0, 1, At, B1); PG8_BAR;
            PG8_LDA(At, 0, 1); PG8_STAGE(PG8_SA(0, 0), a2, voffA);
            PG8_BAR; PG8_WAIT_L(0); PG8_MMA(1, 0, At, B0); PG8_BAR; PG8_SCHED;
            PG8_STAGE(PG8_SB(0, 1), b2 + hstep, voffB);
            PG8_WAIT_V(6); PG8_BAR; PG8_MMA(1, 1, At, B1); PG8_BAR;
            PG8_LDB(B0, 1, 0); PG8_SCHED; PG8_LDA(At, 1, 0); PG8_STAGE(PG8_SA(0, 1), a2 + hstep, voffA);
            PG8_WAIT_L(8); PG8_BAR; PG8_WAIT_L(0); PG8_MMA(0, 0, At, B0); PG8_BAR; PG8_SCHED;
            PG8_LDB(B1, 1, 1); PG8_STAGE(PG8_SB(1, 0), b3, voffB);
            PG8_BAR; PG8_WAIT_L(0); PG8_MMA(0, 1, At, B1); PG8_BAR;
            PG8_LDA(At, 1, 1); PG8_STAGE(PG8_SA(1, 0), a3, voffA);
            PG8_BAR; PG8_WAIT_L(0); PG8_MMA(1, 0, At, B0); PG8_BAR; PG8_SCHED;
            PG8_STAGE(PG8_SB(1, 1), b3 + hstep, voffB);
            PG8_WAIT_V(6); PG8_BAR; PG8_MMA(1, 1, At, B1); PG8_BAR;
            }
        }
        if constexpr (ALIGN_EPI) { if (wr == 0) PG8_BAR; }
        if constexpr (!Epi::AFTER_DRAIN) { E(acc, cur, wr, wc, fr, fq); S.done(cur); }
        if (!has_next) break;
#pragma unroll
        for (int a = 0; a < 2; ++a)
#pragma unroll
            for (int b = 0; b < 2; ++b)
#pragma unroll
                for (int m = 0; m < 4; ++m)
#pragma unroll
                    for (int n = 0; n < 2; ++n) acc[a][b][m][n] = (f32x4){0.f, 0.f, 0.f, 0.f};
        cur = nxt; cA = nA; cB = nB; ++ui;
        if constexpr (ALIGN_EPI) { if (wr == 1) PG8_BAR; }
    }
    PG8_WAIT_V(0);
    if constexpr (!ALIGN_EPI) { if (wr == 0) PG8_BAR; }
    PG8_BAR;
    if constexpr (Epi::AFTER_DRAIN) { E.fused(acc, cur, wr, wc, fr, fq, lds, wid, lane); S.done(cur); }
#undef PG8_SA
#undef PG8_SB
#undef PG8_STAGE
#undef PG8_LDA
#undef PG8_LDB
#undef PG8_MMA
#undef PG8_WAIT_V
#undef PG8_WAIT_L
#undef PG8_BAR
#undef PG8_SCHED
}
}

#ifndef PG8_SP2
#define PG8_SP2 true
#endif
#ifndef PG8_ALIGN
#define PG8_ALIGN true
#endif
#include <hip/hip_bf16.h>
#include <cmath>
namespace attn_body {
using bf16=__hip_bfloat16;
using bf16x8=__attribute__((ext_vector_type(8)))short;
using s16x4=__attribute__((ext_vector_type(4)))short;
using f32x16=__attribute__((ext_vector_type(16)))float;
using u32x4=__attribute__((ext_vector_type(4)))unsigned;
constexpr int BATCH=4,NHEAD=6,SEQ=8192,D=64,DM=3072,ODM=1024;
constexpr int NW=8,QBLK=32,QB=QBLK*NW,KVBLK=64,NQB=SEQ/QB;
constexpr int ATTN_PITCH=DM, ATTN_UNIT_ROWS=QB;
__device__ __forceinline__ int crow(int r,int hi){return (r&3)+8*(r>>2)+4*hi;}
#define SBAR() __builtin_amdgcn_sched_barrier(0)
__device__ __forceinline__ void cmask(f32x16&p0,f32x16&p1,int jb,int qrel,int hi){
  const float NEG=-INFINITY; int kb=64*jb+4*hi;
  #pragma unroll
  for(int r=0;r<16;++r){int kv=kb+(r&3)+8*(r>>2); if(kv>qrel)p0[r]=NEG; if(kv+32>qrel)p1[r]=NEG;}
}

constexpr int NSLOT=3, SLOTB=8192;
constexpr int LDS_K=0, LDS_V=NSLOT*SLOTB, LDS_WS=2*NSLOT*SLOTB, LDS_OST=LDS_WS+NW*64*4, LDS_CKS=LDS_OST+NW*4096, LDS_BYTES=LDS_CKS+SEQ*4;
constexpr float C2=0.125f*1.4426950408889634f;
__device__ __forceinline__ void glds16(const void*gsrc,unsigned lds_dst){unsigned keep;
  asm volatile("s_mov_b32 %0, m0\n\ts_mov_b32 m0, %2\n\ts_nop 0\n\tglobal_load_lds_dwordx4 %1, off\n\ts_mov_b32 m0, %0":"=&s"(keep):"v"(gsrc),"s"(lds_dst):"memory");}
__device__ __forceinline__ float max3f(float a,float b,float c){float r;asm("v_max3_f32 %0, %1, %2, %3":"=v"(r):"v"(a),"v"(b),"v"(c));return r;}
__device__ __forceinline__ float max2f(float a,float b){float r;asm("v_max_f32_e32 %0, %1, %2":"=v"(r):"v"(a),"v"(b));return r;}
__device__ __forceinline__ float fadd_s(float a,float b){float r;asm("v_add_f32_e32 %0, %1, %2":"=v"(r):"v"(a),"v"(b));return r;}
__device__ __forceinline__ float fsub_s(float a,float b){float r;asm("v_sub_f32_e32 %0, %1, %2":"=v"(r):"v"(a),"v"(b));return r;}
typedef float f32x2_t __attribute__((ext_vector_type(2))); typedef __bf16 bf16x2_t __attribute__((ext_vector_type(2)));
__device__ __forceinline__ unsigned cvtpk_s(float lo,float hi){f32x2_t v={lo,hi};bf16x2_t b=__builtin_convertvector(v,bf16x2_t);return __builtin_bit_cast(unsigned,b);}
#define WAIT_BAR(N) asm volatile("s_waitcnt vmcnt(" #N ") lgkmcnt(0)\n\ts_barrier":::"memory")

__device__ __forceinline__ void qkt(f32x16&p0,f32x16&p1,const char*Kslot,const bf16x8*qr,const f32x16&negm,int r32,int hi){
  const char*kb=Kslot+hi*1024+r32*16;
  #pragma unroll
  for(int d0=0;d0<4;++d0){
    const bf16x8 b0=*reinterpret_cast<const bf16x8*>(kb+d0*2048);
    const bf16x8 b1=*reinterpret_cast<const bf16x8*>(kb+d0*2048+512);
    if(d0==0){p0=__builtin_amdgcn_mfma_f32_32x32x16_bf16(b0,qr[0],negm,0,0,0);p1=__builtin_amdgcn_mfma_f32_32x32x16_bf16(b1,qr[0],negm,0,0,0);}
    else{p0=__builtin_amdgcn_mfma_f32_32x32x16_bf16(b0,qr[d0],p0,0,0,0);p1=__builtin_amdgcn_mfma_f32_32x32x16_bf16(b1,qr[d0],p1,0,0,0);}}
}
typedef __attribute__((address_space(3))) const char* lds_cptr;
typedef short v4i16_t __attribute__((ext_vector_type(4)));
__device__ __forceinline__ void kload8(bf16x8*kf,lds_cptr kp){
  kf[0]=*(const __attribute__((address_space(3))) bf16x8*)(kp);      kf[1]=*(const __attribute__((address_space(3))) bf16x8*)(kp+512);
  kf[2]=*(const __attribute__((address_space(3))) bf16x8*)(kp+2048); kf[3]=*(const __attribute__((address_space(3))) bf16x8*)(kp+2560);
  kf[4]=*(const __attribute__((address_space(3))) bf16x8*)(kp+4096); kf[5]=*(const __attribute__((address_space(3))) bf16x8*)(kp+4608);
  kf[6]=*(const __attribute__((address_space(3))) bf16x8*)(kp+6144); kf[7]=*(const __attribute__((address_space(3))) bf16x8*)(kp+6656);
}
__device__ __forceinline__ void kload2(bf16x8*kf,lds_cptr kp,int j){ kf[2*j]=*(const __attribute__((address_space(3))) bf16x8*)(kp+j*2048); kf[2*j+1]=*(const __attribute__((address_space(3))) bf16x8*)(kp+j*2048+512); }
__device__ __forceinline__ s16x4 vtr(lds_cptr p){ return __builtin_bit_cast(s16x4,__builtin_amdgcn_ds_read_tr16_b64_v4i16((__attribute__((address_space(3))) v4i16_t*)p)); }
__device__ __forceinline__ float rowmax(const f32x16&p0,const f32x16&p1){
  float a=max3f(p0[0],p0[1],p1[0]),b=max3f(p0[2],p0[3],p1[1]);a=max3f(a,p1[2],p1[3]);
  #pragma unroll
  for(int r=4;r<16;r+=4){a=max3f(a,p0[r],p0[r+1]);b=max3f(b,p0[r+2],p0[r+3]);a=max3f(a,p1[r],p1[r+1]);b=max3f(b,p1[r+2],p1[r+3]);}
  const float m=max2f(a,b);
  auto rr=__builtin_amdgcn_permlane32_swap(__float_as_uint(m),__float_as_uint(m),false,false);
  return max2f(__uint_as_float(rr[0]),__uint_as_float(rr[1]));
}
__device__ __forceinline__ void pv(f32x16*o,int vb,bf16x8 pa0,bf16x8 pa1,bf16x8 pa2,bf16x8 pa3){
  #pragma unroll
  for(int d0=0;d0<2;++d0){s16x4 lo[4],hi[4];
    #pragma unroll
    for(int ks=0;ks<4;++ks){
      asm volatile("ds_read_b64_tr_b16 %0,%1 offset:%c2":"=&v"(lo[ks]):"v"(vb),"i"(d0*4096+ks*1024):"memory");
      asm volatile("ds_read_b64_tr_b16 %0,%1 offset:%c2":"=&v"(hi[ks]):"v"(vb),"i"(d0*4096+ks*1024+512):"memory");}
    asm volatile("s_waitcnt lgkmcnt(0)":::"memory");SBAR();
    #define PK(k) (bf16x8){lo[k][0],lo[k][1],lo[k][2],lo[k][3],hi[k][0],hi[k][1],hi[k][2],hi[k][3]}
    o[d0]=__builtin_amdgcn_mfma_f32_32x32x16_bf16(pa0,PK(0),o[d0],0,0,0);
    o[d0]=__builtin_amdgcn_mfma_f32_32x32x16_bf16(pa1,PK(1),o[d0],0,0,0);
    o[d0]=__builtin_amdgcn_mfma_f32_32x32x16_bf16(pa2,PK(2),o[d0],0,0,0);
    o[d0]=__builtin_amdgcn_mfma_f32_32x32x16_bf16(pa3,PK(3),o[d0],0,0,0);
    #undef PK
  }
}

#ifndef ATTN_STORE16
#define ATTN_STORE16(p,v) (*(u32x4*)(p)=(v))
#endif
template<int THRL> __device__ __forceinline__ void attn_unit(int b,int h,int qb,const bf16*Q,const bf16*__restrict__ K,const bf16*__restrict__ V,bf16*O,const float*__restrict__ CUMh,const float*__restrict__ qgain,const float skip_th,char*shm){
  int tid=threadIdx.x; asm volatile("":"+v"(tid)); const int lane=tid&63,r32=lane&31,hi=lane>>5; const int wid=__builtin_amdgcn_readfirstlane(tid>>6);
  const long rowbase=(long)b*SEQ; const int q0=qb*QB;
  const bf16*Qw=Q+(rowbase+q0+wid*QBLK)*DM+h*D;
  const bf16*Kh=K+rowbase*DM+h*D,*Vh=V+rowbase*DM+h*D;
  const float cref=CUMh[q0]; int ts=0;
  { const int tmax=(q0+QB)/KVBLK-4;
    for(int t0=0;t0<tmax;t0+=64){ const int t=t0+lane; bool sk=false; if(t<tmax) sk=(CUMh[64*t+63]-cref)*1.4426950408889634f>skip_th; ts+=__popcll(__ballot(sk)); }
    ts=__builtin_amdgcn_readfirstlane(ts)&~1; }
  Kh+=(long)ts*KVBLK*DM; Vh+=(long)ts*KVBLK*DM;
  const unsigned lds0=(unsigned)(uintptr_t)shm;
  float*wsf=(float*)(shm+LDS_WS)+wid*64;
  const bf16*ksrc=Kh+(long)lane*DM+wid*8;
  const bf16*vsrc=Vh+(long)(16*(wid&3)+(lane>>2))*DM+(wid>>2)*32+(lane&3)*8;
  const unsigned kdst=lds0+LDS_K+wid*1024, vdst=lds0+LDS_V+wid*1024;
  #define DMA_K(t,slot) glds16(ksrc+(long)(t)*KVBLK*DM,(unsigned)__builtin_amdgcn_readfirstlane(kdst+(slot)))
  #define DMA_V(t,slot) glds16(vsrc+(long)(t)*KVBLK*DM,(unsigned)__builtin_amdgcn_readfirstlane(vdst+(slot)))
  const int vb0=(int)(lds0+LDS_V)+((lane>>4)&1)*32+(lane&3)*8+(4*hi+((lane&15)>>2))*64;
  const char*Kbase=shm+LDS_K; bf16x8 kf[8];
  const lds_cptr shm3=(lds_cptr)shm; const lds_cptr kp0=shm3+LDS_K+hi*1024+r32*16; const lds_cptr vp0=shm3+LDS_V+((lane>>4)&1)*32+(lane&3)*8+(4*hi+((lane&15)>>2))*64;
  const int NT=(q0+QB)/KVBLK-ts;
  DMA_K(0,0);DMA_V(0,0);DMA_K(1,SLOTB);
  bf16x8 qr[4];
  #pragma unroll
  for(int d0=0;d0<4;++d0)qr[d0]=*reinterpret_cast<const bf16x8*>(&Qw[(long)r32*DM+d0*16+hi*8]);
  {
    __attribute__((address_space(3))) float*ckw=(__attribute__((address_space(3))) float*)(shm3+LDS_CKS); const int nkv=q0+QB-ts*KVBLK; const float*cums=CUMh+ts*KVBLK;
    for(int i=tid*4;i<nkv;i+=NW*64*4){ const float4 c4=*reinterpret_cast<const float4*>(cums+i);
      ckw[i]=(c4.x-cref)*1.4426950408889634f; ckw[i+1]=(c4.y-cref)*1.4426950408889634f; ckw[i+2]=(c4.z-cref)*1.4426950408889634f; ckw[i+3]=(c4.w-cref)*1.4426950408889634f; }
  }
  float mhat=0.f,l_reg=0.f;f32x16 o[2];o[0]=f32x16{};o[1]=f32x16{};f32x16 negm=f32x16{};asm volatile("":"+v"(negm));
  const int qrel=wid*QBLK+r32;
  #define CMASK(P0,P1,t) do{int jb_=(t)-(NT-4); if(jb_>=0)cmask(P0,P1,jb_,qrel,hi);}while(0)
  bool resc=false;
  #define START(P0,P1) do{ const float rm=rowmax(P0,P1); resc=false; \
    { const float dl=rm; mhat=fadd_s(mhat,dl); \
      _Pragma("unroll") for(int r=0;r<16;++r){P0[r]=fsub_s(P0[r],dl);P1[r]=fsub_s(P1[r],dl);} \
      _Pragma("unroll") for(int r=0;r<16;++r)negm[r]=-mhat; asm volatile("":"+v"(negm)); } \
    _Pragma("unroll") for(int r=0;r<16;++r)P0[r]=__builtin_amdgcn_exp2f(P0[r]); }while(0)
  #define RESC() do{ if(resc){ asm volatile("s_waitcnt lgkmcnt(0)":::"memory"); \
      _Pragma("unroll") for(int d_=0;d_<2;++d_) _Pragma("unroll") for(int r=0;r<16;++r)o[d_][r]*=wsf[crow(r,hi)]; } }while(0)
  typedef float f32x4_t __attribute__((ext_vector_type(4)));
  #define BIAS(P0,P1,t) do{ const __attribute__((address_space(3))) float*ck_=(const __attribute__((address_space(3))) float*)(shm3+LDS_CKS)+(t)*64+4*hi; \
    _Pragma("unroll") for(int g_=0;g_<4;++g_){ const f32x4_t a_=*(const __attribute__((address_space(3))) f32x4_t*)(ck_+8*g_), b_=*(const __attribute__((address_space(3))) f32x4_t*)(ck_+32+8*g_); \
      _Pragma("unroll") for(int j_=0;j_<4;++j_){ float t0_=P0[4*g_+j_]-a_[j_]; asm volatile("":"+v"(t0_)); P0[4*g_+j_]=t0_; float t1_=P1[4*g_+j_]-b_[j_]; asm volatile("":"+v"(t1_)); P1[4*g_+j_]=t1_; } } }while(0)
  f32x16 pA0,pA1,pB0,pB1;
  int sl_prev=0,sl_cur=0,sl_next=SLOTB;
  #define ROT() do{sl_prev=sl_cur;sl_cur=sl_next;sl_next=(sl_next==(NSLOT-1)*SLOTB)?0:sl_next+SLOTB;}while(0)
  DMA_K(2,2*SLOTB);
  WAIT_BAR(3);
  qkt(pA0,pA1,Kbase,qr,negm,r32,hi);asm volatile("s_nop 15\n\ts_nop 7":"+v"(pA0),"+v"(pA1));BIAS(pA0,pA1,0);CMASK(pA0,pA1,0);
  START(pA0,pA1);
  _Pragma("unroll") for(int r=0;r<16;++r)pA1[r]=__builtin_amdgcn_exp2f(pA1[r]);
  WAIT_BAR(0);
  DMA_K(3,0);DMA_V(1,SLOTB);
  ROT();
  kload8(kf,kp0+sl_cur);
  WAIT_BAR(2);
  s16x4 vlo[8],vhi[8]; u32x4 pw0,pw1,pw2,pw3;
  #define PKW(P,B) cvtpk_s(P[B],P[B+1])
  #define PAF(k) __builtin_bit_cast(bf16x8,pw##k)
  #define VFR(i) (bf16x8){vlo[i][0],vlo[i][1],vlo[i][2],vlo[i][3],vhi[i][0],vhi[i][1],vhi[i][2],vhi[i][3]}
  #define PIN(x) asm volatile("":"+v"(x))
  #define MX3(a,b,c) __builtin_fmaxf(__builtin_fmaxf((a),(b)),(c))
  #define GAPA(MF,A0,A1,A2,A3,W0,W1,PW) do{ MF; sacc+=A0; sacc+=A1; sacc+=A2; sacc+=A3; PIN(sacc); W0; W1; PIN(PW); SBAR(); }while(0)
  #define EX(v) __builtin_amdgcn_exp2f(v)
  #define GAPB(MF,X,B) do{ MF; X[B]=EX(X[B]); X[B+1]=EX(X[B+1]); X[B+2]=EX(X[B+2]); X[B+3]=EX(X[B+3]); PIN(X); SBAR(); }while(0)
  #define VRD(i) do{ vlo[i]=vtr(vp_+(((i)>>2)*4096+((i)&3)*1024)); vhi[i]=vtr(vp_+(((i)>>2)*4096+((i)&3)*1024+512)); }while(0)
  #define KRD(G,j) do{ if(G){ kload2(kf,kp0+sl_next,j); SBAR(); } }while(0)
  #define STEP(C0,C1,P0,P1,t,GK,GV,GL) do{ SBAR(); \
    const lds_cptr vp_=vp0+sl_prev; \
    VRD(0); SBAR(); float sacc=(P0[0]+P0[1]); \
    GAPA(C0=__builtin_amdgcn_mfma_f32_32x32x16_bf16(kf[0],qr[0],negm,0,0,0), P0[2],P0[3],P0[4],P0[5],     pw0[0]=PKW(P0,0), pw0[1]=PKW(P0,2), pw0); \
    VRD(4); SBAR(); GAPA(C1=__builtin_amdgcn_mfma_f32_32x32x16_bf16(kf[1],qr[0],negm,0,0,0), P0[6],P0[7],P0[8],P0[9],     pw0[2]=PKW(P0,4), pw0[3]=PKW(P0,6), pw0); \
    VRD(1); SBAR(); GAPA(C0=__builtin_amdgcn_mfma_f32_32x32x16_bf16(kf[2],qr[1],C0,0,0,0),   P0[10],P0[11],P0[12],P0[13], pw1[0]=PKW(P0,8), pw1[1]=PKW(P0,10), pw1); \
    VRD(5); SBAR(); GAPA(C1=__builtin_amdgcn_mfma_f32_32x32x16_bf16(kf[3],qr[1],C1,0,0,0),   P0[14],P0[15],P1[0],P1[1],   pw1[2]=PKW(P0,12),pw1[3]=PKW(P0,14), pw1); \
    VRD(2); SBAR(); GAPA(C0=__builtin_amdgcn_mfma_f32_32x32x16_bf16(kf[4],qr[2],C0,0,0,0),   P1[2],P1[3],P1[4],P1[5],     pw2[0]=PKW(P1,0), pw2[1]=PKW(P1,2), pw2); \
    VRD(6); SBAR(); GAPA(C1=__builtin_amdgcn_mfma_f32_32x32x16_bf16(kf[5],qr[2],C1,0,0,0),   P1[6],P1[7],P1[8],P1[9],     pw2[2]=PKW(P1,4), pw2[3]=PKW(P1,6), pw2); \
    VRD(3); SBAR(); GAPA(C0=__builtin_amdgcn_mfma_f32_32x32x16_bf16(kf[6],qr[3],C0,0,0,0),   P1[10],P1[11],P1[12],P1[13], pw3[0]=PKW(P1,8), pw3[1]=PKW(P1,10), pw3); \
    VRD(7); SBAR(); GAPA(C1=__builtin_amdgcn_mfma_f32_32x32x16_bf16(kf[7],qr[3],C1,0,0,0),   P1[14],P1[15],0.f,0.f,       pw3[2]=PKW(P1,12),pw3[3]=PKW(P1,14), pw3); \
    l_reg+=sacc; \
    if(GK){DMA_K((t)+3,sl_cur);} if(GV){DMA_V((t)+1,sl_next);} \
    BIAS(C0,C1,t); CMASK(C0,C1,t); \
    { float a=MX3(C0[0],C0[1],C1[0]),b=MX3(C0[2],C0[3],C1[1]); a=MX3(a,C1[2],C1[3]); \
      _Pragma("unroll") for(int r=4;r<16;r+=4){a=MX3(a,C0[r],C0[r+1]);b=MX3(b,C0[r+2],C0[r+3]);a=MX3(a,C1[r],C1[r+1]);b=MX3(b,C1[r+2],C1[r+3]);} \
      float rm=__builtin_fmaxf(a,b); { auto rr=__builtin_amdgcn_permlane32_swap(__float_as_uint(rm),__float_as_uint(rm),false,false); rm=__builtin_fmaxf(__uint_as_float(rr[0]),__uint_as_float(rr[1])); } \
      resc=false; \
      if(__builtin_expect(__any(rm>(float)THRL),0)){ const float dl=__builtin_fmaxf(rm,0.f); mhat+=dl; \
        _Pragma("unroll") for(int r=0;r<16;++r){C0[r]-=dl;C1[r]-=dl;} \
        _Pragma("unroll") for(int r=0;r<16;++r)negm[r]=-mhat; asm volatile("":"+v"(negm)); \
        const float f=__builtin_amdgcn_exp2f(-dl); l_reg*=f; if(hi==0)wsf[r32]=f; resc=true; } } \
    SBAR(); \
    GAPB(o[0]=__builtin_amdgcn_mfma_f32_32x32x16_bf16(PAF(0),VFR(0),o[0],0,0,0), C0,0); \
    GAPB(o[1]=__builtin_amdgcn_mfma_f32_32x32x16_bf16(PAF(0),VFR(4),o[1],0,0,0), C0,4); \
    KRD(GL,0); GAPB(o[0]=__builtin_amdgcn_mfma_f32_32x32x16_bf16(PAF(1),VFR(1),o[0],0,0,0), C0,8); \
    KRD(GL,1); GAPB(o[1]=__builtin_amdgcn_mfma_f32_32x32x16_bf16(PAF(1),VFR(5),o[1],0,0,0), C0,12); \
    KRD(GL,2); GAPB(o[0]=__builtin_amdgcn_mfma_f32_32x32x16_bf16(PAF(2),VFR(2),o[0],0,0,0), C1,0); \
    KRD(GL,3); GAPB(o[1]=__builtin_amdgcn_mfma_f32_32x32x16_bf16(PAF(2),VFR(6),o[1],0,0,0), C1,4); \
    GAPB(o[0]=__builtin_amdgcn_mfma_f32_32x32x16_bf16(PAF(3),VFR(3),o[0],0,0,0), C1,8); \
    GAPB(o[1]=__builtin_amdgcn_mfma_f32_32x32x16_bf16(PAF(3),VFR(7),o[1],0,0,0), C1,12); \
    }while(0)
  int t=1;
  #undef CMASK
  #define CMASK(P0,P1,t) do{}while(0)
  for(;t+5<NT;t+=2){
    STEP(pB0,pB1,pA0,pA1,t,true,true,true);     WAIT_BAR(2); RESC(); ROT();
    STEP(pA0,pA1,pB0,pB1,t+1,true,true,true);   WAIT_BAR(2); RESC(); ROT();
  }
  #undef CMASK
  #define CMASK(P0,P1,t) do{int jb_=(t)-(NT-4); if(jb_>=0)cmask(P0,P1,jb_,qrel,hi);}while(0)
  #define ENDW(tt) do{ if((tt)+3<NT){WAIT_BAR(2);} else if((tt)+2<NT){WAIT_BAR(1);} else {WAIT_BAR(0);} }while(0)
  for(;t+1<NT;t+=2){
    STEP(pB0,pB1,pA0,pA1,t,(t+3<NT),(t+1<NT),(t+1<NT));       ENDW(t);   RESC(); ROT();
    STEP(pA0,pA1,pB0,pB1,t+1,(t+4<NT),(t+2<NT),(t+2<NT));     ENDW(t+1); RESC(); ROT();
  }
  STEP(pB0,pB1,pA0,pA1,NT-1,false,false,false); RESC();
  { float sacc=pB0[0]+pB0[1]; _Pragma("unroll") for(int r=2;r<16;++r)sacc+=pB0[r]; _Pragma("unroll") for(int r=0;r<16;++r)sacc+=pB1[r]; l_reg+=sacc;
    pw0=(u32x4){PKW(pB0,0),PKW(pB0,2),PKW(pB0,4),PKW(pB0,6)};pw1=(u32x4){PKW(pB0,8),PKW(pB0,10),PKW(pB0,12),PKW(pB0,14)};pw2=(u32x4){PKW(pB1,0),PKW(pB1,2),PKW(pB1,4),PKW(pB1,6)};pw3=(u32x4){PKW(pB1,8),PKW(pB1,10),PKW(pB1,12),PKW(pB1,14)};
    SBAR(); pv(o,vb0+sl_cur,PAF(0),PAF(1),PAF(2),PAF(3)); }
  #undef PKW
  #undef PAF
  #undef VFR
  #undef PIN
  #undef MX3
  #undef GAPA
  #undef GAPB
  #undef EX
  #undef VRD
  #undef KRD
  #undef STEP
  #undef ENDW
  {auto rr=__builtin_amdgcn_permlane32_swap(__float_as_uint(l_reg),__float_as_uint(l_reg),false,false);l_reg=__uint_as_float(rr[0])+__uint_as_float(rr[1]);}
  if(hi==0)wsf[32+r32]=l_reg;asm volatile("s_waitcnt lgkmcnt(0)":::"memory");
  float rli[16];
  #pragma unroll
  for(int r=0;r<16;++r)rli[r]=__builtin_amdgcn_rcpf(wsf[32+crow(r,hi)]);
  bf16*Ow=O+(rowbase+q0+wid*QBLK)*ODM+h*D;
  { bf16*stg=(bf16*)(shm+LDS_OST)+wid*2048;
    #pragma unroll
    for(int r=0;r<16;++r){const int orow=crow(r,hi);
      #pragma unroll
      for(int d0=0;d0<2;++d0)stg[orow*64+d0*32+r32]=__float2bfloat16(o[d0][r]*rli[r]);}
    asm volatile("s_waitcnt lgkmcnt(0)":::"memory");
    #pragma unroll
    for(int i=0;i<4;++i){const int row=i*8+(lane>>3),ch=lane&7; const u32x4 v=*(const u32x4*)(stg+row*64+ch*8); ATTN_STORE16(Ow+(long)row*ODM+ch*8,v);} }
  asm volatile("s_waitcnt lgkmcnt(0)\n\ts_barrier":::"memory");
  #undef DMA_K
  #undef DMA_V
  #undef CMASK
  #undef START
  #undef RESC
  #undef ROT
  #undef BIAS
}
constexpr int ATTN_LDS_BYTES=LDS_BYTES;
#undef SBAR
#undef WAIT_BAR
}

#define LAS __attribute__((address_space(3)))
typedef unsigned short bfr;
typedef float f32x4v __attribute__((ext_vector_type(4)));
typedef unsigned u32x4v __attribute__((ext_vector_type(4)));
typedef unsigned u32x2v __attribute__((ext_vector_type(2)));
typedef short bf16x8v __attribute__((ext_vector_type(8)));

constexpr int NB = 4, SEQ = 8192, DMODEL = 1024, DEPTH = 4, MROWS = NB * SEQ;
constexpr int NPROJ = 3072, DIN = 2966, DFF = 2816, NGU = 5632, NMOD = 6144, DMIX = 1024;
constexpr int C_LX = 0, C_LG = 384, C_FQ = 768, C_FK = 1152, C_FV = 1536, C_GQ = 1920, C_GK = 2176, C_GV = 2432, C_GG = 2688, C_GL = 2944, C_FF = 2960;
constexpr float EPS = 1e-6f, LOG2E = 1.4426950408889634f;

constexpr size_t MiB = 1u << 20;
constexpr size_t WS_CTL = 0, CTL_BYTES = 65536;
constexpr int CW_BAR = 1024;
constexpr size_t WS_MOD = 1 * MiB;
constexpr size_t WS_CUM = 2 * MiB;
constexpr size_t WS_DEC = 3 * MiB;
constexpr size_t WS_SUMA = 4 * MiB, WS_SUMH = 5 * MiB;
constexpr size_t WS_LRUW = 6 * MiB;
constexpr size_t WS_WIN = 8 * MiB, WS_WOUT = 32 * MiB, WS_WGU = 40 * MiB, WS_WDN = 84 * MiB;
constexpr size_t WIN_L = (size_t)NPROJ * 1024 * 2, WOUT_L = (size_t)1024 * 1024 * 2, WGU_L = (size_t)NGU * 1024 * 2, WDN_L = (size_t)1024 * DFF * 2;
constexpr size_t WS_PROJ = 106 * MiB;
constexpr size_t WS_MIX = 298 * MiB;
constexpr size_t WS_HN = 362 * MiB;
constexpr size_t WS_HL = 362 * MiB, WS_ACUM = 386 * MiB, WS_QDEC = 410 * MiB;
constexpr size_t WS_OINTRA = 426 * MiB;
constexpr size_t WS_KV = 442 * MiB;
constexpr size_t WS_ST = 474 * MiB;
constexpr size_t WS_END = 490 * MiB;
static_assert(WS_WDN + 4 * WDN_L <= WS_PROJ && WS_WGU + 4 * WGU_L <= WS_WDN && WS_WIN + 4 * WIN_L <= WS_WOUT && WS_WOUT + 4 * WOUT_L <= WS_WGU, "ws map");

constexpr int RING_BYTES = 131072, MISC_OFF = RING_BYTES, LDS_BYTES = 147456;
static_assert(attn_body::ATTN_LDS_BYTES <= RING_BYTES, "attention LDS");

__device__ __forceinline__ float bf2f(bfr h) { return __uint_as_float((unsigned)h << 16); }
typedef float f32x2v_ __attribute__((ext_vector_type(2))); typedef __bf16 bf16x2v_ __attribute__((ext_vector_type(2)));
__device__ __forceinline__ unsigned pk2(float lo, float hi) { f32x2v_ v = {lo, hi}; bf16x2v_ b = __builtin_convertvector(v, bf16x2v_); return __builtin_bit_cast(unsigned, b); }
__device__ __forceinline__ bfr f2bf(float f) { return (bfr)(pk2(f, f) & 0xffffu); }
__device__ __forceinline__ float wave_sum(float v) {
#pragma unroll
    for (int o = 1; o < 64; o <<= 1) v += __shfl_xor(v, o);
    return v;
}
__device__ __forceinline__ float sigmoidf_(float x) { return __builtin_amdgcn_rcpf(1.0f + __expf(-x)); }
__device__ __forceinline__ float log_sigmoid_(float z) { return fminf(z, 0.f) - __logf(1.0f + __expf(-fabsf(z))); }
__device__ __forceinline__ float gelu_tanh_(float y) { const float z = 0.7978845608028654f * (y + 0.044715f * y * y * y); const float t = 1.0f - 2.0f * __builtin_amdgcn_rcpf(__expf(2.0f * z) + 1.0f); return 0.5f * y * (1.0f + t); }
__device__ __forceinline__ float silu_(float g) { return g * __builtin_amdgcn_rcpf(1.0f + __expf(-g)); }

struct Params { const float* in[23]; float* out; unsigned char* ws; };

__device__ __forceinline__ int map_in(int n) {
    if (n >= 768 && n < 1536) {
        const int c = n & 255, s_ = (c & 127) >> 5, d = (c & 31) + 32 * (c >> 7), H = 4 * ((n >> 8) - 3) + s_;
        return 768 + H * 64 + d; }
    if (n < 1920) return n;
    if (n < 2688) return n + 6;
    if (n < 2944) return n - 2688 + 2710;
    if (n < 2960) return n - 2944 + 2694;
    if (n < 2966) return n - 2960 + 1920;
    return -1;
}
__device__ __forceinline__ int map_gu(int n) { const int pn = n >> 8, r = n & 255; return r < 128 ? pn * 128 + r : DFF + pn * 128 + (r - 128); }
template <int MODE> __device__ __forceinline__ void transpose_item(const float* __restrict__ W, int K, int N, int NP, bfr* __restrict__ WT, LAS float* scr, int item, int lane) {
    const int nblk = NP / 32, kb = item / nblk, nb = item % nblk, k0 = 64 * kb, n0 = 32 * nb;
    const int nme = n0 + (lane & 31);
    const int nsrc = MODE == 0 ? nme : (MODE == 1 ? map_in(nme) : map_gu(nme));
#pragma unroll 8
    for (int i = 0; i < 32; ++i) { const int kk = 2 * i + (lane >> 5); scr[kk * 33 + (lane & 31)] = nsrc >= 0 ? W[(size_t)(k0 + kk) * N + nsrc] : 0.f; }
    asm volatile("s_waitcnt lgkmcnt(0)" ::: "memory");
    const int c = lane & 7;
#pragma unroll
    for (int j = 0; j < 4; ++j) { const int n = (lane >> 3) + 8 * j; const LAS float* s = scr + (8 * c) * 33 + n;
        u32x4v o; o.x = pk2(s[0 * 33], s[1 * 33]); o.y = pk2(s[2 * 33], s[3 * 33]); o.z = pk2(s[4 * 33], s[5 * 33]); o.w = pk2(s[6 * 33], s[7 * 33]);
        *(u32x4v*)(WT + (size_t)(n0 + n) * K + k0 + 8 * c) = o; }
    asm volatile("s_waitcnt lgkmcnt(0)" ::: "memory");
}
__device__ __forceinline__ void p0_prologue(const Params& P, LAS unsigned char* lds, int tid, int lane, int wid, int G) {
    asm volatile("" : "+v"(tid), "+v"(lane), "+s"(wid));
    unsigned char* ws = P.ws;
    {
        LAS float* CA = (LAS float*)lds;
        LAS float* RED = (LAS float*)(lds + 16384);
        const float* c = P.in[1];
        for (int i = tid; i < NB * DMODEL; i += 512) CA[i] = silu_(c[i]);
        __syncthreads();
        const int kp = tid >> 5, col = tid & 31;
        float* MOD = (float*)(ws + WS_MOD);
        for (int it = blockIdx.x; it < DEPTH * (NMOD / 32); it += G) {
            const int l = it / (NMOD / 32), c0 = (it % (NMOD / 32)) * 32;
            const float* w = P.in[4] + ((size_t)l * DMODEL + kp * 64) * NMOD + c0 + col;
            float a0 = 0.f, a1 = 0.f, a2 = 0.f, a3 = 0.f;
#pragma unroll 8
            for (int k = 0; k < 64; ++k) { const float wv = w[(size_t)k * NMOD]; const int kk = kp * 64 + k;
                a0 += CA[kk] * wv; a1 += CA[1024 + kk] * wv; a2 += CA[2048 + kk] * wv; a3 += CA[3072 + kk] * wv; }
            RED[(kp * 4 + 0) * 32 + col] = a0; RED[(kp * 4 + 1) * 32 + col] = a1; RED[(kp * 4 + 2) * 32 + col] = a2; RED[(kp * 4 + 3) * 32 + col] = a3;
            __syncthreads();
            if (tid < 128) { const int b = tid >> 5; float s = P.in[5][(size_t)l * NMOD + c0 + col];
#pragma unroll
                for (int q = 0; q < 16; ++q) s += RED[(q * 4 + b) * 32 + col];
                MOD[((size_t)l * NB + b) * NMOD + c0 + col] = s; }
            __syncthreads();
        }
    }
    __syncthreads();
    {
        bfr* LW = (bfr*)(ws + WS_LRUW);
        for (int i = blockIdx.x * 512 + tid; i < DEPTH * 6 * 2 * 4096; i += G * 512) {
            const int d = i & 63, e = (i >> 6) & 63, mat = (i >> 12) & 1, ln = i >> 13;
            const float* src = mat ? P.in[11] : P.in[9];
            LW[i] = f2bf(src[(size_t)ln * 4096 + d * 64 + e]);
        }
    }
    {
        LAS float* scr = (LAS float*)(lds + wid * 16384);
        const int gw = blockIdx.x * 8 + wid, NGW = G * 8;
        constexpr int I_IN = 16 * (NPROJ / 32), I_OUT = 16 * 32, I_GU = 16 * (NGU / 32), I_DN = (DFF / 64) * 32, I_L = I_IN + I_OUT + I_GU + I_DN;
        for (int it = gw; it < DEPTH * I_L; it += NGW) {
            const int l = it / I_L; int r = it % I_L;
            if (r < I_IN) { transpose_item<1>(P.in[6] + (size_t)l * DMODEL * DIN, DMODEL, DIN, NPROJ, (bfr*)(ws + WS_WIN + l * WIN_L), scr, r, lane); continue; } r -= I_IN;
            if (r < I_OUT) { transpose_item<0>(P.in[20] + (size_t)l * DMIX * DMODEL, DMIX, DMODEL, DMODEL, (bfr*)(ws + WS_WOUT + l * WOUT_L), scr, r, lane); continue; } r -= I_OUT;
            if (r < I_GU) { transpose_item<2>(P.in[21] + (size_t)l * DMODEL * NGU, DMODEL, NGU, NGU, (bfr*)(ws + WS_WGU + l * WGU_L), scr, r, lane); continue; } r -= I_GU;
            transpose_item<0>(P.in[22] + (size_t)l * DFF * DMODEL, DFF, DMODEL, DMODEL, (bfr*)(ws + WS_WDN + l * WDN_L), scr, r, lane);
        }
    }
}

__device__ __forceinline__ void norm_phase(const float* __restrict__ x, const bfr* __restrict__ x16, const float* __restrict__ gain, const float* __restrict__ modl, int shift_off, int scale_off, bfr* __restrict__ HN, int gw, int NGW, int lane) {
    asm volatile("" : "+v"(lane), "+s"(gw));
    const bool xloc = (NGW % 64) == 0;
    const int xq = xloc ? (gw >> 3) & 7 : 0, wloc = xloc ? ((gw >> 6) << 3) + (gw & 7) : gw, nwl = xloc ? NGW / 8 : NGW, rbase = xq * (MROWS / 8), rcnt = xloc ? MROWS / 8 : MROWS;
#pragma unroll 4
    for (int r = wloc; r < rcnt; r += nwl) {
        const int m = rbase + r;
        f32x4v v[4]; float s = 0.f;
        if (x16) {
            const u32x2v* xr = (const u32x2v*)(x16 + (size_t)m * DMODEL) + lane;
#pragma unroll
            for (int j = 0; j < 4; ++j) { const u32x2v w = xr[64 * j]; const pg8::f32x2 a = pg8::h2f(w.x), b = pg8::h2f(w.y); v[j] = (f32x4v){a.x, a.y, b.x, b.y}; }
        } else {
            const f32x4v* xr = (const f32x4v*)(x + (size_t)m * DMODEL) + lane;
#pragma unroll
            for (int j = 0; j < 4; ++j) v[j] = xr[64 * j];
        }
#pragma unroll
        for (int j = 0; j < 4; ++j) s += (v[j].x * v[j].x + v[j].y * v[j].y) + (v[j].z * v[j].z + v[j].w * v[j].w);
        const float rstd = 1.0f / sqrtf(wave_sum(s) * (1.0f / DMODEL) + EPS);
        const float* mb = modl + (size_t)(m / SEQ) * NMOD;
        u32x2v* o8 = (u32x2v*)(HN + (size_t)m * DMODEL) + lane;
#pragma unroll
        for (int j = 0; j < 4; ++j) { const int col = 4 * lane + 256 * j;
            const f32x4v g = *(const f32x4v*)(gain + col), sc = *(const f32x4v*)(mb + scale_off + col), sh = *(const f32x4v*)(mb + shift_off + col);
            const f32x4v h = v[j] * rstd * g * (sc + 1.0f) + sh;
            u32x2v w; w.x = pk2(h.x, h.y); w.y = pk2(h.z, h.w); o8[64 * j] = w; }
    }
}

struct LayerPtrs {
    const float *conv_w, *conv_b, *b_r, *b_i, *lam, *fox_bf, *qgain, *kgain, *w_alpha, *b_alpha, *ogain;
    const bfr* lruw;
};

constexpr int LRU_LC = 128, LRU_NCH = SEQ / LRU_LC;
__device__ __forceinline__ void lru_local_item(int idx, const LayerPtrs& L, unsigned char* ws, LAS unsigned char* lds, int tid, int lane, int wid) {
    asm volatile("" : "+v"(tid), "+v"(lane), "+s"(wid));
    const int n = idx % 6, c = (idx / 6) % LRU_NCH, b = idx / (6 * LRU_NCH);
    const int ch = tid & 63, tg = wid;
    const bfr* PROJ = (const bfr*)(ws + WS_PROJ);
    LAS bfr* XA = (LAS bfr*)lds;
    LAS float* RI = (LAS float*)(lds + 18432);
    LAS float* SEG = (LAS float*)(lds + 18432 + 65536);
    const int cg_ = n * 64 + ch;
    const int mat = wid >> 2, fr = lane & 15, fq = lane >> 4;
    const bfr* wt = L.lruw + (size_t)(n * 2 + mat) * 4096;
    bf16x8v bfrag[4][2];
#pragma unroll
    for (int te = 0; te < 4; ++te) { bfrag[te][0] = *(const bf16x8v*)(wt + (16 * te + fr) * 64 + 8 * fq); bfrag[te][1] = *(const bf16x8v*)(wt + (16 * te + fr) * 64 + 32 + 8 * fq); }
    const float lam = L.lam[cg_], br = L.b_r[cg_], bi = L.b_i[cg_];
    float xa[16];
    {
        float raw[19];
#pragma unroll
        for (int j = 0; j < 19; ++j) { const int tt = c * LRU_LC + 16 * tg - 3 + j; raw[j] = tt >= 0 ? bf2f(PROJ[((size_t)b * SEQ + tt) * NPROJ + C_LX + cg_]) : 0.f; }
        asm volatile("" :: "v"(raw[0]), "v"(raw[1]), "v"(raw[2]), "v"(raw[3]), "v"(raw[4]), "v"(raw[5]), "v"(raw[6]), "v"(raw[7]), "v"(raw[8]), "v"(raw[9]), "v"(raw[10]), "v"(raw[11]), "v"(raw[12]), "v"(raw[13]), "v"(raw[14]), "v"(raw[15]), "v"(raw[16]), "v"(raw[17]), "v"(raw[18]) : "memory");
        const float w0 = L.conv_w[cg_], w1 = L.conv_w[384 + cg_], w2 = L.conv_w[768 + cg_], w3 = L.conv_w[1152 + cg_], cb = L.conv_b[cg_];
#pragma unroll
        for (int i = 0; i < 16; ++i) { xa[i] = cb + w0 * raw[i] + w1 * raw[i + 1] + w2 * raw[i + 2] + w3 * raw[i + 3]; XA[(16 * tg + i) * 72 + ch] = f2bf(xa[i]); }
    }
    __syncthreads();
    {
#pragma unroll
        for (int q = 0; q < 2; ++q) {
            const int tr = 2 * (wid & 3) + q;
            const bf16x8v a0 = *(const LAS bf16x8v*)(XA + (16 * tr + fr) * 72 + 8 * fq), a1 = *(const LAS bf16x8v*)(XA + (16 * tr + fr) * 72 + 32 + 8 * fq);
#pragma unroll
            for (int te = 0; te < 4; ++te) {
                f32x4v acc = {0.f, 0.f, 0.f, 0.f};
                acc = __builtin_amdgcn_mfma_f32_16x16x32_bf16(a0, bfrag[te][0], acc, 0, 0, 0);
                acc = __builtin_amdgcn_mfma_f32_16x16x32_bf16(a1, bfrag[te][1], acc, 0, 0, 0);
#pragma unroll
                for (int r = 0; r < 4; ++r) RI[(mat * LRU_LC + 16 * tr + 4 * fq + r) * 64 + 16 * te + fr] = acc[r];
            }
        }
    }
    __syncthreads();
    float hs[16], ps[16];
    {
        const float e_ = __expf(-fabsf(lam));
        const float sp = fmaxf(-lam, 0.f) + (e_ < 0.03125f ? e_ * (1.0f - e_ * (0.5f - e_ * (0.33333334f - 0.25f * e_))) : __logf(1.0f + e_));
        float h = 0.f, p = 1.f;
#pragma unroll
        for (int i = 0; i < 16; ++i) {
            const float r = sigmoidf_(RI[(16 * tg + i) * 64 + ch] + br), ig = sigmoidf_(RI[(LRU_LC + 16 * tg + i) * 64 + ch] + bi);
            const float la = -8.0f * r * sp; const float a = __expf(la); const float mult = __builtin_amdgcn_sqrtf(fmaxf(1.0f - a * a, 0.f));
            h = a * h + mult * ig * xa[i]; p *= a; hs[i] = h; ps[i] = p;
        }
        SEG[(tg * 2 + 0) * 64 + ch] = p; SEG[(tg * 2 + 1) * 64 + ch] = h;
    }
    __syncthreads();
    {
        float carry = 0.f, pref = 1.f;
        for (int g = 0; g < tg; ++g) { const float pg = SEG[(g * 2) * 64 + ch], hg = SEG[(g * 2 + 1) * 64 + ch]; carry = pg * carry + hg; pref *= pg; }
        bfr* HL = (bfr*)(ws + WS_HL); bfr* AC = (bfr*)(ws + WS_ACUM);
        const size_t m0 = (size_t)b * SEQ + c * LRU_LC + 16 * tg;
        float hl = 0.f, ac = 0.f;
#pragma unroll
        for (int i = 0; i < 16; ++i) { hl = hs[i] + ps[i] * carry; ac = ps[i] * pref; HL[(m0 + i) * 384 + cg_] = f2bf(hl); AC[(m0 + i) * 384 + cg_] = f2bf(ac); }
        if (tg == 7) { ((float*)(ws + WS_SUMA))[((size_t)b * LRU_NCH + c) * 384 + cg_] = ac; ((float*)(ws + WS_SUMH))[((size_t)b * LRU_NCH + c) * 384 + cg_] = hl; }
    }
    __syncthreads();
}
__device__ __forceinline__ void knorm_item(int idx, const LayerPtrs& L, unsigned char* ws, int tid) {
    asm volatile("" : "+v"(tid));
    bfr* PROJ = (bfr*)(ws + WS_PROJ);
    const int part = tid & 7, hr = tid >> 3;
    const f32x4v g0 = *(const f32x4v*)(L.kgain + part * 8), g1 = *(const f32x4v*)(L.kgain + part * 8 + 4);
#pragma unroll
    for (int p = 0; p < 6; ++p) {
        const int R = p * 64 + hr, tok = R / 6, head = R % 6;
        u32x4v* ptr = (u32x4v*)(PROJ + ((size_t)idx * 64 + tok) * NPROJ + C_FK + head * 64 + part * 8);
        const u32x4v w = *ptr;
        float f[8];
        f[0] = __uint_as_float(w.x << 16); f[1] = __uint_as_float(w.x & 0xffff0000u); f[2] = __uint_as_float(w.y << 16); f[3] = __uint_as_float(w.y & 0xffff0000u);
        f[4] = __uint_as_float(w.z << 16); f[5] = __uint_as_float(w.z & 0xffff0000u); f[6] = __uint_as_float(w.w << 16); f[7] = __uint_as_float(w.w & 0xffff0000u);
        float ss = 0.f;
#pragma unroll
        for (int j = 0; j < 8; ++j) ss += f[j] * f[j];
        ss += __shfl_xor(ss, 1); ss += __shfl_xor(ss, 2); ss += __shfl_xor(ss, 4);
        const float rs = 1.0f / sqrtf(ss * (1.0f / 64.0f) + EPS);
        u32x4v o; o.x = pk2(f[0] * rs * g0.x, f[1] * rs * g0.y); o.y = pk2(f[2] * rs * g0.z, f[3] * rs * g0.w); o.z = pk2(f[4] * rs * g1.x, f[5] * rs * g1.y); o.w = pk2(f[6] * rs * g1.z, f[7] * rs * g1.w);
        *ptr = o;
    }
}
__device__ __forceinline__ void cum_item(int idx, const LayerPtrs& L, unsigned char* ws, LAS unsigned char* lds, int tid, int lane, int wid) {
    asm volatile("" : "+v"(tid), "+v"(lane), "+s"(wid));
    const int b = idx / 6, h = idx % 6;
    const bfr* PROJ = (const bfr*)(ws + WS_PROJ);
    LAS float* WT = (LAS float*)lds;
    const float bf = L.fox_bf[h];
    float loc[16]; float run = 0.f;
#pragma unroll
    for (int i = 0; i < 16; ++i) { const float z = bf2f(PROJ[((size_t)b * SEQ + 16 * tid + i) * NPROJ + C_FF + h]) + bf; run += log_sigmoid_(z); loc[i] = run; }
    float inc = run;
#pragma unroll
    for (int o = 1; o < 64; o <<= 1) { const float t = __shfl_up(inc, o); if (lane >= o) inc += t; }
    if (lane == 63) WT[wid] = inc;
    __syncthreads();
    float base = inc - run;
    for (int w = 0; w < wid; ++w) base += WT[w];
    float* CUM = (float*)(ws + WS_CUM) + ((size_t)b * 6 + h) * SEQ + 16 * tid;
#pragma unroll
    for (int i = 0; i < 16; i += 4) *(f32x4v*)(CUM + i) = (f32x4v){loc[i] + base, loc[i + 1] + base, loc[i + 2] + base, loc[i + 3] + base};
    __syncthreads();
}
__device__ __forceinline__ void gla_local_item(int idx, const LayerPtrs& L, unsigned char* ws, LAS unsigned char* lds, int tid, int lane, int wid) {
    asm volatile("" : "+v"(tid), "+v"(lane), "+s"(wid));
    const int bh = idx >> 6, np = idx & 63, b = bh >> 2, h = bh & 3;
    const int d = tid & 63, tg = wid, fr = lane & 15, fq = lane >> 4;
    const bfr* PROJ = (const bfr*)(ws + WS_PROJ);
    constexpr int CCB = 49152;
    float qf[2][8], kf[2][8]; bfr vb[2][8];
#pragma unroll
    for (int cc = 0; cc < 2; ++cc)
#pragma unroll
        for (int i = 0; i < 8; ++i) { const size_t m = (size_t)b * SEQ + (2 * np + cc) * 64 + 8 * tg + i;
            qf[cc][i] = bf2f(PROJ[m * NPROJ + C_GQ + h * 64 + d]); kf[cc][i] = bf2f(PROJ[m * NPROJ + C_GK + h * 64 + d]); vb[cc][i] = PROJ[m * NPROJ + C_GV + h * 64 + d]; }
    float bc[2][8];
    {
        float wal[16];
#pragma unroll
        for (int r = 0; r < 16; ++r) wal[r] = L.w_alpha[r * 256 + h * 64 + d];
        const float bal = L.b_alpha[h * 64 + d];
#pragma unroll
        for (int cc = 0; cc < 2; ++cc) {
            LAS float* SEGB = (LAS float*)(lds + cc * CCB);
            const size_t m0 = (size_t)b * SEQ + (2 * np + cc) * 64;
            float run = 0.f;
#pragma unroll
            for (int i = 0; i < 8; ++i) {
                const u32x4v* lp = (const u32x4v*)(PROJ + (m0 + 8 * tg + i) * NPROJ + C_GL);
                const u32x4v l0 = lp[0], l1 = lp[1];
                float z = bal;
                z += __uint_as_float(l0.x << 16) * wal[0] + __uint_as_float(l0.x & 0xffff0000u) * wal[1] + __uint_as_float(l0.y << 16) * wal[2] + __uint_as_float(l0.y & 0xffff0000u) * wal[3];
                z += __uint_as_float(l0.z << 16) * wal[4] + __uint_as_float(l0.z & 0xffff0000u) * wal[5] + __uint_as_float(l0.w << 16) * wal[6] + __uint_as_float(l0.w & 0xffff0000u) * wal[7];
                z += __uint_as_float(l1.x << 16) * wal[8] + __uint_as_float(l1.x & 0xffff0000u) * wal[9] + __uint_as_float(l1.y << 16) * wal[10] + __uint_as_float(l1.y & 0xffff0000u) * wal[11];
                z += __uint_as_float(l1.z << 16) * wal[12] + __uint_as_float(l1.z & 0xffff0000u) * wal[13] + __uint_as_float(l1.w << 16) * wal[14] + __uint_as_float(l1.w & 0xffff0000u) * wal[15];
                run += log_sigmoid_(z) * (1.0f / 16.0f); bc[cc][i] = run;
            }
            SEGB[tg * 64 + d] = run;
        }
    }
    __syncthreads();
#pragma unroll
    for (int cc = 0; cc < 2; ++cc) {
        LAS float* SEGB = (LAS float*)(lds + cc * CCB);
        LAS bfr* QD = (LAS bfr*)(lds + cc * CCB + 2048); LAS bfr* KD = QD + 4608; LAS bfr* KTET = KD + 4608; LAS bfr* VT = KTET + 4608;
        const size_t m0 = (size_t)b * SEQ + (2 * np + cc) * 64;
        float off = 0.f, total = 0.f;
#pragma unroll
        for (int g = 0; g < 8; ++g) { const float sg = SEGB[g * 64 + d]; total += sg; if (g < tg) off += sg; }
        bfr* QDEC = (bfr*)(ws + WS_QDEC);
        unsigned kt[4], vv[4];
#pragma unroll
        for (int i = 0; i < 8; ++i) {
            const size_t m = m0 + 8 * tg + i; const float bcum = bc[cc][i] + off;
            const float q = qf[cc][i], k = kf[cc][i]; const bfr v = vb[cc][i];
            const bfr qd = f2bf(q * 0.125f * __expf(bcum)), kd = f2bf(k * __expf(-bcum)), kte = f2bf(k * __expf(total - bcum));
            QD[(8 * tg + i) * 72 + d] = qd; KD[(8 * tg + i) * 72 + d] = kd; QDEC[m * 256 + h * 64 + d] = qd;
            if (i & 1) { kt[i >> 1] |= (unsigned)kte << 16; vv[i >> 1] |= (unsigned)v << 16; } else { kt[i >> 1] = kte; vv[i >> 1] = v; }
        }
        *(LAS u32x4v*)(KTET + d * 72 + 8 * tg) = (u32x4v){kt[0], kt[1], kt[2], kt[3]};
        *(LAS u32x4v*)(VT + d * 72 + 8 * tg) = (u32x4v){vv[0], vv[1], vv[2], vv[3]};
        if (tg == 0) ((float*)(ws + WS_DEC))[((size_t)bh * 128 + 2 * np + cc) * 64 + d] = __expf(total);
    }
    __syncthreads();
#pragma unroll
    for (int cc = 0; cc < 2; ++cc) {
        LAS bfr* QD = (LAS bfr*)(lds + cc * CCB + 2048); LAS bfr* KD = QD + 4608; LAS bfr* ATT = QD + 4 * 4608;
        const int ti = wid & 3;
#pragma unroll
        for (int q = 0; q < 2; ++q) {
            const int tj = 2 * (wid >> 2) + q;
            f32x4v acc = {0.f, 0.f, 0.f, 0.f};
            if (tj <= ti) {
                const bf16x8v a0 = *(const LAS bf16x8v*)(QD + (16 * ti + fr) * 72 + 8 * fq), a1 = *(const LAS bf16x8v*)(QD + (16 * ti + fr) * 72 + 32 + 8 * fq);
                const bf16x8v b0 = *(const LAS bf16x8v*)(KD + (16 * tj + fr) * 72 + 8 * fq), b1 = *(const LAS bf16x8v*)(KD + (16 * tj + fr) * 72 + 32 + 8 * fq);
                acc = __builtin_amdgcn_mfma_f32_16x16x32_bf16(a0, b0, acc, 0, 0, 0);
                acc = __builtin_amdgcn_mfma_f32_16x16x32_bf16(a1, b1, acc, 0, 0, 0);
            }
#pragma unroll
            for (int r = 0; r < 4; ++r) { const int i = 16 * ti + 4 * fq + r, j = 16 * tj + fr; ATT[i * 72 + j] = f2bf(j <= i ? acc[r] : 0.f); }
        }
    }
    __syncthreads();
#pragma unroll
    for (int cc = 0; cc < 2; ++cc) {
        LAS bfr* QD = (LAS bfr*)(lds + cc * CCB + 2048); LAS bfr* KTET = QD + 2 * 4608; LAS bfr* VT = QD + 3 * 4608; LAS bfr* ATT = QD + 4 * 4608;
        const size_t m0 = (size_t)b * SEQ + (2 * np + cc) * 64;
        const int mat = wid >> 2, t4 = wid & 3;
        if (mat == 0) {
            bfr* OI = (bfr*)(ws + WS_OINTRA);
            const bf16x8v b0 = *(const LAS bf16x8v*)(ATT + (16 * t4 + fr) * 72 + 8 * fq), b1 = *(const LAS bf16x8v*)(ATT + (16 * t4 + fr) * 72 + 32 + 8 * fq);
#pragma unroll
            for (int tv = 0; tv < 4; ++tv) {
                const bf16x8v a0 = *(const LAS bf16x8v*)(VT + (16 * tv + fr) * 72 + 8 * fq), a1 = *(const LAS bf16x8v*)(VT + (16 * tv + fr) * 72 + 32 + 8 * fq);
                f32x4v acc = {0.f, 0.f, 0.f, 0.f};
                acc = __builtin_amdgcn_mfma_f32_16x16x32_bf16(a0, b0, acc, 0, 0, 0);
                acc = __builtin_amdgcn_mfma_f32_16x16x32_bf16(a1, b1, acc, 0, 0, 0);
                u32x2v w; w.x = pk2(acc[0], acc[1]); w.y = pk2(acc[2], acc[3]);
                *(u32x2v*)(OI + (m0 + 16 * t4 + fr) * 256 + h * 64 + 16 * tv + 4 * fq) = w;
            }
        } else {
            float* KV = (float*)(ws + WS_KV) + ((size_t)bh * 128 + 2 * np + cc) * 4096;
            const bf16x8v a0 = *(const LAS bf16x8v*)(KTET + (16 * t4 + fr) * 72 + 8 * fq), a1 = *(const LAS bf16x8v*)(KTET + (16 * t4 + fr) * 72 + 32 + 8 * fq);
#pragma unroll
            for (int tv = 0; tv < 4; ++tv) {
                const bf16x8v b0 = *(const LAS bf16x8v*)(VT + (16 * tv + fr) * 72 + 8 * fq), b1 = *(const LAS bf16x8v*)(VT + (16 * tv + fr) * 72 + 32 + 8 * fq);
                f32x4v acc = {0.f, 0.f, 0.f, 0.f};
                acc = __builtin_amdgcn_mfma_f32_16x16x32_bf16(a0, b0, acc, 0, 0, 0);
                acc = __builtin_amdgcn_mfma_f32_16x16x32_bf16(a1, b1, acc, 0, 0, 0);
                *(f32x4v*)(KV + (16 * tv + fr) * 64 + 16 * t4 + 4 * fq) = acc;
            }
        }
    }
    __syncthreads();
}

__device__ __forceinline__ void gla_scan_item(int idx, unsigned char* ws, int tid) {
    asm volatile("" : "+v"(tid));
    const int bh = idx >> 3, e = (idx & 7) * 512 + tid, d = e & 63;
    const float* KV = (const float*)(ws + WS_KV) + (size_t)bh * 128 * 4096 + e;
    const float* DEC = (const float*)(ws + WS_DEC) + (size_t)bh * 128 * 64 + d;
    bfr* ST = (bfr*)(ws + WS_ST) + (size_t)bh * 128 * 4096 + e;
    float s = 0.f;
#pragma unroll 16
    for (int n = 0; n < 128; ++n) { const float kvv = KV[(size_t)n * 4096], dc = DEC[n * 64]; ST[(size_t)n * 4096] = f2bf(s); s = dc * s + kvv; }
}
__device__ __forceinline__ void lru_out_item(int q, unsigned char* ws, LAS unsigned char* lds, int tid, int wid) {
    asm volatile("" : "+v"(tid), "+s"(wid));
    const int b = q / 96, rem = q % 96, n = rem / 16, cgp = rem % 16;
    const int ch = tid & 63, tg = wid, cg_ = n * 64 + ch;
    const float* SA = (const float*)(ws + WS_SUMA) + (size_t)b * LRU_NCH * 384 + cg_;
    const float* SH = (const float*)(ws + WS_SUMH) + (size_t)b * LRU_NCH * 384 + cg_;
    LAS float* COMP = (LAS float*)lds;
    {
        const int nprev = 4 * cgp;
        float pw = 1.f, hw = 0.f;
        for (int j = (tg * nprev) >> 3; j < ((tg + 1) * nprev) >> 3; ++j) { const float a = SA[j * 384], hh = SH[j * 384]; hw = a * hw + hh; pw *= a; }
        COMP[(tg * 2) * 64 + ch] = pw; COMP[(tg * 2 + 1) * 64 + ch] = hw;
    }
    __syncthreads();
    float carry = 0.f;
#pragma unroll
    for (int g = 0; g < 8; ++g) carry = COMP[(g * 2) * 64 + ch] * carry + COMP[(g * 2 + 1) * 64 + ch];
    const bfr* HL = (const bfr*)(ws + WS_HL); const bfr* AC = (const bfr*)(ws + WS_ACUM); const bfr* PROJ = (const bfr*)(ws + WS_PROJ); bfr* MIX = (bfr*)(ws + WS_MIX);
    for (int cc = 0; cc < 4; ++cc) {
        const int c = cgp * 4 + cc;
        const size_t m0 = (size_t)b * SEQ + c * LRU_LC + 16 * tg;
        const float sa = SA[c * 384], sh = SH[c * 384];
        unsigned hlr[16], acr[16], yr[16];
#pragma unroll
        for (int i = 0; i < 16; ++i) { const size_t m = m0 + i; hlr[i] = HL[m * 384 + cg_]; acr[i] = AC[m * 384 + cg_]; yr[i] = PROJ[m * NPROJ + C_LG + cg_]; }
        asm volatile("" :: "v"(hlr[0]), "v"(hlr[1]), "v"(hlr[2]), "v"(hlr[3]), "v"(hlr[4]), "v"(hlr[5]), "v"(hlr[6]), "v"(hlr[7]), "v"(hlr[8]), "v"(hlr[9]), "v"(hlr[10]), "v"(hlr[11]), "v"(hlr[12]), "v"(hlr[13]), "v"(hlr[14]), "v"(hlr[15]) : "memory"); asm volatile("" :: "v"(acr[0]), "v"(acr[1]), "v"(acr[2]), "v"(acr[3]), "v"(acr[4]), "v"(acr[5]), "v"(acr[6]), "v"(acr[7]), "v"(acr[8]), "v"(acr[9]), "v"(acr[10]), "v"(acr[11]), "v"(acr[12]), "v"(acr[13]), "v"(acr[14]), "v"(acr[15]) : "memory"); asm volatile("" :: "v"(yr[0]), "v"(yr[1]), "v"(yr[2]), "v"(yr[3]), "v"(yr[4]), "v"(yr[5]), "v"(yr[6]), "v"(yr[7]), "v"(yr[8]), "v"(yr[9]), "v"(yr[10]), "v"(yr[11]), "v"(yr[12]), "v"(yr[13]), "v"(yr[14]), "v"(yr[15]) : "memory");
#pragma unroll
        for (int i = 0; i < 16; ++i) { const size_t m = m0 + i;
            const float hh = bf2f((bfr)hlr[i]) + bf2f((bfr)acr[i]) * carry; const float y = bf2f((bfr)yr[i]);
            MIX[m * DMIX + cg_] = f2bf(hh * gelu_tanh_(y)); }
        carry = sa * carry + sh;
    }
}
__device__ __forceinline__ void gla_out_item(int idx, const LayerPtrs& L, unsigned char* ws, int lane) {
    asm volatile("" : "+v"(lane));
    const int bh = idx >> 7, n = idx & 127, b = bh >> 2, h = bh & 3, fr = lane & 15, fq = lane >> 4;
    const size_t m0 = (size_t)b * SEQ + n * 64;
    const bfr* ST = (const bfr*)(ws + WS_ST) + (size_t)idx * 4096; const bfr* QDEC = (const bfr*)(ws + WS_QDEC); const bfr* OI = (const bfr*)(ws + WS_OINTRA);
    const bfr* PROJ = (const bfr*)(ws + WS_PROJ); bfr* MIX = (bfr*)(ws + WS_MIX);
    bf16x8v st[4][2];
#pragma unroll
    for (int tv = 0; tv < 4; ++tv)
#pragma unroll
        for (int ks = 0; ks < 2; ++ks) st[tv][ks] = *(const bf16x8v*)(ST + (16 * tv + fr) * 64 + 32 * ks + 8 * fq);
    f32x4v gn[4];
#pragma unroll
    for (int tv = 0; tv < 4; ++tv) gn[tv] = *(const f32x4v*)(L.ogain + 16 * tv + 4 * fq);
#pragma unroll
    for (int ti = 0; ti < 4; ++ti) {
        const size_t m = m0 + 16 * ti + fr;
        const bf16x8v q0 = *(const bf16x8v*)(QDEC + m * 256 + h * 64 + 8 * fq), q1 = *(const bf16x8v*)(QDEC + m * 256 + h * 64 + 32 + 8 * fq);
        u32x2v oiw[4], ggw[4];
#pragma unroll
        for (int tv = 0; tv < 4; ++tv) { oiw[tv] = *(const u32x2v*)(OI + m * 256 + h * 64 + 16 * tv + 4 * fq); ggw[tv] = *(const u32x2v*)(PROJ + m * NPROJ + C_GG + h * 64 + 16 * tv + 4 * fq); }
        asm volatile("" :: "v"(q0), "v"(q1), "v"(oiw[0]), "v"(oiw[1]), "v"(oiw[2]), "v"(oiw[3]), "v"(ggw[0]), "v"(ggw[1]), "v"(ggw[2]), "v"(ggw[3]) : "memory");
        f32x4v o[4]; float ss = 0.f;
#pragma unroll
        for (int tv = 0; tv < 4; ++tv) {
            f32x4v acc = {0.f, 0.f, 0.f, 0.f};
            acc = __builtin_amdgcn_mfma_f32_16x16x32_bf16(st[tv][0], q0, acc, 0, 0, 0);
            acc = __builtin_amdgcn_mfma_f32_16x16x32_bf16(st[tv][1], q1, acc, 0, 0, 0);
            const u32x2v w = oiw[tv];
            acc[0] += __uint_as_float(w.x << 16); acc[1] += __uint_as_float(w.x & 0xffff0000u); acc[2] += __uint_as_float(w.y << 16); acc[3] += __uint_as_float(w.y & 0xffff0000u);
            o[tv] = acc; ss += (acc[0] * acc[0] + acc[1] * acc[1]) + (acc[2] * acc[2] + acc[3] * acc[3]);
        }
        ss += __shfl_xor(ss, 16); ss += __shfl_xor(ss, 32);
        const float rs = 1.0f / sqrtf(ss * (1.0f / 64.0f) + EPS);
#pragma unroll
        for (int tv = 0; tv < 4; ++tv) {
            const u32x2v gw = ggw[tv];
            const float g0 = __uint_as_float(gw.x << 16), g1 = __uint_as_float(gw.x & 0xffff0000u), g2 = __uint_as_float(gw.y << 16), g3 = __uint_as_float(gw.y & 0xffff0000u);
            u32x2v w; w.x = pk2(o[tv][0] * rs * gn[tv][0] * silu_(g0), o[tv][1] * rs * gn[tv][1] * silu_(g1)); w.y = pk2(o[tv][2] * rs * gn[tv][2] * silu_(g2), o[tv][3] * rs * gn[tv][3] * silu_(g3));
            *(u32x2v*)(MIX + m * DMIX + 768 + h * 64 + 16 * tv + 4 * fq) = w;
        }
    }
}

#define XB_TMO      128
#define XB_XCNT(j)  (256  + 64 * (j))
#define XB_XSUB(j)  (1280 + 64 * (j))
#define XB_XGEN(j)  (2304 + 64 * (j))
#define XB_TOP      3328
#define XB_TOPGEN   3392
#define XCD_BAR_WORDS 3456
#define XB_SPIN_CAP (1u << 18)

__device__ __forceinline__ unsigned xb_ld(unsigned* p)              { return __hip_atomic_load(p, __ATOMIC_RELAXED, __HIP_MEMORY_SCOPE_AGENT); }
__device__ __forceinline__ unsigned xb_add(unsigned* p, unsigned v) { return __hip_atomic_fetch_add(p, v, __ATOMIC_RELAXED, __HIP_MEMORY_SCOPE_AGENT); }
__device__ __forceinline__ unsigned xb_xcc_id() { return (unsigned)__builtin_amdgcn_s_getreg((3 << 11) | 20) & 0xFu; }
#define XB_SPIN(cond, bar) do { unsigned _sp = 0; while (cond) { __builtin_amdgcn_s_sleep(1); \
    if ((++_sp & 255u) == 0u) { if (xb_ld(&(bar)[XB_TMO])) break; if (_sp > XB_SPIN_CAP) { atomicAdd(&(bar)[XB_TMO], 1u); break; } } } } while (0)

struct XcdBarrier {
    unsigned* bar; unsigned x;
    volatile LAS unsigned* st;
};

__device__ __forceinline__ XcdBarrier xcd_barrier_post(unsigned* bar, volatile LAS unsigned* st) {
    XcdBarrier b; b.bar = bar; b.x = xb_xcc_id(); b.st = st;
    if (threadIdx.x == 0) (void)xb_add(&bar[XB_XCNT(b.x)], 1u);
    return b;
}
__device__ __forceinline__ void xcd_barrier_complete(unsigned* bar, unsigned x, unsigned& nloc, unsigned& nx) {
    const unsigned G = gridDim.x * gridDim.y * gridDim.z;
    unsigned sum, cnt, mine, sp = 0u;
    for (;;) {
        sum = 0u; cnt = 0u; mine = 0u;
#pragma unroll
        for (unsigned j = 0; j < 16; ++j) { const unsigned c = xb_ld(&bar[XB_XCNT(j)]); sum += c; cnt += (c > 0u) ? 1u : 0u; mine = (j == x) ? c : mine; }
        if (sum == G) break;
        __builtin_amdgcn_s_sleep(1);
        if ((++sp & 255u) == 0u) { if (xb_ld(&bar[XB_TMO])) break; if (sp > XB_SPIN_CAP) { atomicAdd(&bar[XB_TMO], 1u); break; } }
    }
    nloc = mine > 0u ? mine : 1u; nx = cnt > 0u ? cnt : 1u;
}

__device__ __forceinline__ void xcd_barrier(const XcdBarrier& b) {
    asm volatile("s_waitcnt vmcnt(0)" ::: "memory");
    __syncthreads();
    if (threadIdx.x == 0) {
        unsigned* bar = b.bar;
        __builtin_amdgcn_s_waitcnt(0);
        unsigned nloc = b.st[0], nx = b.st[1];
        if (nloc == 0u) { xcd_barrier_complete(bar, b.x, nloc, nx); b.st[0] = nloc; b.st[1] = nx; }
        const unsigned old = xb_add(&bar[XB_XSUB(b.x)], 1u);
        const unsigned gen = old / nloc;
        if (old + 1u == (gen + 1u) * nloc) {
            __builtin_amdgcn_fence(__ATOMIC_RELEASE, "agent");
            asm volatile("s_waitcnt vmcnt(0)" ::: "memory");
            const unsigned og = xb_add(&bar[XB_TOP], 1u);
            const unsigned tg = og / nx;
            if (og + 1u == (tg + 1u) * nx) xb_add(&bar[XB_TOPGEN], 1u);
            else XB_SPIN(xb_ld(&bar[XB_TOPGEN]) == tg, bar);
            __builtin_amdgcn_fence(__ATOMIC_ACQUIRE, "agent");
            xb_add(&bar[XB_XGEN(b.x)], 1u);
            asm volatile("s_waitcnt vmcnt(0)" ::: "memory");
        } else {
            XB_SPIN(xb_ld(&bar[XB_XGEN(b.x)]) == gen, bar);
            __builtin_amdgcn_fence(__ATOMIC_ACQUIRE, "agent");
            asm volatile("s_waitcnt vmcnt(0)" ::: "memory");
        }
    }
    __syncthreads();
}

#ifdef EXP_P2
#define EXP_KN_ONCE (rep_ == 0)
#else
#define EXP_KN_ONCE true
#endif
#define XBAR1() do { XcdBarrier b_; b_.bar = (unsigned*)P.ws + CW_BAR; b_.x = xb_xcc_id(); b_.st = (volatile LAS unsigned*)(lds + MISC_OFF + 32); xcd_barrier(b_); } while (0)
#ifdef EXP_SYNC
#define GSYNC() do { XBAR1(); XBAR1(); } while (0)
#else
#define GSYNC() XBAR1()
#endif
__global__ void __launch_bounds__(512, 2) hybrid_fwd(Params P) {
    extern __shared__ __attribute__((aligned(16))) unsigned char lds_raw[];
    cg::grid_group grid = cg::this_grid();
    LAS unsigned char* lds = (LAS unsigned char*)lds_raw;
    const int tid = threadIdx.x, lane = tid & 63, wid = __builtin_amdgcn_readfirstlane(tid >> 6);
    const int G = gridDim.x, gw = blockIdx.x * 8 + wid, NGW = G * 8;
    unsigned char* ws = P.ws;
    unsigned* ctl = (unsigned*)(ws + WS_CTL);
    volatile LAS int* slot = (volatile LAS int*)(lds + MISC_OFF);
    const float* MOD = (const float*)(ws + WS_MOD);
    bfr* XB = (bfr*)P.out;
    bfr* HN = (bfr*)(ws + WS_HN); bfr* PROJ = (bfr*)(ws + WS_PROJ); bfr* MIX = (bfr*)(ws + WS_MIX); bfr* GB = (bfr*)(ws + WS_PROJ);

    if (tid < 16) ((LAS unsigned*)(lds + MISC_OFF))[tid] = 0u;
    __syncthreads();
    (void)xcd_barrier_post(ctl + CW_BAR, (volatile LAS unsigned*)(lds + MISC_OFF + 32));
    p0_prologue(P, lds, tid, lane, wid, G);
#ifdef EXP_P0
    __syncthreads(); p0_prologue(P, lds, tid, lane, wid, G);
#endif
    grid.sync();

    for (int l = 0; l < DEPTH; ++l) {
        const float* modl = MOD + (size_t)l * NB * NMOD;
        bfr* XBm = l < DEPTH - 1 ? XB : (bfr*)(ws + WS_OINTRA);
        LayerPtrs L;
        L.conv_w = P.in[7] + (size_t)l * 4 * 384; L.conv_b = P.in[8] + (size_t)l * 384; L.b_r = P.in[10] + (size_t)l * 384; L.b_i = P.in[12] + (size_t)l * 384; L.lam = P.in[13] + (size_t)l * 384;
        L.fox_bf = P.in[14] + (size_t)l * 6; L.qgain = P.in[15] + (size_t)l * 64; L.kgain = P.in[16] + (size_t)l * 64;
        L.w_alpha = P.in[17] + (size_t)l * 16 * 256; L.b_alpha = P.in[18] + (size_t)l * 256; L.ogain = P.in[19] + (size_t)l * 64;
        L.lruw = (const bfr*)(ws + WS_LRUW) + (size_t)l * 6 * 2 * 4096;

        norm_phase(P.in[0], l == 0 ? (const bfr*)nullptr : XB, P.in[2] + (size_t)l * DMODEL, modl, 0, 1024, HN, gw, NGW, lane);
        GSYNC();
        {
            pg8::Gemm g{HN, (const bfr*)(ws + WS_WIN + l * WIN_L), MROWS, NPROJ, DMODEL}; pg8::StaticOrder S; S.init(MROWS, NPROJ, G, (int)blockIdx.x);
            pg8::EpiProj E{PROJ, NPROJ, L.qgain, L.kgain, C_FQ};
            pg8::gemm_phase<pg8::EpiProj, pg8::StaticOrder, PG8_ALIGN, PG8_SP2>(lds, g, S, E);
#ifdef EXP_G16
            __syncthreads(); pg8::gemm_phase<pg8::EpiBf16<0>, pg8::StaticOrder, PG8_ALIGN, PG8_SP2>(lds, g, S, E);
#endif
        }
        GSYNC();
        {
            constexpr int N_CUM = 24, N_GLA = 1024, N_LL = 6 * LRU_NCH * NB, N_KN = 0, N_P2 = N_CUM + N_GLA + N_LL + N_KN;
#ifdef EXP_P2
          for (int rep_ = 0; rep_ < 2; ++rep_) {
            unsigned* ctr = ctl + 64 * l + 16 + 8 * rep_;
#else
            unsigned* ctr = ctl + 64 * l + 16;
#endif
            int cur = blockIdx.x, itn = 0;
            while (cur < N_P2) {
                if (tid == 0) slot[itn & 1] = (int)atomicAdd(ctr, 1u) + G;
                if (cur < N_CUM) cum_item(cur, L, ws, lds, tid, lane, wid);
                else if (cur < N_CUM + N_GLA) gla_local_item(cur - N_CUM, L, ws, lds, tid, lane, wid);
                else if (cur < N_CUM + N_GLA + N_LL) lru_local_item(cur - N_CUM - N_GLA, L, ws, lds, tid, lane, wid);
                __syncthreads();
                cur = slot[itn & 1]; ++itn;
            }
#ifdef EXP_P2
            __syncthreads();
          }
#endif
        }
        GSYNC();
        {
            constexpr int N_ATT = 768, N_SCAN = 128, N_LRU = 384, N_GO = 256, N_ALL = N_ATT + N_SCAN + N_LRU + N_GO;
            unsigned* sdone = ctl + 64 * l + 48;
#ifdef EXP_P3
          for (int rep_ = 0; rep_ < 2; ++rep_) {
            unsigned* ctr = ctl + 64 * l + 32 * rep_;
#else
            unsigned* ctr = ctl + 64 * l;
#endif
            float skip_th;
            { int ln_ = lane; asm volatile("" : "+v"(ln_)); float gq = fabsf(L.qgain[ln_]), gk = fabsf(L.kgain[ln_]);
#pragma unroll
              for (int o = 1; o < 64; o <<= 1) { gq = fmaxf(gq, __shfl_xor(gq, o)); gk = fmaxf(gk, __shfl_xor(gk, o)); }
              skip_th = 150.0f + 2.0f * 11.7f * gq * gk; }
            int cur = blockIdx.x, itn = 0;
            while (cur < N_ALL) {
                if (tid == 0) slot[itn & 1] = (int)atomicAdd(ctr, 1u) + G;
                if (cur < N_SCAN) {
                    gla_scan_item(cur, ws, tid);
                    __syncthreads();
                    if (tid == 0) { __builtin_amdgcn_fence(__ATOMIC_RELEASE, "agent"); asm volatile("s_waitcnt vmcnt(0)" ::: "memory"); __hip_atomic_fetch_add(sdone + (cur >> 3), 1u, __ATOMIC_RELAXED, __HIP_MEMORY_SCOPE_AGENT); }
                } else if (cur < N_SCAN + N_ATT) {
                    const int ua = cur - N_SCAN; const int qb = 31 - ua / 24, bh = ua % 24, b = bh / 6, h = bh % 6;
                    attn_body::attn_unit<96>(b, h, qb, (const attn_body::bf16*)(PROJ + C_FQ), (const attn_body::bf16*)(PROJ + C_FK), (const attn_body::bf16*)(PROJ + C_FV), (attn_body::bf16*)(MIX + 384),
                                            (const float*)(ws + WS_CUM) + (size_t)bh * SEQ, L.qgain, skip_th, (char*)lds_raw);
                } else if (cur < N_SCAN + N_ATT + N_LRU) {
                    lru_out_item(cur - N_ATT - N_SCAN, ws, lds, tid, wid);
                } else {
                    const int gi = (cur - N_SCAN - N_ATT - N_LRU) * 8;
                    if (tid == 0) { unsigned sp = 0; while (__hip_atomic_load(sdone + (gi >> 7), __ATOMIC_RELAXED, __HIP_MEMORY_SCOPE_AGENT) < 8u) { __builtin_amdgcn_s_sleep(2); if (++sp > (1u << 22)) break; }
                        __builtin_amdgcn_fence(__ATOMIC_ACQUIRE, "agent"); asm volatile("s_waitcnt vmcnt(0)" ::: "memory"); }
                    __syncthreads();
                    gla_out_item(gi + wid, L, ws, lane);
                }
                __syncthreads();
                cur = slot[itn & 1]; ++itn;
            }
#ifdef EXP_P3
            __syncthreads();
          }
#endif
        }
        GSYNC();
        {
            pg8::Gemm g{MIX, (const bfr*)(ws + WS_WOUT + l * WOUT_L), MROWS, DMODEL, DMIX}; pg8::StaticOrder S; S.init(MROWS, DMODEL, G, (int)blockIdx.x);
            pg8::EpiResidB E{l == 0 ? P.in[0] : (const float*)nullptr, XB, XBm, (float*)nullptr, DMODEL, modl + 2048, NMOD, SEQ};
            pg8::gemm_phase<pg8::EpiResidB, pg8::StaticOrder, PG8_ALIGN, PG8_SP2>(lds, g, S, E);
        }
        GSYNC();
        norm_phase(P.in[0], XBm, P.in[3] + (size_t)l * DMODEL, modl, 3072, 4096, HN, gw, NGW, lane);
        GSYNC();
        {
            pg8::Gemm g{HN, (const bfr*)(ws + WS_WGU + l * WGU_L), MROWS, NGU, DMODEL}; pg8::StaticOrder S; S.init(MROWS, NGU, G, (int)blockIdx.x);
            pg8::EpiSwiGLU E{GB, DFF};
            pg8::gemm_phase<pg8::EpiSwiGLU, pg8::StaticOrder, PG8_ALIGN, PG8_SP2>(lds, g, S, E);
#ifdef EXP_G16
            __syncthreads(); pg8::gemm_phase<pg8::EpiSwiGLU, pg8::StaticOrder, PG8_ALIGN, PG8_SP2>(lds, g, S, E);
#endif
        }
        GSYNC();
        {
            pg8::Gemm g{GB, (const bfr*)(ws + WS_WDN + l * WDN_L), MROWS, DMODEL, DFF}; pg8::StaticOrder S; S.init(MROWS, DMODEL, G, (int)blockIdx.x);
            pg8::EpiResidB E{(const float*)nullptr, XBm, l < DEPTH - 1 ? XB : (bfr*)nullptr, l < DEPTH - 1 ? (float*)nullptr : P.out, DMODEL, modl + 5120, NMOD, SEQ};
            pg8::gemm_phase<pg8::EpiResidB, pg8::StaticOrder, PG8_ALIGN, PG8_SP2>(lds, g, S, E);
        }
        if (l < DEPTH - 1) GSYNC();
    }
}

extern "C" void kernel_launch(void* const* d_in, const int* in_sizes, int n_in, void* d_out, int out_size, void* d_ws, size_t ws_size, hipStream_t stream) {
    static int grid = 0;
    if (grid == 0) {
        if (n_in != 23 || out_size != MROWS * DMODEL || ws_size < WS_END) { fprintf(stderr, "kernel_launch: unexpected shapes (n_in %d out %d ws %zu)\n", n_in, out_size, ws_size); grid = -1; return; }
        int dev = 0, cus = 0, per_cu = 0;
        if (hipGetDevice(&dev) != hipSuccess || hipDeviceGetAttribute(&cus, hipDeviceAttributeMultiprocessorCount, dev) != hipSuccess) { grid = -1; return; }
        if (hipFuncSetAttribute((const void*)hybrid_fwd, hipFuncAttributeMaxDynamicSharedMemorySize, LDS_BYTES) != hipSuccess) { fprintf(stderr, "kernel_launch: hipFuncSetAttribute failed\n"); grid = -1; return; }
        if (hipOccupancyMaxActiveBlocksPerMultiprocessor(&per_cu, (const void*)hybrid_fwd, 512, LDS_BYTES) != hipSuccess || per_cu < 1) { fprintf(stderr, "kernel_launch: occupancy query says %d\n", per_cu); per_cu = 1; }
        (void)hipGetLastError();
        grid = cus;
    }
    if (grid < 0) return;
    (void)hipMemsetAsync((char*)d_ws + WS_CTL, 0, CTL_BYTES, stream);
    Params p{};
    for (int i = 0; i < 23; ++i) p.in[i] = (const float*)d_in[i];
    p.out = (float*)d_out; p.ws = (unsigned char*)d_ws;
    void* args[] = {&p};
    hipError_t e = hipLaunchCooperativeKernel((const void*)hybrid_fwd, dim3(grid), dim3(512), args, LDS_BYTES, stream);
    if (e != hipSuccess) fprintf(stderr, "kernel_launch: cooperative launch failed: %s (grid %d)\n", hipGetErrorString(e), grid);
}
```

```cpp
#include <hip/hip_runtime.h>
#include <hip/hip_cooperative_groups.h>
#include <hip/hip_bf16.h>
#include <cstdio>
#include <cstdint>
#include <cmath>
namespace cg = cooperative_groups;
namespace pg8 {
#define PG8_LAS __attribute__((address_space(3)))
typedef unsigned short bf16_t;
typedef short bf16x8 __attribute__((ext_vector_type(8)));
typedef float f32x4 __attribute__((ext_vector_type(4)));
typedef unsigned u32x4 __attribute__((ext_vector_type(4)));
constexpr int BM = 256, BK = 64, HALF = 128, HTB = HALF * BK * 2  , STAGE_BYTES = 8 * HTB, NXCD = 8, WGM = 8;

__host__ __device__ __forceinline__ int lds_byte(int r, int c) { const int st = (r >> 4) * 2 + (c >> 5), rr = r & 15, cc = c & 31, ob = rr * 64 + cc * 2; return st * 1024 + (ob ^ (((ob >> 9) & 1) << 5)); }
__host__ __device__ __forceinline__ void stage_rc(int b, int& R, int& C) { const int st = b / 1024, sb = b % 1024, swz = sb ^ (((sb >> 9) & 1) << 5); R = (st >> 1) * 16 + swz / 64; C = (st & 1) * 32 + (swz % 64) / 2; }
__host__ __device__ __forceinline__ int perm32(int rho) { const int n = rho >> 4, i = rho & 15; return 8 * (i >> 2) + 4 * n + (i & 3); }

struct Unit { int pm, pn; };
struct Gemm { const bf16_t* A; const bf16_t* Bt; int M, N, K; };

struct StaticOrder {
    int nM, nN, nwg, G, c;
    __host__ __device__ void init(int M, int N, int G_, int c_) { nM = M / BM; nN = N / BM; nwg = nM * nN; G = G_; c = c_; }
    __host__ __device__ bool next(int i, Unit& u) const {
        const long L = (long)i * G + c; if (L >= nwg) return false;
        int wgid = (int)L; { const int q = nwg / NXCD, r = nwg % NXCD, xcd = wgid % NXCD, off = wgid / NXCD; wgid = (xcd < r ? xcd * (q + 1) : r * (q + 1) + (xcd - r) * q) + off; }
        const int nig = WGM * nN, gid = wgid / nig, fm = gid * WGM, gsz = (nM - fm) < WGM ? (nM - fm) : WGM;
        u.pm = fm + ((wgid % nig) % gsz); u.pn = (wgid % nig) / gsz; return true;
    }
    __device__ __forceinline__ void a_ready(const Unit&) const {}
    __device__ __forceinline__ void done(const Unit&) const {}
};

__device__ __forceinline__ unsigned cvt_pk_bf16(float lo, float hi) { unsigned r; asm volatile("v_cvt_pk_bf16_f32 %0, %1, %2" : "=v"(r) : "v"(lo), "v"(hi)); return r; }
typedef float f32x2 __attribute__((ext_vector_type(2)));
__device__ __forceinline__ f32x2 gelu_pk(f32x2 v) {
    const f32x2 av = __builtin_elementwise_abs(v), d = av * 0.2316418882f + 1.0f;
    f32x2 t; t.x = __builtin_amdgcn_rcpf(d.x); t.y = __builtin_amdgcn_rcpf(d.y);
    f32x2 q = t * 0.5307027145f + (-0.7265760135f); q = q * t + 0.7107068705f; q = q * t + (-0.142248368f); q = q * t + 0.127414796f; q = q * t;
    const f32x2 s = (v * v) * (-0.72134752044f);
    f32x2 e; e.x = __builtin_amdgcn_exp2f(s.x); e.y = __builtin_amdgcn_exp2f(s.y);
    const f32x2 m = v * (q * e), r = v - m;
    f32x2 o; o.x = v.x < 0.f ? m.x : r.x; o.y = v.y < 0.f ? m.y : r.y; return o;
}

template <int ACT  > struct EpiBf16 {
    static constexpr bool PERM = true, AFTER_DRAIN = false; static_assert(ACT == 0 || ACT == 1, "EpiBf16: ACT is 0 (none) or 1 (gelu_pk)");
    bf16_t* O; int ldc; const float* bias; int split_cols; size_t split_stride; float scale0;
    __device__ __forceinline__ void operator()(const f32x4 (&acc)[2][2][4][2], const Unit& u, int wr, int wc, int fr, int fq) const {
        const int row0 = u.pm * BM + wr * 64 + fr; int colt = u.pn * BM; bf16_t* base = O;
        float sc = 1.f; if (split_cols) { const int t = colt / split_cols; base += (size_t)t * split_stride; colt -= t * split_cols; if (t == 0) sc = scale0; }
        const int col0 = colt + wc * 32 + 8 * fq, bcol0 = u.pn * BM + wc * 32 + 8 * fq;
        f32x4 bv[2][2];
#pragma unroll
        for (int bj = 0; bj < 2; ++bj)
#pragma unroll
            for (int n = 0; n < 2; ++n) bv[bj][n] = bias ? *(const f32x4*)(bias + bcol0 + bj * HALF + 4 * n) : (f32x4){0.f, 0.f, 0.f, 0.f};
#pragma unroll
        for (int ai = 0; ai < 2; ++ai)
#pragma unroll
            for (int m = 0; m < 4; ++m) { bf16_t* rowp = base + (size_t)(row0 + ai * HALF + m * 16) * ldc + col0;
#pragma unroll
                for (int bj = 0; bj < 2; ++bj) { f32x4 v0 = acc[ai][bj][m][0] + bv[bj][0], v1 = acc[ai][bj][m][1] + bv[bj][1];
                    if (ACT == 1) { f32x2 a = gelu_pk((f32x2){v0[0], v0[1]}), b = gelu_pk((f32x2){v0[2], v0[3]}), c = gelu_pk((f32x2){v1[0], v1[1]}), d = gelu_pk((f32x2){v1[2], v1[3]});
                        v0 = (f32x4){a.x, a.y, b.x, b.y}; v1 = (f32x4){c.x, c.y, d.x, d.y}; }
                    v0 = v0 * sc; v1 = v1 * sc; u32x4 w; w.x = cvt_pk_bf16(v0[0], v0[1]); w.y = cvt_pk_bf16(v0[2], v0[3]); w.z = cvt_pk_bf16(v1[0], v1[1]); w.w = cvt_pk_bf16(v1[2], v1[3]);
                    *(u32x4*)(rowp + bj * HALF) = w; } }
    }
};


struct EpiProj {
    static constexpr bool PERM = true, AFTER_DRAIN = false;
    bf16_t* O; int ldc; const float* qgain; const float* kgain; int cfq;
    __device__ __forceinline__ void operator()(const f32x4 (&acc)[2][2][4][2], const Unit& u, int wr, int wc, int fr, int fq) const {
        const int row0 = u.pm * BM + wr * 64 + fr;
        if (u.pn < 3 || u.pn > 5) {
            const int col0 = u.pn * BM + wc * 32 + 8 * fq;
#pragma unroll
            for (int ai = 0; ai < 2; ++ai)
#pragma unroll
                for (int m = 0; m < 4; ++m) { bf16_t* rowp = O + (size_t)(row0 + ai * HALF + m * 16) * ldc + col0;
#pragma unroll
                    for (int bj = 0; bj < 2; ++bj) { const f32x4 v0 = acc[ai][bj][m][0], v1 = acc[ai][bj][m][1];
                        u32x4 w; w.x = cvt_pk_bf16(v0[0], v0[1]); w.y = cvt_pk_bf16(v0[2], v0[3]); w.z = cvt_pk_bf16(v1[0], v1[1]); w.w = cvt_pk_bf16(v1[2], v1[3]);
                        *(u32x4*)(rowp + bj * HALF) = w; } }
        } else {
            const int H = 4 * (u.pn - 3) + wc;
            const float* gp = (H < 6 ? qgain : kgain) + 8 * fq; const float sc = H < 6 ? 0.125f * 1.4426950408889634f : 1.0f;
            f32x4 gv[2][2];
#pragma unroll
            for (int bj = 0; bj < 2; ++bj)
#pragma unroll
                for (int n = 0; n < 2; ++n) gv[bj][n] = *(const f32x4*)(gp + 32 * bj + 4 * n) * sc;
            const int col0 = cfq + H * 64 + 8 * fq;
#pragma unroll
            for (int ai = 0; ai < 2; ++ai)
#pragma unroll
                for (int m = 0; m < 4; ++m) { bf16_t* rowp = O + (size_t)(row0 + ai * HALF + m * 16) * ldc + col0;
                    float ss = 0.f;
#pragma unroll
                    for (int bj = 0; bj < 2; ++bj)
#pragma unroll
                        for (int n = 0; n < 2; ++n) { const f32x4 x = acc[ai][bj][m][n]; ss += (x[0] * x[0] + x[1] * x[1]) + (x[2] * x[2] + x[3] * x[3]); }
                    ss += __shfl_xor(ss, 16); ss += __shfl_xor(ss, 32);
                    const float rs = __builtin_amdgcn_rsqf(ss * (1.0f / 64.0f) + 1e-6f);
#pragma unroll
                    for (int bj = 0; bj < 2; ++bj) { const f32x4 v0 = acc[ai][bj][m][0] * rs * gv[bj][0], v1 = acc[ai][bj][m][1] * rs * gv[bj][1];
                        u32x4 w; w.x = cvt_pk_bf16(v0[0], v0[1]); w.y = cvt_pk_bf16(v0[2], v0[3]); w.z = cvt_pk_bf16(v1[0], v1[1]); w.w = cvt_pk_bf16(v1[2], v1[3]);
                        *(u32x4*)(rowp + 32 * bj) = w; } }
        }
    }
};
struct EpiSwiGLU {
    static constexpr bool PERM = true, AFTER_DRAIN = false;
    bf16_t* O; int ldc;
    __device__ __forceinline__ void operator()(const f32x4 (&acc)[2][2][4][2], const Unit& u, int wr, int wc, int fr, int fq) const {
        const int row0 = u.pm * BM + wr * 64 + fr; const int col0 = u.pn * HALF + wc * 32 + 8 * fq;
#pragma unroll
        for (int ai = 0; ai < 2; ++ai)
#pragma unroll
            for (int m = 0; m < 4; ++m) { bf16_t* rowp = O + (size_t)(row0 + ai * HALF + m * 16) * ldc + col0;
                float o[8];
#pragma unroll
                for (int n = 0; n < 2; ++n)
#pragma unroll
                    for (int j = 0; j < 4; ++j) { const float g = acc[ai][0][m][n][j], up = acc[ai][1][m][n][j];
                        const float sg = g * __builtin_amdgcn_rcpf(1.0f + __builtin_amdgcn_exp2f(-1.4426950408889634f * g)); o[n * 4 + j] = sg * up; }
                u32x4 w; w.x = cvt_pk_bf16(o[0], o[1]); w.y = cvt_pk_bf16(o[2], o[3]); w.z = cvt_pk_bf16(o[4], o[5]); w.w = cvt_pk_bf16(o[6], o[7]);
                *(u32x4*)rowp = w; }
    }
};
struct EpiResid {
    static constexpr bool PERM = false, AFTER_DRAIN = false;
    const float* base; float* out; int ldc; const float* gate; int gstride; int rows_per_batch;
    __device__ __forceinline__ void operator()(const f32x4 (&acc)[2][2][4][2], const Unit& u, int wr, int wc, int fr, int fq) const {
        const int col0 = u.pn * BM + wc * 32 + 4 * fq;
        const float* gp = gate + (size_t)((u.pm * BM) / rows_per_batch) * gstride + col0;
        f32x4 gv[2][2];
#pragma unroll
        for (int bj = 0; bj < 2; ++bj)
#pragma unroll
            for (int n = 0; n < 2; ++n) gv[bj][n] = *(const f32x4*)(gp + bj * HALF + n * 16);
#pragma unroll
        for (int ai = 0; ai < 2; ++ai)
#pragma unroll
            for (int m = 0; m < 4; ++m) { const size_t off = (size_t)(u.pm * BM + ai * HALF + wr * 64 + m * 16 + fr) * ldc + col0;
#pragma unroll
                for (int bj = 0; bj < 2; ++bj)
#pragma unroll
                    for (int n = 0; n < 2; ++n) { const f32x4 bs = *(const f32x4*)(base + off + bj * HALF + n * 16);
                        *(f32x4*)(out + off + bj * HALF + n * 16) = bs + gv[bj][n] * acc[ai][bj][m][n]; } }
    }
};


typedef _Float16 h16x2 __attribute__((ext_vector_type(2)));
__device__ __forceinline__ f32x2 h2f(unsigned w) { return __builtin_convertvector(__builtin_bit_cast(h16x2, w), f32x2); }
__device__ __forceinline__ unsigned f2h(float lo, float hi) { f32x2 v = {lo, hi}; return __builtin_bit_cast(unsigned, __builtin_convertvector(v, h16x2)); }
struct EpiResidB {
    static constexpr bool PERM = true, AFTER_DRAIN = false;
    const float* base32; const bf16_t* base16; bf16_t* out16; float* out32; int ldc; const float* gate; int gstride; int rows_per_batch;
    __device__ __forceinline__ void operator()(const f32x4 (&acc)[2][2][4][2], const Unit& u, int wr, int wc, int fr, int fq) const {
        const int row0 = u.pm * BM + wr * 64 + fr; const int col0 = u.pn * BM + wc * 32 + 8 * fq;
        const float* gp = gate + (size_t)((u.pm * BM) / rows_per_batch) * gstride + col0;
        f32x4 gv[2][2];
#pragma unroll
        for (int bj = 0; bj < 2; ++bj)
#pragma unroll
            for (int n = 0; n < 2; ++n) gv[bj][n] = *(const f32x4*)(gp + bj * HALF + 4 * n);
#pragma unroll
        for (int ai = 0; ai < 2; ++ai)
#pragma unroll
            for (int m = 0; m < 4; ++m) { const size_t off = (size_t)(row0 + ai * HALF + m * 16) * ldc + col0;
#pragma unroll
                for (int bj = 0; bj < 2; ++bj) {
                    f32x4 b0, b1;
                    if (base32) { b0 = *(const f32x4*)(base32 + off + bj * HALF); b1 = *(const f32x4*)(base32 + off + bj * HALF + 4); }
                    else { const u32x4 w = *(const u32x4*)(base16 + off + bj * HALF);
                        const f32x2 p0 = h2f(w.x), p1 = h2f(w.y), p2 = h2f(w.z), p3 = h2f(w.w);
                        b0 = (f32x4){p0.x, p0.y, p1.x, p1.y}; b1 = (f32x4){p2.x, p2.y, p3.x, p3.y}; }
                    const f32x4 v0 = b0 + gv[bj][0] * acc[ai][bj][m][0], v1 = b1 + gv[bj][1] * acc[ai][bj][m][1];
                    if (out32) { *(f32x4*)(out32 + off + bj * HALF) = v0; *(f32x4*)(out32 + off + bj * HALF + 4) = v1; }
                    else { u32x4 w; w.x = f2h(v0[0], v0[1]); w.y = f2h(v0[2], v0[3]); w.z = f2h(v1[0], v1[1]); w.w = f2h(v1[2], v1[3]); *(u32x4*)(out16 + off + bj * HALF) = w; } } }
    }
};

template <class Epi, class Sched, bool ALIGN_EPI = false, bool SP2 = false>
__device__ __forceinline__ void gemm_phase(PG8_LAS unsigned char* lds, const Gemm g, const Sched& S, const Epi& E) {
    int tid = threadIdx.x; asm volatile("" : "+v"(tid)); const int wid = __builtin_amdgcn_readfirstlane(tid >> 6), lane = tid & 63, wr = wid >> 2, wc = wid & 3, fr = lane & 15, fq = lane >> 4;
    const int K = g.K, nt = K / BK;
    unsigned voffA[2], voffB[2];
#pragma unroll
    for (int i = 0; i < 2; ++i) { int R, C; stage_rc(tid * 16 + i * 8192, R, C); const int Rb = Epi::PERM ? ((R & ~31) + perm32(R & 31)) : R;
        voffA[i] = (unsigned)(R * K + C) * 2u; voffB[i] = (unsigned)(Rb * K + C) * 2u; }
    const size_t kstep = (size_t)(BK * 2);
    const size_t hstep = (size_t)HALF * K * 2;
    const size_t tstep = 2 * hstep;
    const unsigned ldsw = (unsigned)wid * 1024u;
    const int aoff = lds_byte(wr * 64 + fr, fq * 8), boff = lds_byte(wc * 32 + fr, fq * 8);
#define PG8_SA(b, h) (((b) * 2 + (h)) * HTB)
#define PG8_SB(b, h) ((4 + (b) * 2 + (h)) * HTB)
#define PG8_STAGE(bufoff, gbase, voff) do { _Pragma("unroll") for (int _i = 0; _i < 2; ++_i) \
        __builtin_amdgcn_global_load_lds((const unsigned*)((const char*)(gbase) + (voff)[_i]), (PG8_LAS unsigned*)(lds + (bufoff) + ldsw + _i * 8192), 16, 0, 0); } while (0)
#define PG8_LDA(dst, b, h) do { _Pragma("unroll") for (int m = 0; m < 4; ++m) _Pragma("unroll") for (int k = 0; k < 2; ++k) dst[m][k] = *(const PG8_LAS bf16x8*)(lds + PG8_SA(b, h) + aoff + m * 2048 + k * 1024); } while (0)
#define PG8_LDB(dst, b, h) do { _Pragma("unroll") for (int n = 0; n < 2; ++n) _Pragma("unroll") for (int k = 0; k < 2; ++k) dst[n][k] = *(const PG8_LAS bf16x8*)(lds + PG8_SB(b, h) + boff + n * 2048 + k * 1024); } while (0)
#define PG8_MMA(ai, bj, At, Bt) do { __builtin_amdgcn_s_setprio(1); _Pragma("unroll") for (int m = 0; m < 4; ++m) _Pragma("unroll") for (int n = 0; n < 2; ++n) _Pragma("unroll") for (int k = 0; k < 2; ++k) \
        acc[ai][bj][m][n] = __builtin_amdgcn_mfma_f32_16x16x32_bf16(Bt[n][k], At[m][k], acc[ai][bj][m][n], 0, 0, 0); __builtin_amdgcn_s_setprio(0); } while (0)
#define PG8_WAIT_V(n) asm volatile("s_waitcnt vmcnt(" #n ")" ::: "memory")
#define PG8_WAIT_L(n) asm volatile("s_waitcnt lgkmcnt(" #n ")" ::: "memory")
#define PG8_BAR __builtin_amdgcn_s_barrier()
#define PG8_SCHED __builtin_amdgcn_sched_barrier(0)
    Unit cur, nxt; int ui = 0;
    if (!S.next(0, cur)) return;
    f32x4 acc[2][2][4][2];
#pragma unroll
    for (int a = 0; a < 2; ++a)
#pragma unroll
        for (int b = 0; b < 2; ++b)
#pragma unroll
            for (int m = 0; m < 4; ++m)
#pragma unroll
                for (int n = 0; n < 2; ++n) acc[a][b][m][n] = (f32x4){0.f, 0.f, 0.f, 0.f};
    bf16x8 At[4][2], B0[2][2], B1[2][2];
    const char* cA = (const char*)g.A + (size_t)cur.pm * tstep; const char* cB = (const char*)g.Bt + (size_t)cur.pn * tstep;
    S.a_ready(cur);
    if constexpr (SP2) {
        PG8_STAGE(PG8_SB(0, 0), cB, voffB); PG8_STAGE(PG8_SB(0, 1), cB + hstep, voffB); PG8_STAGE(PG8_SA(0, 0), cA, voffA); PG8_STAGE(PG8_SA(0, 1), cA + hstep, voffA);
        if (wr == 1) PG8_BAR;
        PG8_WAIT_V(2); PG8_BAR;
        PG8_STAGE(PG8_SB(1, 0), cB + kstep, voffB); PG8_STAGE(PG8_SA(1, 0), cA + kstep, voffA); PG8_STAGE(PG8_SB(1, 1), cB + hstep + kstep, voffB);
        PG8_WAIT_V(6); PG8_BAR;
    } else {
        PG8_STAGE(PG8_SB(0, 0), cB, voffB); PG8_STAGE(PG8_SA(0, 0), cA, voffA); PG8_STAGE(PG8_SB(0, 1), cB + hstep, voffB); PG8_STAGE(PG8_SA(0, 1), cA + hstep, voffA);
        if (wr == 1) PG8_BAR;
        PG8_WAIT_V(4); PG8_BAR;
        PG8_STAGE(PG8_SB(1, 0), cB + kstep, voffB); PG8_STAGE(PG8_SA(1, 0), cA + kstep, voffA); PG8_STAGE(PG8_SB(1, 1), cB + hstep + kstep, voffB);
        PG8_WAIT_V(6); PG8_BAR;
    }
    for (;;) {
        const bool has_next = S.next(ui + 1, nxt);
        const char* nA = has_next ? (const char*)g.A + (size_t)nxt.pm * tstep : cA; const char* nB = has_next ? (const char*)g.Bt + (size_t)nxt.pn * tstep : cB;
        for (int t = 0; t < nt; t += 2) {
            const bool last = (t == nt - 2);
            const char* a1 = cA + (size_t)(t + 1) * kstep;
            const char* a2 = last ? nA : cA + (size_t)(t + 2) * kstep; const char* b2 = last ? nB : cB + (size_t)(t + 2) * kstep;
            const char* a3 = a2 + kstep; const char* b3 = b2 + kstep;
            if (last && has_next) S.a_ready(nxt);
            if constexpr (SP2) {
            PG8_LDB(B0, 0, 0); PG8_LDB(B1, 0, 1); PG8_SCHED; PG8_LDA(At, 0, 0); PG8_STAGE(PG8_SA(1, 1), a1 + hstep, voffA);
            PG8_WAIT_V(8); PG8_WAIT_L(0); PG8_BAR; PG8_MMA(0, 0, At, B0); PG8_MMA(0, 1, At, B1); PG8_BAR; PG8_SCHED;
            PG8_LDA(At, 0, 1); PG8_STAGE(PG8_SB(0, 0), b2, voffB); PG8_STAGE(PG8_SB(0, 1), b2 + hstep, voffB); PG8_STAGE(PG8_SA(0, 0), a2, voffA);
            PG8_WAIT_V(8); PG8_WAIT_L(0); PG8_BAR; PG8_MMA(1, 0, At, B0); PG8_MMA(1, 1, At, B1); PG8_BAR; PG8_SCHED;
            PG8_LDB(B0, 1, 0); PG8_LDB(B1, 1, 1); PG8_SCHED; PG8_LDA(At, 1, 0); PG8_STAGE(PG8_SA(0, 1), a2 + hstep, voffA);
            PG8_WAIT_V(8); PG8_WAIT_L(0); PG8_BAR; PG8_MMA(0, 0, At, B0); PG8_MMA(0, 1, At, B1); PG8_BAR; PG8_SCHED;
            PG8_LDA(At, 1, 1); PG8_STAGE(PG8_SB(1, 0), b3, voffB); PG8_STAGE(PG8_SB(1, 1), b3 + hstep, voffB); PG8_STAGE(PG8_SA(1, 0), a3, voffA);
            PG8_WAIT_V(8); PG8_WAIT_L(0); PG8_BAR; PG8_MMA(1, 0, At, B0); PG8_MMA(1, 1, At, B1); PG8_BAR; PG8_SCHED;
            } else {
            PG8_LDB(B0, 0, 0); PG8_SCHED; PG8_LDA(At, 0, 0); PG8_STAGE(PG8_SA(1, 1), a1 + hstep, voffA);
            PG8_WAIT_L(8); PG8_BAR; PG8_WAIT_L(0); PG8_MMA(0, 0, At, B0); PG8_BAR; PG8_SCHED;
            PG8_LDB(B1, 0, 1); PG8_STAGE(PG8_SB(0, 0), b2, voffB);
            PG8_BAR; PG8_WAIT_L(0); PG8_MMA(0, 1, At, B1); PG8_BAR;
            PG8_LDA(At, 0, 1); PG8_STAGE(PG8_SA(0, 0), a2, voffA);
            PG8_BAR; PG8_WAIT_L(0); PG8_MMA(1, 0, At, B0); PG8_BAR; PG8_SCHED;
            PG8_STAGE(PG8_SB(0, 1), b2 + hstep, voffB);
            PG8_WAIT_V(6); PG8_BAR; PG8_MMA(1, 1, At, B1); PG8_BAR;
            PG8_LDB(B0, 1, 0); PG8_SCHED; PG8_LDA(At, 1, 0); PG8_STAGE(PG8_SA(0, 1), a2 + hstep, voffA);
            PG8_WAIT_L(8); PG8_BAR; PG8_WAIT_L(0); PG8_MMA(0, 0, At, B0); PG8_BAR; PG8_SCHED;
            PG8_LDB(B1, 1, 1); PG8_STAGE(PG8_SB(1, 0), b3, voffB);
            PG8_BAR; PG8_WAIT_L(0); PG8_MMA(0, 1, At, B1); PG8_BAR;
            PG8_LDA(At, 1, 1); PG8_STAGE(PG8_SA(1, 0), a3, voffA);
            PG8_BAR; PG8_WAIT_L(0); PG8_MMA(1, 0, At, B0); PG8_BAR; PG8_SCHED;
            PG8_STAGE(PG8_SB(1, 1), b3 + hstep, voffB);
            PG8_WAIT_V(6); PG8_BAR; PG8_MMA(1, 1, At, B1); PG8_BAR;
            }
        }
        if constexpr (ALIGN_EPI) { if (wr == 0) PG8_BAR; }
        if constexpr (!Epi::AFTER_DRAIN) { E(acc, cur, wr, wc, fr, fq); S.done(cur); }
        if (!has_next) break;
#pragma unroll
        for (int a = 0; a < 2; ++a)
#pragma unroll
            for (int b = 0; b < 2; ++b)
#pragma unroll
                for (int m = 0; m < 4; ++m)
#pragma unroll
                    for (int n = 0; n < 2; ++n) acc[a][b][m][n] = (f32x4){0.f, 0.f, 0.f, 0.f};
        cur = nxt; cA = nA; cB = nB; ++ui;
        if constexpr (ALIGN_EPI) { if (wr == 1) PG8_BAR; }
    }
    PG8_WAIT_V(0);
    if constexpr (!ALIGN_EPI) { if (wr == 0) PG8_BAR; }
    PG8_BAR;
    if constexpr (Epi::AFTER_DRAIN) { E.fused(acc, cur, wr, wc, fr, fq, lds, wid, lane); S.done(cur); }
#undef PG8_SA
#undef PG8_SB
#undef PG8_STAGE
#undef PG8_LDA
#undef PG8_LDB
#undef PG8_MMA
#undef PG8_WAIT_V
#undef PG8_WAIT_L
#undef PG8_BAR
#undef PG8_SCHED
}
}

#ifndef PG8_SP2
#define PG8_SP2 true
#endif
#ifndef PG8_ALIGN
#define PG8_ALIGN true
#endif
#include <hip/hip_bf16.h>
#include <cmath>
namespace attn_body {
using bf16=__hip_bfloat16;
using bf16x8=__attribute__((ext_vector_type(8)))short;
using s16x4=__attribute__((ext_vector_type(4)))short;
using f32x16=__attribute__((ext_vector_type(16)))float;
using u32x4=__attribute__((ext_vector_type(4)))unsigned;
constexpr int BATCH=4,NHEAD=6,SEQ=8192,D=64,DM=3072,ODM=1024;
constexpr int NW=8,QBLK=32,QB=QBLK*NW,KVBLK=64,NQB=SEQ/QB;
constexpr int ATTN_PITCH=DM, ATTN_UNIT_ROWS=QB;
__device__ __forceinline__ int crow(int r,int hi){return (r&3)+8*(r>>2)+4*hi;}
#define SBAR() __builtin_amdgcn_sched_barrier(0)
__device__ __forceinline__ void cmask(f32x16&p0,f32x16&p1,int jb,int qrel,int hi){
  const float NEG=-INFINITY; int kb=64*jb+4*hi;
  #pragma unroll
  for(int r=0;r<16;++r){int kv=kb+(r&3)+8*(r>>2); if(kv>qrel)p0[r]=NEG; if(kv+32>qrel)p1[r]=NEG;}
}

constexpr int NSLOT=3, SLOTB=8192;
constexpr int LDS_K=0, LDS_V=NSLOT*SLOTB, LDS_WS=2*NSLOT*SLOTB, LDS_OST=LDS_WS+NW*64*4, LDS_CKS=LDS_OST+NW*4096, LDS_BYTES=LDS_CKS+SEQ*4;
constexpr float C2=0.125f*1.4426950408889634f;
__device__ __forceinline__ void glds16(const void*gsrc,unsigned lds_dst){unsigned keep;
  asm volatile("s_mov_b32 %0, m0\n\ts_mov_b32 m0, %2\n\ts_nop 0\n\tglobal_load_lds_dwordx4 %1, off\n\ts_mov_b32 m0, %0":"=&s"(keep):"v"(gsrc),"s"(lds_dst):"memory");}
__device__ __forceinline__ float max3f(float a,float b,float c){float r;asm("v_max3_f32 %0, %1, %2, %3":"=v"(r):"v"(a),"v"(b),"v"(c));return r;}
__device__ __forceinline__ float max2f(float a,float b){float r;asm("v_max_f32_e32 %0, %1, %2":"=v"(r):"v"(a),"v"(b));return r;}
__device__ __forceinline__ float fadd_s(float a,float b){float r;asm("v_add_f32_e32 %0, %1, %2":"=v"(r):"v"(a),"v"(b));return r;}
__device__ __forceinline__ float fsub_s(float a,float b){float r;asm("v_sub_f32_e32 %0, %1, %2":"=v"(r):"v"(a),"v"(b));return r;}
typedef float f32x2_t __attribute__((ext_vector_type(2))); typedef __bf16 bf16x2_t __attribute__((ext_vector_type(2)));
__device__ __forceinline__ unsigned cvtpk_s(float lo,float hi){f32x2_t v={lo,hi};bf16x2_t b=__builtin_convertvector(v,bf16x2_t);return __builtin_bit_cast(unsigned,b);}
#define WAIT_BAR(N) asm volatile("s_waitcnt vmcnt(" #N ") lgkmcnt(0)\n\ts_barrier":::"memory")

__device__ __forceinline__ void qkt(f32x16&p0,f32x16&p1,const char*Kslot,const bf16x8*qr,const f32x16&negm,int r32,int hi){
  const char*kb=Kslot+hi*1024+r32*16;
  #pragma unroll
  for(int d0=0;d0<4;++d0){
    const bf16x8 b0=*reinterpret_cast<const bf16x8*>(kb+d0*2048);
    const bf16x8 b1=*reinterpret_cast<const bf16x8*>(kb+d0*2048+512);
    if(d0==0){p0=__builtin_amdgcn_mfma_f32_32x32x16_bf16(b0,qr[0],negm,0,0,0);p1=__builtin_amdgcn_mfma_f32_32x32x16_bf16(b1,qr[0],negm,0,0,0);}
    else{p0=__builtin_amdgcn_mfma_f32_32x32x16_bf16(b0,qr[d0],p0,0,0,0);p1=__builtin_amdgcn_mfma_f32_32x32x16_bf16(b1,qr[d0],p1,0,0,0);}}
}
typedef __attribute__((address_space(3))) const char* lds_cptr;
typedef short v4i16_t __attribute__((ext_vector_type(4)));
__device__ __forceinline__ void kload8(bf16x8*kf,lds_cptr kp){
  kf[0]=*(const __attribute__((address_space(3))) bf16x8*)(kp);      kf[1]=*(const __attribute__((address_space(3))) bf16x8*)(kp+512);
  kf[2]=*(const __attribute__((address_space(3))) bf16x8*)(kp+2048); kf[3]=*(const __attribute__((address_space(3))) bf16x8*)(kp+2560);
  kf[4]=*(const __attribute__((address_space(3))) bf16x8*)(kp+4096); kf[5]=*(const __attribute__((address_space(3))) bf16x8*)(kp+4608);
  kf[6]=*(const __attribute__((address_space(3))) bf16x8*)(kp+6144); kf[7]=*(const __attribute__((address_space(3))) bf16x8*)(kp+6656);
}
__device__ __forceinline__ void kload2(bf16x8*kf,lds_cptr kp,int j){ kf[2*j]=*(const __attribute__((address_space(3))) bf16x8*)(kp+j*2048); kf[2*j+1]=*(const __attribute__((address_space(3))) bf16x8*)(kp+j*2048+512); }
__device__ __forceinline__ s16x4 vtr(lds_cptr p){ return __builtin_bit_cast(s16x4,__builtin_amdgcn_ds_read_tr16_b64_v4i16((__attribute__((address_space(3))) v4i16_t*)p)); }
__device__ __forceinline__ float rowmax(const f32x16&p0,const f32x16&p1){
  float a=max3f(p0[0],p0[1],p1[0]),b=max3f(p0[2],p0[3],p1[1]);a=max3f(a,p1[2],p1[3]);
  #pragma unroll
  for(int r=4;r<16;r+=4){a=max3f(a,p0[r],p0[r+1]);b=max3f(b,p0[r+2],p0[r+3]);a=max3f(a,p1[r],p1[r+1]);b=max3f(b,p1[r+2],p1[r+3]);}
  const float m=max2f(a,b);
  auto rr=__builtin_amdgcn_permlane32_swap(__float_as_uint(m),__float_as_uint(m),false,false);
  return max2f(__uint_as_float(rr[0]),__uint_as_float(rr[1]));
}
__device__ __forceinline__ void pv(f32x16*o,int vb,bf16x8 pa0,bf16x8 pa1,bf16x8 pa2,bf16x8 pa3){
  #pragma unroll
  for(int d0=0;d0<2;++d0){s16x4 lo[4],hi[4];
    #pragma unroll
    for(int ks=0;ks<4;++ks){
      asm volatile("ds_read_b64_tr_b16 %0,%1 offset:%c2":"=&v"(lo[ks]):"v"(vb),"i"(d0*4096+ks*1024):"memory");
      asm volatile("ds_read_b64_tr_b16 %0,%1 offset:%c2":"=&v"(hi[ks]):"v"(vb),"i"(d0*4096+ks*1024+512):"memory");}
    asm volatile("s_waitcnt lgkmcnt(0)":::"memory");SBAR();
    #define PK(k) (bf16x8){lo[k][0],lo[k][1],lo[k][2],lo[k][3],hi[k][0],hi[k][1],hi[k][2],hi[k][3]}
    o[d0]=__builtin_amdgcn_mfma_f32_32x32x16_bf16(pa0,PK(0),o[d0],0,0,0);
    o[d0]=__builtin_amdgcn_mfma_f32_32x32x16_bf16(pa1,PK(1),o[d0],0,0,0);
    o[d0]=__builtin_amdgcn_mfma_f32_32x32x16_bf16(pa2,PK(2),o[d0],0,0,0);
    o[d0]=__builtin_amdgcn_mfma_f32_32x32x16_bf16(pa3,PK(3),o[d0],0,0,0);
    #undef PK
  }
}

#ifndef ATTN_STORE16
#define ATTN_STORE16(p,v) (*(u32x4*)(p)=(v))
#endif
template<int THRL> __device__ __forceinline__ void attn_unit(int b,int h,int qb,const bf16*Q,const bf16*__restrict__ K,const bf16*__restrict__ V,bf16*O,const float*__restrict__ CUMh,const float*__restrict__ qgain,const float skip_th,char*shm){
  int tid=threadIdx.x; asm volatile("":"+v"(tid)); const int lane=tid&63,r32=lane&31,hi=lane>>5; const int wid=__builtin_amdgcn_readfirstlane(tid>>6);
  const long rowbase=(long)b*SEQ; const int q0=qb*QB;
  const bf16*Qw=Q+(rowbase+q0+wid*QBLK)*DM+h*D;
  const bf16*Kh=K+rowbase*DM+h*D,*Vh=V+rowbase*DM+h*D;
  const float cref=CUMh[q0]; int ts=0;
  { const int tmax=(q0+QB)/KVBLK-4;
    for(int t0=0;t0<tmax;t0+=64){ const int t=t0+lane; bool sk=false; if(t<tmax) sk=(CUMh[64*t+63]-cref)*1.4426950408889634f>skip_th; ts+=__popcll(__ballot(sk)); }
    ts=__builtin_amdgcn_readfirstlane(ts)&~1; }
  Kh+=(long)ts*KVBLK*DM; Vh+=(long)ts*KVBLK*DM;
  const unsigned lds0=(unsigned)(uintptr_t)shm;
  float*wsf=(float*)(shm+LDS_WS)+wid*64;
  const bf16*ksrc=Kh+(long)lane*DM+wid*8;
  const bf16*vsrc=Vh+(long)(16*(wid&3)+(lane>>2))*DM+(wid>>2)*32+(lane&3)*8;
  const unsigned kdst=lds0+LDS_K+wid*1024, vdst=lds0+LDS_V+wid*1024;
  #define DMA_K(t,slot) glds16(ksrc+(long)(t)*KVBLK*DM,(unsigned)__builtin_amdgcn_readfirstlane(kdst+(slot)))
  #define DMA_V(t,slot) glds16(vsrc+(long)(t)*KVBLK*DM,(unsigned)__builtin_amdgcn_readfirstlane(vdst+(slot)))
  const int vb0=(int)(lds0+LDS_V)+((lane>>4)&1)*32+(lane&3)*8+(4*hi+((lane&15)>>2))*64;
  const char*Kbase=shm+LDS_K; bf16x8 kf[8];
  const lds_cptr shm3=(lds_cptr)shm; const lds_cptr kp0=shm3+LDS_K+hi*1024+r32*16; const lds_cptr vp0=shm3+LDS_V+((lane>>4)&1)*32+(lane&3)*8+(4*hi+((lane&15)>>2))*64;
  const int NT=(q0+QB)/KVBLK-ts;
  DMA_K(0,0);DMA_V(0,0);DMA_K(1,SLOTB);
  bf16x8 qr[4];
  #pragma unroll
  for(int d0=0;d0<4;++d0)qr[d0]=*reinterpret_cast<const bf16x8*>(&Qw[(long)r32*DM+d0*16+hi*8]);
  {
    __attribute__((address_space(3))) float*ckw=(__attribute__((address_space(3))) float*)(shm3+LDS_CKS); const int nkv=q0+QB-ts*KVBLK; const float*cums=CUMh+ts*KVBLK;
    for(int i=tid*4;i<nkv;i+=NW*64*4){ const float4 c4=*reinterpret_cast<const float4*>(cums+i);
      ckw[i]=(c4.x-cref)*1.4426950408889634f; ckw[i+1]=(c4.y-cref)*1.4426950408889634f; ckw[i+2]=(c4.z-cref)*1.4426950408889634f; ckw[i+3]=(c4.w-cref)*1.4426950408889634f; }
  }
  float mhat=0.f,l_reg=0.f;f32x16 o[2];o[0]=f32x16{};o[1]=f32x16{};f32x16 negm=f32x16{};asm volatile("":"+v"(negm));
  const int qrel=wid*QBLK+r32;
  #define CMASK(P0,P1,t) do{int jb_=(t)-(NT-4); if(jb_>=0)cmask(P0,P1,jb_,qrel,hi);}while(0)
  bool resc=false;
  #define START(P0,P1) do{ const float rm=rowmax(P0,P1); resc=false; \
    { const float dl=rm; mhat=fadd_s(mhat,dl); \
      _Pragma("unroll") for(int r=0;r<16;++r){P0[r]=fsub_s(P0[r],dl);P1[r]=fsub_s(P1[r],dl);} \
      _Pragma("unroll") for(int r=0;r<16;++r)negm[r]=-mhat; asm volatile("":"+v"(negm)); } \
    _Pragma("unroll") for(int r=0;r<16;++r)P0[r]=__builtin_amdgcn_exp2f(P0[r]); }while(0)
  #define RESC() do{ if(resc){ asm volatile("s_waitcnt lgkmcnt(0)":::"memory"); \
      _Pragma("unroll") for(int d_=0;d_<2;++d_) _Pragma("unroll") for(int r=0;r<16;++r)o[d_][r]*=wsf[crow(r,hi)]; } }while(0)
  typedef float f32x4_t __attribute__((ext_vector_type(4)));
  #define BIAS(P0,P1,t) do{ const __attribute__((address_space(3))) float*ck_=(const __attribute__((address_space(3))) float*)(shm3+LDS_CKS)+(t)*64+4*hi; \
    _Pragma("unroll") for(int g_=0;g_<4;++g_){ const f32x4_t a_=*(const __attribute__((address_space(3))) f32x4_t*)(ck_+8*g_), b_=*(const __attribute__((address_space(3))) f32x4_t*)(ck_+32+8*g_); \
      _Pragma("unroll") for(int j_=0;j_<4;++j_){ float t0_=P0[4*g_+j_]-a_[j_]; asm volatile("":"+v"(t0_)); P0[4*g_+j_]=t0_; float t1_=P1[4*g_+j_]-b_[j_]; asm volatile("":"+v"(t1_)); P1[4*g_+j_]=t1_; } } }while(0)
  f32x16 pA0,pA1,pB0,pB1;
  int sl_prev=0,sl_cur=0,sl_next=SLOTB;
  #define ROT() do{sl_prev=sl_cur;sl_cur=sl_next;sl_next=(sl_next==(NSLOT-1)*SLOTB)?0:sl_next+SLOTB;}while(0)
  DMA_K(2,2*SLOTB);
  WAIT_BAR(3);
  qkt(pA0,pA1,Kbase,qr,negm,r32,hi);asm volatile("s_nop 15\n\ts_nop 7":"+v"(pA0),"+v"(pA1));BIAS(pA0,pA1,0);CMASK(pA0,pA1,0);
  START(pA0,pA1);
  _Pragma("unroll") for(int r=0;r<16;++r)pA1[r]=__builtin_amdgcn_exp2f(pA1[r]);
  WAIT_BAR(0);
  DMA_K(3,0);DMA_V(1,SLOTB);
  ROT();
  kload8(kf,kp0+sl_cur);
  WAIT_BAR(2);
  s16x4 vlo[8],vhi[8]; u32x4 pw0,pw1,pw2,pw3;
  #define PKW(P,B) cvtpk_s(P[B],P[B+1])
  #define PAF(k) __builtin_bit_cast(bf16x8,pw##k)
  #define VFR(i) (bf16x8){vlo[i][0],vlo[i][1],vlo[i][2],vlo[i][3],vhi[i][0],vhi[i][1],vhi[i][2],vhi[i][3]}
  #define PIN(x) asm volatile("":"+v"(x))
  #define MX3(a,b,c) __builtin_fmaxf(__builtin_fmaxf((a),(b)),(c))
  #define GAPA(MF,A0,A1,A2,A3,W0,W1,PW) do{ MF; sacc+=A0; sacc+=A1; sacc+=A2; sacc+=A3; PIN(sacc); W0; W1; PIN(PW); SBAR(); }while(0)
  #define EX(v) __builtin_amdgcn_exp2f(v)
  #define GAPB(MF,X,B) do{ MF; X[B]=EX(X[B]); X[B+1]=EX(X[B+1]); X[B+2]=EX(X[B+2]); X[B+3]=EX(X[B+3]); PIN(X); SBAR(); }while(0)
  #define VRD(i) do{ vlo[i]=vtr(vp_+(((i)>>2)*4096+((i)&3)*1024)); vhi[i]=vtr(vp_+(((i)>>2)*4096+((i)&3)*1024+512)); }while(0)
  #define KRD(G,j) do{ if(G){ kload2(kf,kp0+sl_next,j); SBAR(); } }while(0)
  #define STEP(C0,C1,P0,P1,t,GK,GV,GL) do{ SBAR(); \
    const lds_cptr vp_=vp0+sl_prev; \
    VRD(0); SBAR(); float sacc=(P0[0]+P0[1]); \
    GAPA(C0=__builtin_amdgcn_mfma_f32_32x32x16_bf16(kf[0],qr[0],negm,0,0,0), P0[2],P0[3],P0[4],P0[5],     pw0[0]=PKW(P0,0), pw0[1]=PKW(P0,2), pw0); \
    VRD(4); SBAR(); GAPA(C1=__builtin_amdgcn_mfma_f32_32x32x16_bf16(kf[1],qr[0],negm,0,0,0), P0[6],P0[7],P0[8],P0[9],     pw0[2]=PKW(P0,4), pw0[3]=PKW(P0,6), pw0); \
    VRD(1); SBAR(); GAPA(C0=__builtin_amdgcn_mfma_f32_32x32x16_bf16(kf[2],qr[1],C0,0,0,0),   P0[10],P0[11],P0[12],P0[13], pw1[0]=PKW(P0,8), pw1[1]=PKW(P0,10), pw1); \
    VRD(5); SBAR(); GAPA(C1=__builtin_amdgcn_mfma_f32_32x32x16_bf16(kf[3],qr[1],C1,0,0,0),   P0[14],P0[15],P1[0],P1[1],   pw1[2]=PKW(P0,12),pw1[3]=PKW(P0,14), pw1); \
    VRD(2); SBAR(); GAPA(C0=__builtin_amdgcn_mfma_f32_32x32x16_bf16(kf[4],qr[2],C0,0,0,0),   P1[2],P1[3],P1[4],P1[5],     pw2[0]=PKW(P1,0), pw2[1]=PKW(P1,2), pw2); \
    VRD(6); SBAR(); GAPA(C1=__builtin_amdgcn_mfma_f32_32x32x16_bf16(kf[5],qr[2],C1,0,0,0),   P1[6],P1[7],P1[8],P1[9],     pw2[2]=PKW(P1,4), pw2[3]=PKW(P1,6), pw2); \
    VRD(3); SBAR(); GAPA(C0=__builtin_amdgcn_mfma_f32_32x32x16_bf16(kf[6],qr[3],C0,0,0,0),   P1[10],P1[11],P1[12],P1[13], pw3[0]=PKW(P1,8), pw3[1]=PKW(P1,10), pw3); \
    VRD(7); SBAR(); GAPA(C1=__builtin_amdgcn_mfma_f32_32x32x16_bf16(kf[7],qr[3],C1,0,0,0),   P1[14],P1[15],0.f,0.f,       pw3[2]=PKW(P1,12),pw3[3]=PKW(P1,14), pw3); \
    l_reg+=sacc; \
    if(GK){DMA_K((t)+3,sl_cur);} if(GV){DMA_V((t)+1,sl_next);} \
    BIAS(C0,C1,t); CMASK(C0,C1,t); \
    { float a=MX3(C0[0],C0[1],C1[0]),b=MX3(C0[2],C0[3],C1[1]); a=MX3(a,C1[2],C1[3]); \
      _Pragma("unroll") for(int r=4;r<16;r+=4){a=MX3(a,C0[r],C0[r+1]);b=MX3(b,C0[r+2],C0[r+3]);a=MX3(a,C1[r],C1[r+1]);b=MX3(b,C1[r+2],C1[r+3]);} \
      float rm=__builtin_fmaxf(a,b); { auto rr=__builtin_amdgcn_permlane32_swap(__float_as_uint(rm),__float_as_uint(rm),false,false); rm=__builtin_fmaxf(__uint_as_float(rr[0]),__uint_as_float(rr[1])); } \
      resc=false; \
      if(__builtin_expect(__any(rm>(float)THRL),0)){ const float dl=__builtin_fmaxf(rm,0.f); mhat+=dl; \
        _Pragma("unroll") for(int r=0;r<16;++r){C0[r]-=dl;C1[r]-=dl;} \
        _Pragma("unroll") for(int r=0;r<16;++r)negm[r]=-mhat; asm volatile("":"+v"(negm)); \
        const float f=__builtin_amdgcn_exp2f(-dl); l_reg*=f; if(hi==0)wsf[r32]=f; resc=true; } } \
    SBAR(); \
    GAPB(o[0]=__builtin_amdgcn_mfma_f32_32x32x16_bf16(PAF(0),VFR(0),o[0],0,0,0), C0,0); \
    GAPB(o[1]=__builtin_amdgcn_mfma_f32_32x32x16_bf16(PAF(0),VFR(4),o[1],0,0,0), C0,4); \
    KRD(GL,0); GAPB(o[0]=__builtin_amdgcn_mfma_f32_32x32x16_bf16(PAF(1),VFR(1),o[0],0,0,0), C0,8); \
    KRD(GL,1); GAPB(o[1]=__builtin_amdgcn_mfma_f32_32x32x16_bf16(PAF(1),VFR(5),o[1],0,0,0), C0,12); \
    KRD(GL,2); GAPB(o[0]=__builtin_amdgcn_mfma_f32_32x32x16_bf16(PAF(2),VFR(2),o[0],0,0,0), C1,0); \
    KRD(GL,3); GAPB(o[1]=__builtin_amdgcn_mfma_f32_32x32x16_bf16(PAF(2),VFR(6),o[1],0,0,0), C1,4); \
    GAPB(o[0]=__builtin_amdgcn_mfma_f32_32x32x16_bf16(PAF(3),VFR(3),o[0],0,0,0), C1,8); \
    GAPB(o[1]=__builtin_amdgcn_mfma_f32_32x32x16_bf16(PAF(3),VFR(7),o[1],0,0,0), C1,12); \
    }while(0)
  int t=1;
  #undef CMASK
  #define CMASK(P0,P1,t) do{}while(0)
  for(;t+5<NT;t+=2){
    STEP(pB0,pB1,pA0,pA1,t,true,true,true);     WAIT_BAR(2); RESC(); ROT();
    STEP(pA0,pA1,pB0,pB1,t+1,true,true,true);   WAIT_BAR(2); RESC(); ROT();
  }
  #undef CMASK
  #define CMASK(P0,P1,t) do{int jb_=(t)-(NT-4); if(jb_>=0)cmask(P0,P1,jb_,qrel,hi);}while(0)
  #define ENDW(tt) do{ if((tt)+3<NT){WAIT_BAR(2);} else if((tt)+2<NT){WAIT_BAR(1);} else {WAIT_BAR(0);} }while(0)
  for(;t+1<NT;t+=2){
    STEP(pB0,pB1,pA0,pA1,t,(t+3<NT),(t+1<NT),(t+1<NT));       ENDW(t);   RESC(); ROT();
    STEP(pA0,pA1,pB0,pB1,t+1,(t+4<NT),(t+2<NT),(t+2<NT));     ENDW(t+1); RESC(); ROT();
  }
  STEP(pB0,pB1,pA0,pA1,NT-1,false,false,false); RESC();
  { float sacc=pB0[0]+pB0[1]; _Pragma("unroll") for(int r=2;r<16;++r)sacc+=pB0[r]; _Pragma("unroll") for(int r=0;r<16;++r)sacc+=pB1[r]; l_reg+=sacc;
    pw0=(u32x4){PKW(pB0,0),PKW(pB0,2),PKW(pB0,4),PKW(pB0,6)};pw1=(u32x4){PKW(pB0,8),PKW(pB0,10),PKW(pB0,12),PKW(pB0,14)};pw2=(u32x4){PKW(pB1,0),PKW(pB1,2),PKW(pB1,4),PKW(pB1,6)};pw3=(u32x4){PKW(pB1,8),PKW(pB1,10),PKW(pB1,12),PKW(pB1,14)};
    SBAR(); pv(o,vb0+sl_cur,PAF(0),PAF(1),PAF(2),PAF(3)); }
  #undef PKW
  #undef PAF
  #undef VFR
  #undef PIN
  #undef MX3
  #undef GAPA
  #undef GAPB
  #undef EX
  #undef VRD
  #undef KRD
  #undef STEP
  #undef ENDW
  {auto rr=__builtin_amdgcn_permlane32_swap(__float_as_uint(l_reg),__float_as_uint(l_reg),false,false);l_reg=__uint_as_float(rr[0])+__uint_as_float(rr[1]);}
  if(hi==0)wsf[32+r32]=l_reg;asm volatile("s_waitcnt lgkmcnt(0)":::"memory");
  float rli[16];
  #pragma unroll
  for(int r=0;r<16;++r)rli[r]=__builtin_amdgcn_rcpf(wsf[32+crow(r,hi)]);
  bf16*Ow=O+(rowbase+q0+wid*QBLK)*ODM+h*D;
  { bf16*stg=(bf16*)(shm+LDS_OST)+wid*2048;
    #pragma unroll
    for(int r=0;r<16;++r){const int orow=crow(r,hi);
      #pragma unroll
      for(int d0=0;d0<2;++d0)stg[orow*64+d0*32+r32]=__float2bfloat16(o[d0][r]*rli[r]);}
    asm volatile("s_waitcnt lgkmcnt(0)":::"memory");
    #pragma unroll
    for(int i=0;i<4;++i){const int row=i*8+(lane>>3),ch=lane&7; const u32x4 v=*(const u32x4*)(stg+row*64+ch*8); ATTN_STORE16(Ow+(long)row*ODM+ch*8,v);} }
  asm volatile("s_waitcnt lgkmcnt(0)\n\ts_barrier":::"memory");
  #undef DMA_K
  #undef DMA_V
  #undef CMASK
  #undef START
  #undef RESC
  #undef ROT
  #undef BIAS
}
constexpr int ATTN_LDS_BYTES=LDS_BYTES;
#undef SBAR
#undef WAIT_BAR
}

#define LAS __attribute__((address_space(3)))
typedef unsigned short bfr;
typedef float f32x4v __attribute__((ext_vector_type(4)));
typedef unsigned u32x4v __attribute__((ext_vector_type(4)));
typedef unsigned u32x2v __attribute__((ext_vector_type(2)));
typedef short bf16x8v __attribute__((ext_vector_type(8)));

constexpr int NB = 4, SEQ = 8192, DMODEL = 1024, DEPTH = 4, MROWS = NB * SEQ;
constexpr int NPROJ = 3072, DIN = 2966, DFF = 2816, NGU = 5632, NMOD = 6144, DMIX = 1024;
constexpr int C_LX = 0, C_LG = 384, C_FQ = 768, C_FK = 1152, C_FV = 1536, C_GQ = 1920, C_GK = 2176, C_GV = 2432, C_GG = 2688, C_GL = 2944, C_FF = 2960;
constexpr float EPS = 1e-6f, LOG2E = 1.4426950408889634f;

constexpr size_t MiB = 1u << 20;
constexpr size_t WS_CTL = 0, CTL_BYTES = 65536;
constexpr int CW_BAR = 1024;
constexpr size_t WS_MOD = 1 * MiB;
constexpr size_t WS_CUM = 2 * MiB;
constexpr size_t WS_DEC = 3 * MiB;
constexpr size_t WS_SUMA = 4 * MiB, WS_SUMH = 5 * MiB;
constexpr size_t WS_LRUW = 6 * MiB;
constexpr size_t WS_WIN = 8 * MiB, WS_WOUT = 32 * MiB, WS_WGU = 40 * MiB, WS_WDN = 84 * MiB;
constexpr size_t WIN_L = (size_t)NPROJ * 1024 * 2, WOUT_L = (size_t)1024 * 1024 * 2, WGU_L = (size_t)NGU * 1024 * 2, WDN_L = (size_t)1024 * DFF * 2;
constexpr size_t WS_PROJ = 106 * MiB;
constexpr size_t WS_MIX = 298 * MiB;
constexpr size_t WS_HN = 362 * MiB;
constexpr size_t WS_HL = 362 * MiB, WS_ACUM = 386 * MiB, WS_QDEC = 410 * MiB;
constexpr size_t WS_OINTRA = 426 * MiB;
constexpr size_t WS_KV = 442 * MiB;
constexpr size_t WS_ST = 474 * MiB;
constexpr size_t WS_END = 490 * MiB;
static_assert(WS_WDN + 4 * WDN_L <= WS_PROJ && WS_WGU + 4 * WGU_L <= WS_WDN && WS_WIN + 4 * WIN_L <= WS_WOUT && WS_WOUT + 4 * WOUT_L <= WS_WGU, "ws map");

constexpr int RING_BYTES = 131072, MISC_OFF = RING_BYTES, LDS_BYTES = 147456;
static_assert(attn_body::ATTN_LDS_BYTES <= RING_BYTES, "attention LDS");

__device__ __forceinline__ float bf2f(bfr h) { return __uint_as_float((unsigned)h << 16); }
typedef float f32x2v_ __attribute__((ext_vector_type(2))); typedef __bf16 bf16x2v_ __attribute__((ext_vector_type(2)));
__device__ __forceinline__ unsigned pk2(float lo, float hi) { f32x2v_ v = {lo, hi}; bf16x2v_ b = __builtin_convertvector(v, bf16x2v_); return __builtin_bit_cast(unsigned, b); }
__device__ __forceinline__ bfr f2bf(float f) { return (bfr)(pk2(f, f) & 0xffffu); }
__device__ __forceinline__ float wave_sum(float v) {
#pragma unroll
    for (int o = 1; o < 64; o <<= 1) v += __shfl_xor(v, o);
    return v;
}
__device__ __forceinline__ float sigmoidf_(float x) { return __builtin_amdgcn_rcpf(1.0f + __expf(-x)); }
__device__ __forceinline__ float log_sigmoid_(float z) { return fminf(z, 0.f) - __logf(1.0f + __expf(-fabsf(z))); }
__device__ __forceinline__ float gelu_tanh_(float y) { const float z = 0.7978845608028654f * (y + 0.044715f * y * y * y); const float t = 1.0f - 2.0f * __builtin_amdgcn_rcpf(__expf(2.0f * z) + 1.0f); return 0.5f * y * (1.0f + t); }
__device__ __forceinline__ float silu_(float g) { return g * __builtin_amdgcn_rcpf(1.0f + __expf(-g)); }

struct Params { const float* in[23]; float* out; unsigned char* ws; };

__device__ __forceinline__ int map_in(int n) {
    if (n >= 768 && n < 1536) {
        const int c = n & 255, s_ = (c & 127) >> 5, d = (c & 31) + 32 * (c >> 7), H = 4 * ((n >> 8) - 3) + s_;
        return 768 + H * 64 + d; }
    if (n < 1920) return n;
    if (n < 2688) return n + 6;
    if (n < 2944) return n - 2688 + 2710;
    if (n < 2960) return n - 2944 + 2694;
    if (n < 2966) return n - 2960 + 1920;
    return -1;
}
__device__ __forceinline__ int map_gu(int n) { const int pn = n >> 8, r = n & 255; return r < 128 ? pn * 128 + r : DFF + pn * 128 + (r - 128); }
template <int MODE> __device__ __forceinline__ void transpose_item(const float* __restrict__ W, int K, int N, int NP, bfr* __restrict__ WT, LAS float* scr, int item, int lane) {
    const int nblk = NP / 32, kb = item / nblk, nb = item % nblk, k0 = 64 * kb, n0 = 32 * nb;
    const int nme = n0 + (lane & 31);
    const int nsrc = MODE == 0 ? nme : (MODE == 1 ? map_in(nme) : map_gu(nme));
#pragma unroll 8
    for (int i = 0; i < 32; ++i) { const int kk = 2 * i + (lane >> 5); scr[kk * 33 + (lane & 31)] = nsrc >= 0 ? W[(size_t)(k0 + kk) * N + nsrc] : 0.f; }
    asm volatile("s_waitcnt lgkmcnt(0)" ::: "memory");
    const int c = lane & 7;
#pragma unroll
    for (int j = 0; j < 4; ++j) { const int n = (lane >> 3) + 8 * j; const LAS float* s = scr + (8 * c) * 33 + n;
        u32x4v o; o.x = pk2(s[0 * 33], s[1 * 33]); o.y = pk2(s[2 * 33], s[3 * 33]); o.z = pk2(s[4 * 33], s[5 * 33]); o.w = pk2(s[6 * 33], s[7 * 33]);
        *(u32x4v*)(WT + (size_t)(n0 + n) * K + k0 + 8 * c) = o; }
    asm volatile("s_waitcnt lgkmcnt(0)" ::: "memory");
}
__device__ __forceinline__ void p0_prologue(const Params& P, LAS unsigned char* lds, int tid, int lane, int wid, int G) {
    asm volatile("" : "+v"(tid), "+v"(lane), "+s"(wid));
    unsigned char* ws = P.ws;
    {
        LAS float* CA = (LAS float*)lds;
        LAS float* RED = (LAS float*)(lds + 16384);
        const float* c = P.in[1];
        for (int i = tid; i < NB * DMODEL; i += 512) CA[i] = silu_(c[i]);
        __syncthreads();
        const int kp = tid >> 5, col = tid & 31;
        float* MOD = (float*)(ws + WS_MOD);
        for (int it = blockIdx.x; it < DEPTH * (NMOD / 32); it += G) {
            const int l = it / (NMOD / 32), c0 = (it % (NMOD / 32)) * 32;
            const float* w = P.in[4] + ((size_t)l * DMODEL + kp * 64) * NMOD + c0 + col;
            float a0 = 0.f, a1 = 0.f, a2 = 0.f, a3 = 0.f;
#pragma unroll 8
            for (int k = 0; k < 64; ++k) { const float wv = w[(size_t)k * NMOD]; const int kk = kp * 64 + k;
                a0 += CA[kk] * wv; a1 += CA[1024 + kk] * wv; a2 += CA[2048 + kk] * wv; a3 += CA[3072 + kk] * wv; }
            RED[(kp * 4 + 0) * 32 + col] = a0; RED[(kp * 4 + 1) * 32 + col] = a1; RED[(kp * 4 + 2) * 32 + col] = a2; RED[(kp * 4 + 3) * 32 + col] = a3;
            __syncthreads();
            if (tid < 128) { const int b = tid >> 5; float s = P.in[5][(size_t)l * NMOD + c0 + col];
#pragma unroll
                for (int q = 0; q < 16; ++q) s += RED[(q * 4 + b) * 32 + col];
                MOD[((size_t)l * NB + b) * NMOD + c0 + col] = s; }
            __syncthreads();
        }
    }
    __syncthreads();
    {
        bfr* LW = (bfr*)(ws + WS_LRUW);
        for (int i = blockIdx.x * 512 + tid; i < DEPTH * 6 * 2 * 4096; i += G * 512) {
            const int d = i & 63, e = (i >> 6) & 63, mat = (i >> 12) & 1, ln = i >> 13;
            const float* src = mat ? P.in[11] : P.in[9];
            LW[i] = f2bf(src[(size_t)ln * 4096 + d * 64 + e]);
        }
    }
    {
        LAS float* scr = (LAS float*)(lds + wid * 16384);
        const int gw = blockIdx.x * 8 + wid, NGW = G * 8;
        constexpr int I_IN = 16 * (NPROJ / 32), I_OUT = 16 * 32, I_GU = 16 * (NGU / 32), I_DN = (DFF / 64) * 32, I_L = I_IN + I_OUT + I_GU + I_DN;
        for (int it = gw; it < DEPTH * I_L; it += NGW) {
            const int l = it / I_L; int r = it % I_L;
            if (r < I_IN) { transpose_item<1>(P.in[6] + (size_t)l * DMODEL * DIN, DMODEL, DIN, NPROJ, (bfr*)(ws + WS_WIN + l * WIN_L), scr, r, lane); continue; } r -= I_IN;
            if (r < I_OUT) { transpose_item<0>(P.in[20] + (size_t)l * DMIX * DMODEL, DMIX, DMODEL, DMODEL, (bfr*)(ws + WS_WOUT + l * WOUT_L), scr, r, lane); continue; } r -= I_OUT;
            if (r < I_GU) { transpose_item<2>(P.in[21] + (size_t)l * DMODEL * NGU, DMODEL, NGU, NGU, (bfr*)(ws + WS_WGU + l * WGU_L), scr, r, lane); continue; } r -= I_GU;
            transpose_item<0>(P.in[22] + (size_t)l * DFF * DMODEL, DFF, DMODEL, DMODEL, (bfr*)(ws + WS_WDN + l * WDN_L), scr, r, lane);
        }
    }
}

__device__ __forceinline__ void norm_phase(const float* __restrict__ x, const bfr* __restrict__ x16, const float* __restrict__ gain, const float* __restrict__ modl, int shift_off, int scale_off, bfr* __restrict__ HN, int gw, int NGW, int lane) {
    asm volatile("" : "+v"(lane), "+s"(gw));
    const bool xloc = (NGW % 64) == 0;
    const int xq = xloc ? (gw >> 3) & 7 : 0, wloc = xloc ? ((gw >> 6) << 3) + (gw & 7) : gw, nwl = xloc ? NGW / 8 : NGW, rbase = xq * (MROWS / 8), rcnt = xloc ? MROWS / 8 : MROWS;
#pragma unroll 4
    for (int r = wloc; r < rcnt; r += nwl) {
        const int m = rbase + r;
        f32x4v v[4]; float s = 0.f;
        if (x16) {
            const u32x2v* xr = (const u32x2v*)(x16 + (size_t)m * DMODEL) + lane;
#pragma unroll
            for (int j = 0; j < 4; ++j) { const u32x2v w = xr[64 * j]; const pg8::f32x2 a = pg8::h2f(w.x), b = pg8::h2f(w.y); v[j] = (f32x4v){a.x, a.y, b.x, b.y}; }
        } else {
            const f32x4v* xr = (const f32x4v*)(x + (size_t)m * DMODEL) + lane;
#pragma unroll
            for (int j = 0; j < 4; ++j) v[j] = xr[64 * j];
        }
#pragma unroll
        for (int j = 0; j < 4; ++j) s += (v[j].x * v[j].x + v[j].y * v[j].y) + (v[j].z * v[j].z + v[j].w * v[j].w);
        const float rstd = 1.0f / sqrtf(wave_sum(s) * (1.0f / DMODEL) + EPS);
        const float* mb = modl + (size_t)(m / SEQ) * NMOD;
        u32x2v* o8 = (u32x2v*)(HN + (size_t)m * DMODEL) + lane;
#pragma unroll
        for (int j = 0; j < 4; ++j) { const int col = 4 * lane + 256 * j;
            const f32x4v g = *(const f32x4v*)(gain + col), sc = *(const f32x4v*)(mb + scale_off + col), sh = *(const f32x4v*)(mb + shift_off + col);
            const f32x4v h = v[j] * rstd * g * (sc + 1.0f) + sh;
            u32x2v w; w.x = pk2(h.x, h.y); w.y = pk2(h.z, h.w); o8[64 * j] = w; }
    }
}

struct LayerPtrs {
    const float *conv_w, *conv_b, *b_r, *b_i, *lam, *fox_bf, *qgain, *kgain, *w_alpha, *b_alpha, *ogain;
    const bfr* lruw;
};

constexpr int LRU_LC = 128, LRU_NCH = SEQ / LRU_LC;
__device__ __forceinline__ void lru_local_item(int idx, const LayerPtrs& L, unsigned char* ws, LAS unsigned char* lds, int tid, int lane, int wid) {
    asm volatile("" : "+v"(tid), "+v"(lane), "+s"(wid));
    const int n = idx % 6, c = (idx / 6) % LRU_NCH, b = idx / (6 * LRU_NCH);
    const int ch = tid & 63, tg = wid;
    const bfr* PROJ = (const bfr*)(ws + WS_PROJ);
    LAS bfr* XA = (LAS bfr*)lds;
    LAS float* RI = (LAS float*)(lds + 18432);
    LAS float* SEG = (LAS float*)(lds + 18432 + 65536);
    const int cg_ = n * 64 + ch;
    const int mat = wid >> 2, fr = lane & 15, fq = lane >> 4;
    const bfr* wt = L.lruw + (size_t)(n * 2 + mat) * 4096;
    bf16x8v bfrag[4][2];
#pragma unroll
    for (int te = 0; te < 4; ++te) { bfrag[te][0] = *(const bf16x8v*)(wt + (16 * te + fr) * 64 + 8 * fq); bfrag[te][1] = *(const bf16x8v*)(wt + (16 * te + fr) * 64 + 32 + 8 * fq); }
    const float lam = L.lam[cg_], br = L.b_r[cg_], bi = L.b_i[cg_];
    float xa[16];
    {
        float raw[19];
        unsigned rawu[19];
#pragma unroll
        for (int j = 0; j < 19; ++j) { const int tt = c * LRU_LC + 16 * tg - 3 + j; rawu[j] = PROJ[((size_t)b * SEQ + (tt < 0 ? 0 : tt)) * NPROJ + C_LX + cg_]; }
        asm volatile("" :: "v"(rawu[0]), "v"(rawu[1]), "v"(rawu[2]), "v"(rawu[3]), "v"(rawu[4]), "v"(rawu[5]), "v"(rawu[6]), "v"(rawu[7]), "v"(rawu[8]), "v"(rawu[9]), "v"(rawu[10]), "v"(rawu[11]), "v"(rawu[12]), "v"(rawu[13]), "v"(rawu[14]), "v"(rawu[15]), "v"(rawu[16]), "v"(rawu[17]), "v"(rawu[18]) : "memory");
#pragma unroll
        for (int j = 0; j < 19; ++j) { const int tt = c * LRU_LC + 16 * tg - 3 + j; raw[j] = tt >= 0 ? bf2f((bfr)rawu[j]) : 0.f; }
        const float w0 = L.conv_w[cg_], w1 = L.conv_w[384 + cg_], w2 = L.conv_w[768 + cg_], w3 = L.conv_w[1152 + cg_], cb = L.conv_b[cg_];
#pragma unroll
        for (int i = 0; i < 16; ++i) { xa[i] = cb + w0 * raw[i] + w1 * raw[i + 1] + w2 * raw[i + 2] + w3 * raw[i + 3]; XA[(16 * tg + i) * 72 + ch] = f2bf(xa[i]); }
    }
    __syncthreads();
    {
#pragma unroll
        for (int q = 0; q < 2; ++q) {
            const int tr = 2 * (wid & 3) + q;
            const bf16x8v a0 = *(const LAS bf16x8v*)(XA + (16 * tr + fr) * 72 + 8 * fq), a1 = *(const LAS bf16x8v*)(XA + (16 * tr + fr) * 72 + 32 + 8 * fq);
#pragma unroll
            for (int te = 0; te < 4; ++te) {
                f32x4v acc = {0.f, 0.f, 0.f, 0.f};
                acc = __builtin_amdgcn_mfma_f32_16x16x32_bf16(a0, bfrag[te][0], acc, 0, 0, 0);
                acc = __builtin_amdgcn_mfma_f32_16x16x32_bf16(a1, bfrag[te][1], acc, 0, 0, 0);
#pragma unroll
                for (int r = 0; r < 4; ++r) RI[(mat * LRU_LC + 16 * tr + 4 * fq + r) * 64 + 16 * te + fr] = acc[r];
            }
        }
    }
    __syncthreads();
    float hs[16], ps[16];
    {
        const float e_ = __expf(-fabsf(lam));
        const float sp = fmaxf(-lam, 0.f) + (e_ < 0.03125f ? e_ * (1.0f - e_ * (0.5f - e_ * (0.33333334f - 0.25f * e_))) : __logf(1.0f + e_));
        float h = 0.f, p = 1.f;
#pragma unroll
        for (int i = 0; i < 16; ++i) {
            const float r = sigmoidf_(RI[(16 * tg + i) * 64 + ch] + br), ig = sigmoidf_(RI[(LRU_LC + 16 * tg + i) * 64 + ch] + bi);
            const float la = -8.0f * r * sp; const float a = __expf(la); const float mult = __builtin_amdgcn_sqrtf(fmaxf(1.0f - a * a, 0.f));
            h = a * h + mult * ig * xa[i]; p *= a; hs[i] = h; ps[i] = p;
        }
        SEG[(tg * 2 + 0) * 64 + ch] = p; SEG[(tg * 2 + 1) * 64 + ch] = h;
    }
    __syncthreads();
    {
        float carry = 0.f, pref = 1.f;
        for (int g = 0; g < tg; ++g) { const float pg = SEG[(g * 2) * 64 + ch], hg = SEG[(g * 2 + 1) * 64 + ch]; carry = pg * carry + hg; pref *= pg; }
        bfr* HL = (bfr*)(ws + WS_HL); bfr* AC = (bfr*)(ws + WS_ACUM);
        const size_t m0 = (size_t)b * SEQ + c * LRU_LC + 16 * tg;
        float hl = 0.f, ac = 0.f;
#pragma unroll
        for (int i = 0; i < 16; ++i) { hl = hs[i] + ps[i] * carry; ac = ps[i] * pref; HL[(m0 + i) * 384 + cg_] = f2bf(hl); AC[(m0 + i) * 384 + cg_] = f2bf(ac); }
        if (tg == 7) { ((float*)(ws + WS_SUMA))[((size_t)b * LRU_NCH + c) * 384 + cg_] = ac; ((float*)(ws + WS_SUMH))[((size_t)b * LRU_NCH + c) * 384 + cg_] = hl; }
    }
    __syncthreads();
}
__device__ __forceinline__ void knorm_item(int idx, const LayerPtrs& L, unsigned char* ws, int tid) {
    asm volatile("" : "+v"(tid));
    bfr* PROJ = (bfr*)(ws + WS_PROJ);
    const int part = tid & 7, hr = tid >> 3;
    const f32x4v g0 = *(const f32x4v*)(L.kgain + part * 8), g1 = *(const f32x4v*)(L.kgain + part * 8 + 4);
#pragma unroll
    for (int p = 0; p < 6; ++p) {
        const int R = p * 64 + hr, tok = R / 6, head = R % 6;
        u32x4v* ptr = (u32x4v*)(PROJ + ((size_t)idx * 64 + tok) * NPROJ + C_FK + head * 64 + part * 8);
        const u32x4v w = *ptr;
        float f[8];
        f[0] = __uint_as_float(w.x << 16); f[1] = __uint_as_float(w.x & 0xffff0000u); f[2] = __uint_as_float(w.y << 16); f[3] = __uint_as_float(w.y & 0xffff0000u);
        f[4] = __uint_as_float(w.z << 16); f[5] = __uint_as_float(w.z & 0xffff0000u); f[6] = __uint_as_float(w.w << 16); f[7] = __uint_as_float(w.w & 0xffff0000u);
        float ss = 0.f;
#pragma unroll
        for (int j = 0; j < 8; ++j) ss += f[j] * f[j];
        ss += __shfl_xor(ss, 1); ss += __shfl_xor(ss, 2); ss += __shfl_xor(ss, 4);
        const float rs = 1.0f / sqrtf(ss * (1.0f / 64.0f) + EPS);
        u32x4v o; o.x = pk2(f[0] * rs * g0.x, f[1] * rs * g0.y); o.y = pk2(f[2] * rs * g0.z, f[3] * rs * g0.w); o.z = pk2(f[4] * rs * g1.x, f[5] * rs * g1.y); o.w = pk2(f[6] * rs * g1.z, f[7] * rs * g1.w);
        *ptr = o;
    }
}
__device__ __forceinline__ void cum_item(int idx, const LayerPtrs& L, unsigned char* ws, LAS unsigned char* lds, int tid, int lane, int wid) {
    asm volatile("" : "+v"(tid), "+v"(lane), "+s"(wid));
    const int b = idx / 6, h = idx % 6;
    const bfr* PROJ = (const bfr*)(ws + WS_PROJ);
    LAS float* WT = (LAS float*)lds;
    const float bf = L.fox_bf[h];
    float loc[16]; float run = 0.f; unsigned fr_[16];
#pragma unroll
    for (int i = 0; i < 16; ++i) fr_[i] = PROJ[((size_t)b * SEQ + 16 * tid + i) * NPROJ + C_FF + h];
    asm volatile("" :: "v"(fr_[0]), "v"(fr_[1]), "v"(fr_[2]), "v"(fr_[3]), "v"(fr_[4]), "v"(fr_[5]), "v"(fr_[6]), "v"(fr_[7]), "v"(fr_[8]), "v"(fr_[9]), "v"(fr_[10]), "v"(fr_[11]), "v"(fr_[12]), "v"(fr_[13]), "v"(fr_[14]), "v"(fr_[15]) : "memory");
#pragma unroll
    for (int i = 0; i < 16; ++i) { const float z = bf2f((bfr)fr_[i]) + bf; run += log_sigmoid_(z); loc[i] = run; }
    float inc = run;
#pragma unroll
    for (int o = 1; o < 64; o <<= 1) { const float t = __shfl_up(inc, o); if (lane >= o) inc += t; }
    if (lane == 63) WT[wid] = inc;
    __syncthreads();
    float base = inc - run;
    for (int w = 0; w < wid; ++w) base += WT[w];
    float* CUM = (float*)(ws + WS_CUM) + ((size_t)b * 6 + h) * SEQ + 16 * tid;
#pragma unroll
    for (int i = 0; i < 16; i += 4) *(f32x4v*)(CUM + i) = (f32x4v){loc[i] + base, loc[i + 1] + base, loc[i + 2] + base, loc[i + 3] + base};
    __syncthreads();
}
__device__ __forceinline__ void gla_local_item(int idx, const LayerPtrs& L, unsigned char* ws, LAS unsigned char* lds, int tid, int lane, int wid) {
    asm volatile("" : "+v"(tid), "+v"(lane), "+s"(wid));
    const int bh = idx >> 6, np = idx & 63, b = bh >> 2, h = bh & 3;
    const int d = tid & 63, tg = wid, fr = lane & 15, fq = lane >> 4;
    const bfr* PROJ = (const bfr*)(ws + WS_PROJ);
    constexpr int CCB = 49152;
    float qf[2][8], kf[2][8]; bfr vb[2][8];
#pragma unroll
    for (int cc = 0; cc < 2; ++cc) {
        unsigned qr_[8], kr_[8], vr_[8];
#pragma unroll
        for (int i = 0; i < 8; ++i) { const size_t m = (size_t)b * SEQ + (2 * np + cc) * 64 + 8 * tg + i;
            qr_[i] = PROJ[m * NPROJ + C_GQ + h * 64 + d]; kr_[i] = PROJ[m * NPROJ + C_GK + h * 64 + d]; vr_[i] = PROJ[m * NPROJ + C_GV + h * 64 + d]; }
        asm volatile("" :: "v"(qr_[0]), "v"(kr_[0]), "v"(vr_[0]), "v"(qr_[1]), "v"(kr_[1]), "v"(vr_[1]), "v"(qr_[2]), "v"(kr_[2]), "v"(vr_[2]), "v"(qr_[3]), "v"(kr_[3]), "v"(vr_[3]), "v"(qr_[4]), "v"(kr_[4]), "v"(vr_[4]), "v"(qr_[5]), "v"(kr_[5]), "v"(vr_[5]), "v"(qr_[6]), "v"(kr_[6]), "v"(vr_[6]), "v"(qr_[7]), "v"(kr_[7]), "v"(vr_[7]) : "memory");
#pragma unroll
        for (int i = 0; i < 8; ++i) { qf[cc][i] = bf2f((bfr)qr_[i]); kf[cc][i] = bf2f((bfr)kr_[i]); vb[cc][i] = (bfr)vr_[i]; }
    }
    float bc[2][8];
    {
        float wal[16];
#pragma unroll
        for (int r = 0; r < 16; ++r) wal[r] = L.w_alpha[r * 256 + h * 64 + d];
        const float bal = L.b_alpha[h * 64 + d];
#pragma unroll
        for (int cc = 0; cc < 2; ++cc) {
            LAS float* SEGB = (LAS float*)(lds + cc * CCB);
            const size_t m0 = (size_t)b * SEQ + (2 * np + cc) * 64;
            float run = 0.f;
            u32x4v l0a[8], l1a[8];
#pragma unroll
            for (int i = 0; i < 8; ++i) { const u32x4v* lp = (const u32x4v*)(PROJ + (m0 + 8 * tg + i) * NPROJ + C_GL); l0a[i] = lp[0]; l1a[i] = lp[1]; }
            asm volatile("" :: "v"(l0a[0]), "v"(l1a[0]), "v"(l0a[1]), "v"(l1a[1]), "v"(l0a[2]), "v"(l1a[2]), "v"(l0a[3]), "v"(l1a[3]), "v"(l0a[4]), "v"(l1a[4]), "v"(l0a[5]), "v"(l1a[5]), "v"(l0a[6]), "v"(l1a[6]), "v"(l0a[7]), "v"(l1a[7]) : "memory");
#pragma unroll
            for (int i = 0; i < 8; ++i) {
                const u32x4v l0 = l0a[i], l1 = l1a[i];
                float z = bal;
                z += __uint_as_float(l0.x << 16) * wal[0] + __uint_as_float(l0.x & 0xffff0000u) * wal[1] + __uint_as_float(l0.y << 16) * wal[2] + __uint_as_float(l0.y & 0xffff0000u) * wal[3];
                z += __uint_as_float(l0.z << 16) * wal[4] + __uint_as_float(l0.z & 0xffff0000u) * wal[5] + __uint_as_float(l0.w << 16) * wal[6] + __uint_as_float(l0.w & 0xffff0000u) * wal[7];
                z += __uint_as_float(l1.x << 16) * wal[8] + __uint_as_float(l1.x & 0xffff0000u) * wal[9] + __uint_as_float(l1.y << 16) * wal[10] + __uint_as_float(l1.y & 0xffff0000u) * wal[11];
                z += __uint_as_float(l1.z << 16) * wal[12] + __uint_as_float(l1.z & 0xffff0000u) * wal[13] + __uint_as_float(l1.w << 16) * wal[14] + __uint_as_float(l1.w & 0xffff0000u) * wal[15];
                run += log_sigmoid_(z) * (1.0f / 16.0f); bc[cc][i] = run;
            }
            SEGB[tg * 64 + d] = run;
        }
    }
    __syncthreads();
#pragma unroll
    for (int cc = 0; cc < 2; ++cc) {
        LAS float* SEGB = (LAS float*)(lds + cc * CCB);
        LAS bfr* QD = (LAS bfr*)(lds + cc * CCB + 2048); LAS bfr* KD = QD + 4608; LAS bfr* KTET = KD + 4608; LAS bfr* VT = KTET + 4608;
        const size_t m0 = (size_t)b * SEQ + (2 * np + cc) * 64;
        float off = 0.f, total = 0.f;
#pragma unroll
        for (int g = 0; g < 8; ++g) { const float sg = SEGB[g * 64 + d]; total += sg; if (g < tg) off += sg; }
        bfr* QDEC = (bfr*)(ws + WS_QDEC);
        unsigned kt[4], vv[4];
#pragma unroll
        for (int i = 0; i < 8; ++i) {
            const size_t m = m0 + 8 * tg + i; const float bcum = bc[cc][i] + off;
            const float q = qf[cc][i], k = kf[cc][i]; const bfr v = vb[cc][i];
            const bfr qd = f2bf(q * 0.125f * __expf(bcum)), kd = f2bf(k * __expf(-bcum)), kte = f2bf(k * __expf(total - bcum));
            QD[(8 * tg + i) * 72 + d] = qd; KD[(8 * tg + i) * 72 + d] = kd; QDEC[m * 256 + h * 64 + d] = qd;
            if (i & 1) { kt[i >> 1] |= (unsigned)kte << 16; vv[i >> 1] |= (unsigned)v << 16; } else { kt[i >> 1] = kte; vv[i >> 1] = v; }
        }
        *(LAS u32x4v*)(KTET + d * 72 + 8 * tg) = (u32x4v){kt[0], kt[1], kt[2], kt[3]};
        *(LAS u32x4v*)(VT + d * 72 + 8 * tg) = (u32x4v){vv[0], vv[1], vv[2], vv[3]};
        if (tg == 0) ((float*)(ws + WS_DEC))[((size_t)bh * 128 + 2 * np + cc) * 64 + d] = __expf(total);
    }
    __syncthreads();
#pragma unroll
    for (int cc = 0; cc < 2; ++cc) {
        LAS bfr* QD = (LAS bfr*)(lds + cc * CCB + 2048); LAS bfr* KD = QD + 4608; LAS bfr* ATT = QD + 4 * 4608;
        const int ti = wid & 3;
#pragma unroll
        for (int q = 0; q < 2; ++q) {
            const int tj = 2 * (wid >> 2) + q;
            f32x4v acc = {0.f, 0.f, 0.f, 0.f};
            if (tj <= ti) {
                const bf16x8v a0 = *(const LAS bf16x8v*)(QD + (16 * ti + fr) * 72 + 8 * fq), a1 = *(const LAS bf16x8v*)(QD + (16 * ti + fr) * 72 + 32 + 8 * fq);
                const bf16x8v b0 = *(const LAS bf16x8v*)(KD + (16 * tj + fr) * 72 + 8 * fq), b1 = *(const LAS bf16x8v*)(KD + (16 * tj + fr) * 72 + 32 + 8 * fq);
                acc = __builtin_amdgcn_mfma_f32_16x16x32_bf16(a0, b0, acc, 0, 0, 0);
                acc = __builtin_amdgcn_mfma_f32_16x16x32_bf16(a1, b1, acc, 0, 0, 0);
            }
#pragma unroll
            for (int r = 0; r < 4; ++r) { const int i = 16 * ti + 4 * fq + r, j = 16 * tj + fr; ATT[i * 72 + j] = f2bf(j <= i ? acc[r] : 0.f); }
        }
    }
    __syncthreads();
#pragma unroll
    for (int cc = 0; cc < 2; ++cc) {
        LAS bfr* QD = (LAS bfr*)(lds + cc * CCB + 2048); LAS bfr* KTET = QD + 2 * 4608; LAS bfr* VT = QD + 3 * 4608; LAS bfr* ATT = QD + 4 * 4608;
        const size_t m0 = (size_t)b * SEQ + (2 * np + cc) * 64;
        const int mat = wid >> 2, t4 = wid & 3;
        if (mat == 0) {
            bfr* OI = (bfr*)(ws + WS_OINTRA);
            const bf16x8v b0 = *(const LAS bf16x8v*)(ATT + (16 * t4 + fr) * 72 + 8 * fq), b1 = *(const LAS bf16x8v*)(ATT + (16 * t4 + fr) * 72 + 32 + 8 * fq);
#pragma unroll
            for (int tv = 0; tv < 4; ++tv) {
                const bf16x8v a0 = *(const LAS bf16x8v*)(VT + (16 * tv + fr) * 72 + 8 * fq), a1 = *(const LAS bf16x8v*)(VT + (16 * tv + fr) * 72 + 32 + 8 * fq);
                f32x4v acc = {0.f, 0.f, 0.f, 0.f};
                acc = __builtin_amdgcn_mfma_f32_16x16x32_bf16(a0, b0, acc, 0, 0, 0);
                acc = __builtin_amdgcn_mfma_f32_16x16x32_bf16(a1, b1, acc, 0, 0, 0);
                u32x2v w; w.x = pk2(acc[0], acc[1]); w.y = pk2(acc[2], acc[3]);
                *(u32x2v*)(OI + (m0 + 16 * t4 + fr) * 256 + h * 64 + 16 * tv + 4 * fq) = w;
            }
        } else {
            float* KV = (float*)(ws + WS_KV) + ((size_t)bh * 128 + 2 * np + cc) * 4096;
            const bf16x8v a0 = *(const LAS bf16x8v*)(KTET + (16 * t4 + fr) * 72 + 8 * fq), a1 = *(const LAS bf16x8v*)(KTET + (16 * t4 + fr) * 72 + 32 + 8 * fq);
#pragma unroll
            for (int tv = 0; tv < 4; ++tv) {
                const bf16x8v b0 = *(const LAS bf16x8v*)(VT + (16 * tv + fr) * 72 + 8 * fq), b1 = *(const LAS bf16x8v*)(VT + (16 * tv + fr) * 72 + 32 + 8 * fq);
                f32x4v acc = {0.f, 0.f, 0.f, 0.f};
                acc = __builtin_amdgcn_mfma_f32_16x16x32_bf16(a0, b0, acc, 0, 0, 0);
                acc = __builtin_amdgcn_mfma_f32_16x16x32_bf16(a1, b1, acc, 0, 0, 0);
                *(f32x4v*)(KV + (16 * tv + fr) * 64 + 16 * t4 + 4 * fq) = acc;
            }
        }
    }
    __syncthreads();
}

__device__ __forceinline__ void gla_scan_item(int idx, unsigned char* ws, int tid) {
    asm volatile("" : "+v"(tid));
    const int bh = idx >> 3, e = (idx & 7) * 512 + tid, d = e & 63;
    const float* KV = (const float*)(ws + WS_KV) + (size_t)bh * 128 * 4096 + e;
    const float* DEC = (const float*)(ws + WS_DEC) + (size_t)bh * 128 * 64 + d;
    bfr* ST = (bfr*)(ws + WS_ST) + (size_t)bh * 128 * 4096 + e;
    float s = 0.f;
#pragma unroll 16
    for (int n = 0; n < 128; ++n) { const float kvv = KV[(size_t)n * 4096], dc = DEC[n * 64]; ST[(size_t)n * 4096] = f2bf(s); s = dc * s + kvv; }
}
__device__ __forceinline__ void lru_out_item(int q, unsigned char* ws, LAS unsigned char* lds, int tid, int wid) {
    asm volatile("" : "+v"(tid), "+s"(wid));
    const int b = q / 96, rem = q % 96, n = rem / 16, cgp = rem % 16;
    const int ch = tid & 63, tg = wid, cg_ = n * 64 + ch;
    const float* SA = (const float*)(ws + WS_SUMA) + (size_t)b * LRU_NCH * 384 + cg_;
    const float* SH = (const float*)(ws + WS_SUMH) + (size_t)b * LRU_NCH * 384 + cg_;
    LAS float* COMP = (LAS float*)lds;
    {
        const int nprev = 4 * cgp;
        float pw = 1.f, hw = 0.f;
        for (int j = (tg * nprev) >> 3; j < ((tg + 1) * nprev) >> 3; ++j) { const float a = SA[j * 384], hh = SH[j * 384]; hw = a * hw + hh; pw *= a; }
        COMP[(tg * 2) * 64 + ch] = pw; COMP[(tg * 2 + 1) * 64 + ch] = hw;
    }
    __syncthreads();
    float carry = 0.f;
#pragma unroll
    for (int g = 0; g < 8; ++g) carry = COMP[(g * 2) * 64 + ch] * carry + COMP[(g * 2 + 1) * 64 + ch];
    const bfr* HL = (const bfr*)(ws + WS_HL); const bfr* AC = (const bfr*)(ws + WS_ACUM); const bfr* PROJ = (const bfr*)(ws + WS_PROJ); bfr* MIX = (bfr*)(ws + WS_MIX);
    for (int cc = 0; cc < 4; ++cc) {
        const int c = cgp * 4 + cc;
        const size_t m0 = (size_t)b * SEQ + c * LRU_LC + 16 * tg;
        const float sa = SA[c * 384], sh = SH[c * 384];
        unsigned hlr[16], acr[16], yr[16];
#pragma unroll
        for (int i = 0; i < 16; ++i) { const size_t m = m0 + i; hlr[i] = HL[m * 384 + cg_]; acr[i] = AC[m * 384 + cg_]; yr[i] = PROJ[m * NPROJ + C_LG + cg_]; }
        asm volatile("" :: "v"(hlr[0]), "v"(hlr[1]), "v"(hlr[2]), "v"(hlr[3]), "v"(hlr[4]), "v"(hlr[5]), "v"(hlr[6]), "v"(hlr[7]), "v"(hlr[8]), "v"(hlr[9]), "v"(hlr[10]), "v"(hlr[11]), "v"(hlr[12]), "v"(hlr[13]), "v"(hlr[14]), "v"(hlr[15]) : "memory"); asm volatile("" :: "v"(acr[0]), "v"(acr[1]), "v"(acr[2]), "v"(acr[3]), "v"(acr[4]), "v"(acr[5]), "v"(acr[6]), "v"(acr[7]), "v"(acr[8]), "v"(acr[9]), "v"(acr[10]), "v"(acr[11]), "v"(acr[12]), "v"(acr[13]), "v"(acr[14]), "v"(acr[15]) : "memory"); asm volatile("" :: "v"(yr[0]), "v"(yr[1]), "v"(yr[2]), "v"(yr[3]), "v"(yr[4]), "v"(yr[5]), "v"(yr[6]), "v"(yr[7]), "v"(yr[8]), "v"(yr[9]), "v"(yr[10]), "v"(yr[11]), "v"(yr[12]), "v"(yr[13]), "v"(yr[14]), "v"(yr[15]) : "memory");
#pragma unroll
        for (int i = 0; i < 16; ++i) { const size_t m = m0 + i;
            const float hh = bf2f((bfr)hlr[i]) + bf2f((bfr)acr[i]) * carry; const float y = bf2f((bfr)yr[i]);
            MIX[m * DMIX + cg_] = f2bf(hh * gelu_tanh_(y)); }
        carry = sa * carry + sh;
    }
}
__device__ __forceinline__ void gla_out_item(int idx, const LayerPtrs& L, unsigned char* ws, int lane) {
    asm volatile("" : "+v"(lane));
    const int bh = idx >> 7, n = idx & 127, b = bh >> 2, h = bh & 3, fr = lane & 15, fq = lane >> 4;
    const size_t m0 = (size_t)b * SEQ + n * 64;
    const bfr* ST = (const bfr*)(ws + WS_ST) + (size_t)idx * 4096; const bfr* QDEC = (const bfr*)(ws + WS_QDEC); const bfr* OI = (const bfr*)(ws + WS_OINTRA);
    const bfr* PROJ = (const bfr*)(ws + WS_PROJ); bfr* MIX = (bfr*)(ws + WS_MIX);
    bf16x8v st[4][2];
#pragma unroll
    for (int tv = 0; tv < 4; ++tv)
#pragma unroll
        for (int ks = 0; ks < 2; ++ks) st[tv][ks] = *(const bf16x8v*)(ST + (16 * tv + fr) * 64 + 32 * ks + 8 * fq);
    f32x4v gn[4];
#pragma unroll
    for (int tv = 0; tv < 4; ++tv) gn[tv] = *(const f32x4v*)(L.ogain + 16 * tv + 4 * fq);
#pragma unroll
    for (int ti = 0; ti < 4; ++ti) {
        const size_t m = m0 + 16 * ti + fr;
        const bf16x8v q0 = *(const bf16x8v*)(QDEC + m * 256 + h * 64 + 8 * fq), q1 = *(const bf16x8v*)(QDEC + m * 256 + h * 64 + 32 + 8 * fq);
        u32x2v oiw[4], ggw[4];
#pragma unroll
        for (int tv = 0; tv < 4; ++tv) { oiw[tv] = *(const u32x2v*)(OI + m * 256 + h * 64 + 16 * tv + 4 * fq); ggw[tv] = *(const u32x2v*)(PROJ + m * NPROJ + C_GG + h * 64 + 16 * tv + 4 * fq); }
        asm volatile("" :: "v"(q0), "v"(q1), "v"(oiw[0]), "v"(oiw[1]), "v"(oiw[2]), "v"(oiw[3]), "v"(ggw[0]), "v"(ggw[1]), "v"(ggw[2]), "v"(ggw[3]) : "memory");
        f32x4v o[4]; float ss = 0.f;
#pragma unroll
        for (int tv = 0; tv < 4; ++tv) {
            f32x4v acc = {0.f, 0.f, 0.f, 0.f};
            acc = __builtin_amdgcn_mfma_f32_16x16x32_bf16(st[tv][0], q0, acc, 0, 0, 0);
            acc = __builtin_amdgcn_mfma_f32_16x16x32_bf16(st[tv][1], q1, acc, 0, 0, 0);
            const u32x2v w = oiw[tv];
            acc[0] += __uint_as_float(w.x << 16); acc[1] += __uint_as_float(w.x & 0xffff0000u); acc[2] += __uint_as_float(w.y << 16); acc[3] += __uint_as_float(w.y & 0xffff0000u);
            o[tv] = acc; ss += (acc[0] * acc[0] + acc[1] * acc[1]) + (acc[2] * acc[2] + acc[3] * acc[3]);
        }
        ss += __shfl_xor(ss, 16); ss += __shfl_xor(ss, 32);
        const float rs = 1.0f / sqrtf(ss * (1.0f / 64.0f) + EPS);
#pragma unroll
        for (int tv = 0; tv < 4; ++tv) {
            const u32x2v gw = ggw[tv];
            const float g0 = __uint_as_float(gw.x << 16), g1 = __uint_as_float(gw.x & 0xffff0000u), g2 = __uint_as_float(gw.y << 16), g3 = __uint_as_float(gw.y & 0xffff0000u);
            u32x2v w; w.x = pk2(o[tv][0] * rs * gn[tv][0] * silu_(g0), o[tv][1] * rs * gn[tv][1] * silu_(g1)); w.y = pk2(o[tv][2] * rs * gn[tv][2] * silu_(g2), o[tv][3] * rs * gn[tv][3] * silu_(g3));
            *(u32x2v*)(MIX + m * DMIX + 768 + h * 64 + 16 * tv + 4 * fq) = w;
        }
    }
}

#define XB_TMO      128
#define XB_XCNT(j)  (256  + 64 * (j))
#define XB_XSUB(j)  (1280 + 64 * (j))
#define XB_XGEN(j)  (2304 + 64 * (j))
#define XB_TOP      3328
#define XB_TOPGEN   3392
#define XCD_BAR_WORDS 3456
#define XB_SPIN_CAP (1u << 18)

__device__ __forceinline__ unsigned xb_ld(unsigned* p)              { return __hip_atomic_load(p, __ATOMIC_RELAXED, __HIP_MEMORY_SCOPE_AGENT); }
__device__ __forceinline__ unsigned xb_add(unsigned* p, unsigned v) { return __hip_atomic_fetch_add(p, v, __ATOMIC_RELAXED, __HIP_MEMORY_SCOPE_AGENT); }
__device__ __forceinline__ unsigned xb_xcc_id() { return (unsigned)__builtin_amdgcn_s_getreg((3 << 11) | 20) & 0xFu; }
#define XB_SPIN(cond, bar) do { unsigned _sp = 0; while (cond) { __builtin_amdgcn_s_sleep(1); \
    if ((++_sp & 255u) == 0u) { if (xb_ld(&(bar)[XB_TMO])) break; if (_sp > XB_SPIN_CAP) { atomicAdd(&(bar)[XB_TMO], 1u); break; } } } } while (0)

struct XcdBarrier {
    unsigned* bar; unsigned x;
    volatile LAS unsigned* st;
};

__device__ __forceinline__ XcdBarrier xcd_barrier_post(unsigned* bar, volatile LAS unsigned* st) {
    XcdBarrier b; b.bar = bar; b.x = xb_xcc_id(); b.st = st;
    if (threadIdx.x == 0) (void)xb_add(&bar[XB_XCNT(b.x)], 1u);
    return b;
}
__device__ __forceinline__ void xcd_barrier_complete(unsigned* bar, unsigned x, unsigned& nloc, unsigned& nx) {
    const unsigned G = gridDim.x * gridDim.y * gridDim.z;
    unsigned sum, cnt, mine, sp = 0u;
    for (;;) {
        sum = 0u; cnt = 0u; mine = 0u;
#pragma unroll
        for (unsigned j = 0; j < 16; ++j) { const unsigned c = xb_ld(&bar[XB_XCNT(j)]); sum += c; cnt += (c > 0u) ? 1u : 0u; mine = (j == x) ? c : mine; }
        if (sum == G) break;
        __builtin_amdgcn_s_sleep(1);
        if ((++sp & 255u) == 0u) { if (xb_ld(&bar[XB_TMO])) break; if (sp > XB_SPIN_CAP) { atomicAdd(&bar[XB_TMO], 1u); break; } }
    }
    nloc = mine > 0u ? mine : 1u; nx = cnt > 0u ? cnt : 1u;
}

__device__ __forceinline__ void xcd_barrier(const XcdBarrier& b) {
    asm volatile("s_waitcnt vmcnt(0)" ::: "memory");
    __syncthreads();
    if (threadIdx.x == 0) {
        unsigned* bar = b.bar;
        __builtin_amdgcn_s_waitcnt(0);
        unsigned nloc = b.st[0], nx = b.st[1];
        if (nloc == 0u) { xcd_barrier_complete(bar, b.x, nloc, nx); b.st[0] = nloc; b.st[1] = nx; }
        const unsigned old = xb_add(&bar[XB_XSUB(b.x)], 1u);
        const unsigned gen = old / nloc;
        if (old + 1u == (gen + 1u) * nloc) {
            __builtin_amdgcn_fence(__ATOMIC_RELEASE, "agent");
            asm volatile("s_waitcnt vmcnt(0)" ::: "memory");
            const unsigned og = xb_add(&bar[XB_TOP], 1u);
            const unsigned tg = og / nx;
            if (og + 1u == (tg + 1u) * nx) xb_add(&bar[XB_TOPGEN], 1u);
            else XB_SPIN(xb_ld(&bar[XB_TOPGEN]) == tg, bar);
            __builtin_amdgcn_fence(__ATOMIC_ACQUIRE, "agent");
            xb_add(&bar[XB_XGEN(b.x)], 1u);
            asm volatile("s_waitcnt vmcnt(0)" ::: "memory");
        } else {
            XB_SPIN(xb_ld(&bar[XB_XGEN(b.x)]) == gen, bar);
            __builtin_amdgcn_fence(__ATOMIC_ACQUIRE, "agent");
            asm volatile("s_waitcnt vmcnt(0)" ::: "memory");
        }
    }
    __syncthreads();
}

#ifdef EXP_P2
#define EXP_KN_ONCE (rep_ == 0)
#else
#define EXP_KN_ONCE true
#endif
#define XBAR1() do { XcdBarrier b_; b_.bar = (unsigned*)P.ws + CW_BAR; b_.x = xb_xcc_id(); b_.st = (volatile LAS unsigned*)(lds + MISC_OFF + 32); xcd_barrier(b_); } while (0)
#ifdef EXP_SYNC
#define GSYNC() do { XBAR1(); XBAR1(); } while (0)
#else
#define GSYNC() XBAR1()
#endif
__global__ void __launch_bounds__(512, 2) hybrid_fwd(Params P) {
    extern __shared__ __attribute__((aligned(16))) unsigned char lds_raw[];
    cg::grid_group grid = cg::this_grid();
    LAS unsigned char* lds = (LAS unsigned char*)lds_raw;
    const int tid = threadIdx.x, lane = tid & 63, wid = __builtin_amdgcn_readfirstlane(tid >> 6);
    const int G = gridDim.x, gw = blockIdx.x * 8 + wid, NGW = G * 8;
    unsigned char* ws = P.ws;
    unsigned* ctl = (unsigned*)(ws + WS_CTL);
    volatile LAS int* slot = (volatile LAS int*)(lds + MISC_OFF);
    const float* MOD = (const float*)(ws + WS_MOD);
    bfr* XB = (bfr*)P.out;
    bfr* HN = (bfr*)(ws + WS_HN); bfr* PROJ = (bfr*)(ws + WS_PROJ); bfr* MIX = (bfr*)(ws + WS_MIX); bfr* GB = (bfr*)(ws + WS_PROJ);

    if (tid < 16) ((LAS unsigned*)(lds + MISC_OFF))[tid] = 0u;
    __syncthreads();
    (void)xcd_barrier_post(ctl + CW_BAR, (volatile LAS unsigned*)(lds + MISC_OFF + 32));
    p0_prologue(P, lds, tid, lane, wid, G);
#ifdef EXP_P0
    __syncthreads(); p0_prologue(P, lds, tid, lane, wid, G);
#endif
    grid.sync();

    for (int l = 0; l < DEPTH; ++l) {
        const float* modl = MOD + (size_t)l * NB * NMOD;
        bfr* XBm = l < DEPTH - 1 ? XB : (bfr*)(ws + WS_OINTRA);
        LayerPtrs L;
        L.conv_w = P.in[7] + (size_t)l * 4 * 384; L.conv_b = P.in[8] + (size_t)l * 384; L.b_r = P.in[10] + (size_t)l * 384; L.b_i = P.in[12] + (size_t)l * 384; L.lam = P.in[13] + (size_t)l * 384;
        L.fox_bf = P.in[14] + (size_t)l * 6; L.qgain = P.in[15] + (size_t)l * 64; L.kgain = P.in[16] + (size_t)l * 64;
        L.w_alpha = P.in[17] + (size_t)l * 16 * 256; L.b_alpha = P.in[18] + (size_t)l * 256; L.ogain = P.in[19] + (size_t)l * 64;
        L.lruw = (const bfr*)(ws + WS_LRUW) + (size_t)l * 6 * 2 * 4096;

        norm_phase(P.in[0], l == 0 ? (const bfr*)nullptr : XB, P.in[2] + (size_t)l * DMODEL, modl, 0, 1024, HN, gw, NGW, lane);
        GSYNC();
        {
            pg8::Gemm g{HN, (const bfr*)(ws + WS_WIN + l * WIN_L), MROWS, NPROJ, DMODEL}; pg8::StaticOrder S; S.init(MROWS, NPROJ, G, (int)blockIdx.x);
            pg8::EpiProj E{PROJ, NPROJ, L.qgain, L.kgain, C_FQ};
            pg8::gemm_phase<pg8::EpiProj, pg8::StaticOrder, PG8_ALIGN, PG8_SP2>(lds, g, S, E);
#ifdef EXP_G16
            __syncthreads(); pg8::gemm_phase<pg8::EpiBf16<0>, pg8::StaticOrder, PG8_ALIGN, PG8_SP2>(lds, g, S, E);
#endif
        }
        GSYNC();
        {
            constexpr int N_CUM = 24, N_GLA = 1024, N_LL = 6 * LRU_NCH * NB, N_KN = 0, N_P2 = N_CUM + N_GLA + N_LL + N_KN;
#ifdef EXP_P2
          for (int rep_ = 0; rep_ < 2; ++rep_) {
            unsigned* ctr = ctl + 64 * l + 16 + 8 * rep_;
#else
            unsigned* ctr = ctl + 64 * l + 16;
#endif
            int cur = blockIdx.x, itn = 0;
            while (cur < N_P2) {
                if (tid == 0) slot[itn & 1] = (int)atomicAdd(ctr, 1u) + G;
                if (cur < N_CUM) cum_item(cur, L, ws, lds, tid, lane, wid);
                else if (cur < N_CUM + N_GLA) gla_local_item(cur - N_CUM, L, ws, lds, tid, lane, wid);
                else if (cur < N_CUM + N_GLA + N_LL) lru_local_item(cur - N_CUM - N_GLA, L, ws, lds, tid, lane, wid);
                __syncthreads();
                cur = slot[itn & 1]; ++itn;
            }
#ifdef EXP_P2
            __syncthreads();
          }
#endif
        }
        GSYNC();
        {
            constexpr int N_ATT = 768, N_SCAN = 128, N_LRU = 384, N_GO = 256, N_ALL = N_ATT + N_SCAN + N_LRU + N_GO;
            unsigned* sdone = ctl + 64 * l + 48;
#ifdef EXP_P3
          for (int rep_ = 0; rep_ < 2; ++rep_) {
            unsigned* ctr = ctl + 64 * l + 32 * rep_;
#else
            unsigned* ctr = ctl + 64 * l;
#endif
            float skip_th;
            { int ln_ = lane; asm volatile("" : "+v"(ln_)); float gq = fabsf(L.qgain[ln_]), gk = fabsf(L.kgain[ln_]);
#pragma unroll
              for (int o = 1; o < 64; o <<= 1) { gq = fmaxf(gq, __shfl_xor(gq, o)); gk = fmaxf(gk, __shfl_xor(gk, o)); }
              skip_th = 150.0f + 2.0f * 11.7f * gq * gk; }
            int cur = blockIdx.x, itn = 0;
            while (cur < N_ALL) {
                if (tid == 0) slot[itn & 1] = (int)atomicAdd(ctr, 1u) + G;
                if (cur < N_SCAN) {
                    gla_scan_item(cur, ws, tid);
                    __syncthreads();
                    if (tid == 0) { __builtin_amdgcn_fence(__ATOMIC_RELEASE, "agent"); asm volatile("s_waitcnt vmcnt(0)" ::: "memory"); __hip_atomic_fetch_add(sdone + (cur >> 3), 1u, __ATOMIC_RELAXED, __HIP_MEMORY_SCOPE_AGENT); }
                } else if (cur < N_SCAN + N_ATT) {
                    const int ua = cur - N_SCAN; const int qb = 31 - ua / 24, bh = ua % 24, b = bh / 6, h = bh % 6;
                    attn_body::attn_unit<96>(b, h, qb, (const attn_body::bf16*)(PROJ + C_FQ), (const attn_body::bf16*)(PROJ + C_FK), (const attn_body::bf16*)(PROJ + C_FV), (attn_body::bf16*)(MIX + 384),
                                            (const float*)(ws + WS_CUM) + (size_t)bh * SEQ, L.qgain, skip_th, (char*)lds_raw);
                } else if (cur < N_SCAN + N_ATT + N_LRU) {
                    lru_out_item(cur - N_ATT - N_SCAN, ws, lds, tid, wid);
                } else {
                    const int gi = (cur - N_SCAN - N_ATT - N_LRU) * 8;
                    if (tid == 0) { unsigned sp = 0; while (__hip_atomic_load(sdone + (gi >> 7), __ATOMIC_RELAXED, __HIP_MEMORY_SCOPE_AGENT) < 8u) { __builtin_amdgcn_s_sleep(2); if (++sp > (1u << 22)) break; }
                        __builtin_amdgcn_fence(__ATOMIC_ACQUIRE, "agent"); asm volatile("s_waitcnt vmcnt(0)" ::: "memory"); }
                    __syncthreads();
                    gla_out_item(gi + wid, L, ws, lane);
                }
                __syncthreads();
                cur = slot[itn & 1]; ++itn;
            }
#ifdef EXP_P3
            __syncthreads();
          }
#endif
        }
        GSYNC();
        {
            pg8::Gemm g{MIX, (const bfr*)(ws + WS_WOUT + l * WOUT_L), MROWS, DMODEL, DMIX}; pg8::StaticOrder S; S.init(MROWS, DMODEL, G, (int)blockIdx.x);
            pg8::EpiResidB E{l == 0 ? P.in[0] : (const float*)nullptr, XB, XBm, (float*)nullptr, DMODEL, modl + 2048, NMOD, SEQ};
            pg8::gemm_phase<pg8::EpiResidB, pg8::StaticOrder, PG8_ALIGN, PG8_SP2>(lds, g, S, E);
        }
        GSYNC();
        norm_phase(P.in[0], XBm, P.in[3] + (size_t)l * DMODEL, modl, 3072, 4096, HN, gw, NGW, lane);
        GSYNC();
        {
            pg8::Gemm g{HN, (const bfr*)(ws + WS_WGU + l * WGU_L), MROWS, NGU, DMODEL}; pg8::StaticOrder S; S.init(MROWS, NGU, G, (int)blockIdx.x);
            pg8::EpiSwiGLU E{GB, DFF};
            pg8::gemm_phase<pg8::EpiSwiGLU, pg8::StaticOrder, PG8_ALIGN, PG8_SP2>(lds, g, S, E);
#ifdef EXP_G16
            __syncthreads(); pg8::gemm_phase<pg8::EpiSwiGLU, pg8::StaticOrder, PG8_ALIGN, PG8_SP2>(lds, g, S, E);
#endif
        }
        GSYNC();
        {
            pg8::Gemm g{GB, (const bfr*)(ws + WS_WDN + l * WDN_L), MROWS, DMODEL, DFF}; pg8::StaticOrder S; S.init(MROWS, DMODEL, G, (int)blockIdx.x);
            pg8::EpiResidB E{(const float*)nullptr, XBm, l < DEPTH - 1 ? XB : (bfr*)nullptr, l < DEPTH - 1 ? (float*)nullptr : P.out, DMODEL, modl + 5120, NMOD, SEQ};
            pg8::gemm_phase<pg8::EpiResidB, pg8::StaticOrder, PG8_ALIGN, PG8_SP2>(lds, g, S, E);
        }
        if (l < DEPTH - 1) GSYNC();
    }
}

extern "C" void kernel_launch(void* const* d_in, const int* in_sizes, int n_in, void* d_out, int out_size, void* d_ws, size_t ws_size, hipStream_t stream) {
    static int grid = 0;
    if (grid == 0) {
        if (n_in != 23 || out_size != MROWS * DMODEL || ws_size < WS_END) { fprintf(stderr, "kernel_launch: unexpected shapes (n_in %d out %d ws %zu)\n", n_in, out_size, ws_size); grid = -1; return; }
        int dev = 0, cus = 0, per_cu = 0;
        if (hipGetDevice(&dev) != hipSuccess || hipDeviceGetAttribute(&cus, hipDeviceAttributeMultiprocessorCount, dev) != hipSuccess) { grid = -1; return; }
        if (hipFuncSetAttribute((const void*)hybrid_fwd, hipFuncAttributeMaxDynamicSharedMemorySize, LDS_BYTES) != hipSuccess) { fprintf(stderr, "kernel_launch: hipFuncSetAttribute failed\n"); grid = -1; return; }
        if (hipOccupancyMaxActiveBlocksPerMultiprocessor(&per_cu, (const void*)hybrid_fwd, 512, LDS_BYTES) != hipSuccess || per_cu < 1) { fprintf(stderr, "kernel_launch: occupancy query says %d\n", per_cu); per_cu = 1; }
        (void)hipGetLastError();
        grid = cus;
    }
    if (grid < 0) return;
    (void)hipMemsetAsync((char*)d_ws + WS_CTL, 0, CTL_BYTES, stream);
    Params p{};
    for (int i = 0; i < 23; ++i) p.in[i] = (const float*)d_in[i];
    p.out = (float*)d_out; p.ws = (unsigned char*)d_ws;
    void* args[] = {&p};
    hipError_t e = hipLaunchCooperativeKernel((const void*)hybrid_fwd, dim3(grid), dim3(512), args, LDS_BYTES, stream);
    if (e != hipSuccess) fprintf(stderr, "kernel_launch: cooperative launch failed: %s (grid %d)\n", hipGetErrorString(e), grid);
}
```

```cpp
#include <hip/hip_runtime.h>
#include <hip/hip_cooperative_groups.h>
#include <hip/hip_bf16.h>
#include <cstdio>
#include <cstdint>
#include <cmath>
namespace cg = cooperative_groups;
namespace pg8 {
#define PG8_LAS __attribute__((address_space(3)))
typedef unsigned short bf16_t;
typedef short bf16x8 __attribute__((ext_vector_type(8)));
typedef float f32x4 __attribute__((ext_vector_type(4)));
typedef unsigned u32x4 __attribute__((ext_vector_type(4)));
constexpr int BM = 256, BK = 64, HALF = 128, HTB = HALF * BK * 2  , STAGE_BYTES = 8 * HTB, NXCD = 8, WGM = 8;

__host__ __device__ __forceinline__ int lds_byte(int r, int c) { const int st = (r >> 4) * 2 + (c >> 5), rr = r & 15, cc = c & 31, ob = rr * 64 + cc * 2; return st * 1024 + (ob ^ (((ob >> 9) & 1) << 5)); }
__host__ __device__ __forceinline__ void stage_rc(int b, int& R, int& C) { const int st = b / 1024, sb = b % 1024, swz = sb ^ (((sb >> 9) & 1) << 5); R = (st >> 1) * 16 + swz / 64; C = (st & 1) * 32 + (swz % 64) / 2; }
__host__ __device__ __forceinline__ int perm32(int rho) { const int n = rho >> 4, i = rho & 15; return 8 * (i >> 2) + 4 * n + (i & 3); }

struct Unit { int pm, pn; };
struct Gemm { const bf16_t* A; const bf16_t* Bt; int M, N, K; };

struct StaticOrder {
    int nM, nN, nwg, G, c;
    __host__ __device__ void init(int M, int N, int G_, int c_) { nM = M / BM; nN = N / BM; nwg = nM * nN; G = G_; c = c_; }
    __host__ __device__ bool next(int i, Unit& u) const {
        const long L = (long)i * G + c; if (L >= nwg) return false;
        int wgid = (int)L; { const int q = nwg / NXCD, r = nwg % NXCD, xcd = wgid % NXCD, off = wgid / NXCD; wgid = (xcd < r ? xcd * (q + 1) : r * (q + 1) + (xcd - r) * q) + off; }
        const int nig = WGM * nN, gid = wgid / nig, fm = gid * WGM, gsz = (nM - fm) < WGM ? (nM - fm) : WGM;
        u.pm = fm + ((wgid % nig) % gsz); u.pn = (wgid % nig) / gsz; return true;
    }
    __device__ __forceinline__ void a_ready(const Unit&) const {}
    __device__ __forceinline__ void done(const Unit&) const {}
};

__device__ __forceinline__ unsigned cvt_pk_bf16(float lo, float hi) { unsigned r; asm volatile("v_cvt_pk_bf16_f32 %0, %1, %2" : "=v"(r) : "v"(lo), "v"(hi)); return r; }
typedef float f32x2 __attribute__((ext_vector_type(2)));
__device__ __forceinline__ f32x2 gelu_pk(f32x2 v) {
    const f32x2 av = __builtin_elementwise_abs(v), d = av * 0.2316418882f + 1.0f;
    f32x2 t; t.x = __builtin_amdgcn_rcpf(d.x); t.y = __builtin_amdgcn_rcpf(d.y);
    f32x2 q = t * 0.5307027145f + (-0.7265760135f); q = q * t + 0.7107068705f; q = q * t + (-0.142248368f); q = q * t + 0.127414796f; q = q * t;
    const f32x2 s = (v * v) * (-0.72134752044f);
    f32x2 e; e.x = __builtin_amdgcn_exp2f(s.x); e.y = __builtin_amdgcn_exp2f(s.y);
    const f32x2 m = v * (q * e), r = v - m;
    f32x2 o; o.x = v.x < 0.f ? m.x : r.x; o.y = v.y < 0.f ? m.y : r.y; return o;
}

template <int ACT  > struct EpiBf16 {
    static constexpr bool PERM = true, AFTER_DRAIN = false; static_assert(ACT == 0 || ACT == 1, "EpiBf16: ACT is 0 (none) or 1 (gelu_pk)");
    bf16_t* O; int ldc; const float* bias; int split_cols; size_t split_stride; float scale0;
    __device__ __forceinline__ void operator()(const f32x4 (&acc)[2][2][4][2], const Unit& u, int wr, int wc, int fr, int fq) const {
        const int row0 = u.pm * BM + wr * 64 + fr; int colt = u.pn * BM; bf16_t* base = O;
        float sc = 1.f; if (split_cols) { const int t = colt / split_cols; base += (size_t)t * split_stride; colt -= t * split_cols; if (t == 0) sc = scale0; }
        const int col0 = colt + wc * 32 + 8 * fq, bcol0 = u.pn * BM + wc * 32 + 8 * fq;
        f32x4 bv[2][2];
#pragma unroll
        for (int bj = 0; bj < 2; ++bj)
#pragma unroll
            for (int n = 0; n < 2; ++n) bv[bj][n] = bias ? *(const f32x4*)(bias + bcol0 + bj * HALF + 4 * n) : (f32x4){0.f, 0.f, 0.f, 0.f};
#pragma unroll
        for (int ai = 0; ai < 2; ++ai)
#pragma unroll
            for (int m = 0; m < 4; ++m) { bf16_t* rowp = base + (size_t)(row0 + ai * HALF + m * 16) * ldc + col0;
#pragma unroll
                for (int bj = 0; bj < 2; ++bj) { f32x4 v0 = acc[ai][bj][m][0] + bv[bj][0], v1 = acc[ai][bj][m][1] + bv[bj][1];
                    if (ACT == 1) { f32x2 a = gelu_pk((f32x2){v0[0], v0[1]}), b = gelu_pk((f32x2){v0[2], v0[3]}), c = gelu_pk((f32x2){v1[0], v1[1]}), d = gelu_pk((f32x2){v1[2], v1[3]});
                        v0 = (f32x4){a.x, a.y, b.x, b.y}; v1 = (f32x4){c.x, c.y, d.x, d.y}; }
                    v0 = v0 * sc; v1 = v1 * sc; u32x4 w; w.x = cvt_pk_bf16(v0[0], v0[1]); w.y = cvt_pk_bf16(v0[2], v0[3]); w.z = cvt_pk_bf16(v1[0], v1[1]); w.w = cvt_pk_bf16(v1[2], v1[3]);
                    *(u32x4*)(rowp + bj * HALF) = w; } }
    }
};


struct EpiProj {
    static constexpr bool PERM = true, AFTER_DRAIN = false;
    bf16_t* O; int ldc; const float* qgain; const float* kgain; int cfq;
    __device__ __forceinline__ void operator()(const f32x4 (&acc)[2][2][4][2], const Unit& u, int wr, int wc, int fr, int fq) const {
        const int row0 = u.pm * BM + wr * 64 + fr;
        if (u.pn < 3 || u.pn > 5) {
            const int col0 = u.pn * BM + wc * 32 + 8 * fq;
#pragma unroll
            for (int ai = 0; ai < 2; ++ai)
#pragma unroll
                for (int m = 0; m < 4; ++m) { bf16_t* rowp = O + (size_t)(row0 + ai * HALF + m * 16) * ldc + col0;
#pragma unroll
                    for (int bj = 0; bj < 2; ++bj) { const f32x4 v0 = acc[ai][bj][m][0], v1 = acc[ai][bj][m][1];
                        u32x4 w; w.x = cvt_pk_bf16(v0[0], v0[1]); w.y = cvt_pk_bf16(v0[2], v0[3]); w.z = cvt_pk_bf16(v1[0], v1[1]); w.w = cvt_pk_bf16(v1[2], v1[3]);
                        *(u32x4*)(rowp + bj * HALF) = w; } }
        } else {
            const int H = 4 * (u.pn - 3) + wc;
            const float* gp = (H < 6 ? qgain : kgain) + 8 * fq; const float sc = H < 6 ? 0.125f * 1.4426950408889634f : 1.0f;
            f32x4 gv[2][2];
#pragma unroll
            for (int bj = 0; bj < 2; ++bj)
#pragma unroll
                for (int n = 0; n < 2; ++n) gv[bj][n] = *(const f32x4*)(gp + 32 * bj + 4 * n) * sc;
            const int col0 = cfq + H * 64 + 8 * fq;
#pragma unroll
            for (int ai = 0; ai < 2; ++ai)
#pragma unroll
                for (int m = 0; m < 4; ++m) { bf16_t* rowp = O + (size_t)(row0 + ai * HALF + m * 16) * ldc + col0;
                    float ss = 0.f;
#pragma unroll
                    for (int bj = 0; bj < 2; ++bj)
#pragma unroll
                        for (int n = 0; n < 2; ++n) { const f32x4 x = acc[ai][bj][m][n]; ss += (x[0] * x[0] + x[1] * x[1]) + (x[2] * x[2] + x[3] * x[3]); }
                    ss += __shfl_xor(ss, 16); ss += __shfl_xor(ss, 32);
                    const float rs = __builtin_amdgcn_rsqf(ss * (1.0f / 64.0f) + 1e-6f);
#pragma unroll
                    for (int bj = 0; bj < 2; ++bj) { const f32x4 v0 = acc[ai][bj][m][0] * rs * gv[bj][0], v1 = acc[ai][bj][m][1] * rs * gv[bj][1];
                        u32x4 w; w.x = cvt_pk_bf16(v0[0], v0[1]); w.y = cvt_pk_bf16(v0[2], v0[3]); w.z = cvt_pk_bf16(v1[0], v1[1]); w.w = cvt_pk_bf16(v1[2], v1[3]);
                        *(u32x4*)(rowp + 32 * bj) = w; } }
        }
    }
};
struct EpiSwiGLU {
    static constexpr bool PERM = true, AFTER_DRAIN = false;
    bf16_t* O; int ldc;
    __device__ __forceinline__ void operator()(const f32x4 (&acc)[2][2][4][2], const Unit& u, int wr, int wc, int fr, int fq) const {
        const int row0 = u.pm * BM + wr * 64 + fr; const int col0 = u.pn * HALF + wc * 32 + 8 * fq;
#pragma unroll
        for (int ai = 0; ai < 2; ++ai)
#pragma unroll
            for (int m = 0; m < 4; ++m) { bf16_t* rowp = O + (size_t)(row0 + ai * HALF + m * 16) * ldc + col0;
                float o[8];
#pragma unroll
                for (int n = 0; n < 2; ++n)
#pragma unroll
                    for (int j = 0; j < 4; ++j) { const float g = acc[ai][0][m][n][j], up = acc[ai][1][m][n][j];
                        const float sg = g * __builtin_amdgcn_rcpf(1.0f + __builtin_amdgcn_exp2f(-1.4426950408889634f * g)); o[n * 4 + j] = sg * up; }
                u32x4 w; w.x = cvt_pk_bf16(o[0], o[1]); w.y = cvt_pk_bf16(o[2], o[3]); w.z = cvt_pk_bf16(o[4], o[5]); w.w = cvt_pk_bf16(o[6], o[7]);
                *(u32x4*)rowp = w; }
    }
};
struct EpiResid {
    static constexpr bool PERM = false, AFTER_DRAIN = false;
    const float* base; float* out; int ldc; const float* gate; int gstride; int rows_per_batch;
    __device__ __forceinline__ void operator()(const f32x4 (&acc)[2][2][4][2], const Unit& u, int wr, int wc, int fr, int fq) const {
        const int col0 = u.pn * BM + wc * 32 + 4 * fq;
        const float* gp = gate + (size_t)((u.pm * BM) / rows_per_batch) * gstride + col0;
        f32x4 gv[2][2];
#pragma unroll
        for (int bj = 0; bj < 2; ++bj)
#pragma unroll
            for (int n = 0; n < 2; ++n) gv[bj][n] = *(const f32x4*)(gp + bj * HALF + n * 16);
#pragma unroll
        for (int ai = 0; ai < 2; ++ai)
#pragma unroll
            for (int m = 0; m < 4; ++m) { const size_t off = (size_t)(u.pm * BM + ai * HALF + wr * 64 + m * 16 + fr) * ldc + col0;
#pragma unroll
                for (int bj = 0; bj < 2; ++bj)
#pragma unroll
                    for (int n = 0; n < 2; ++n) { const f32x4 bs = *(const f32x4*)(base + off + bj * HALF + n * 16);
                        *(f32x4*)(out + off + bj * HALF + n * 16) = bs + gv[bj][n] * acc[ai][bj][m][n]; } }
    }
};


typedef _Float16 h16x2 __attribute__((ext_vector_type(2)));
__device__ __forceinline__ f32x2 h2f(unsigned w) { return __builtin_convertvector(__builtin_bit_cast(h16x2, w), f32x2); }
__device__ __forceinline__ unsigned f2h(float lo, float hi) { f32x2 v = {lo, hi}; return __builtin_bit_cast(unsigned, __builtin_convertvector(v, h16x2)); }
struct EpiResidB {
    static constexpr bool PERM = true, AFTER_DRAIN = false;
    const float* base32; const bf16_t* base16; bf16_t* out16; float* out32; int ldc; const float* gate; int gstride; int rows_per_batch;
    __device__ __forceinline__ void operator()(const f32x4 (&acc)[2][2][4][2], const Unit& u, int wr, int wc, int fr, int fq) const {
        const int row0 = u.pm * BM + wr * 64 + fr; const int col0 = u.pn * BM + wc * 32 + 8 * fq;
        const float* gp = gate + (size_t)((u.pm * BM) / rows_per_batch) * gstride + col0;
        f32x4 gv[2][2];
#pragma unroll
        for (int bj = 0; bj < 2; ++bj)
#pragma unroll
            for (int n = 0; n < 2; ++n) gv[bj][n] = *(const f32x4*)(gp + bj * HALF + 4 * n);
#pragma unroll
        for (int ai = 0; ai < 2; ++ai) {
            if (base32) {
#pragma unroll
                for (int m = 0; m < 4; ++m) { const size_t off = (size_t)(row0 + ai * HALF + m * 16) * ldc + col0;
#pragma unroll
                    for (int bj = 0; bj < 2; ++bj) {
                        const f32x4 b0 = *(const f32x4*)(base32 + off + bj * HALF), b1 = *(const f32x4*)(base32 + off + bj * HALF + 4);
                        const f32x4 v0 = b0 + gv[bj][0] * acc[ai][bj][m][0], v1 = b1 + gv[bj][1] * acc[ai][bj][m][1];
                        if (out32) { *(f32x4*)(out32 + off + bj * HALF) = v0; *(f32x4*)(out32 + off + bj * HALF + 4) = v1; }
                        else { u32x4 w; w.x = f2h(v0[0], v0[1]); w.y = f2h(v0[2], v0[3]); w.z = f2h(v1[0], v1[1]); w.w = f2h(v1[2], v1[3]); *(u32x4*)(out16 + off + bj * HALF) = w; } } }
            } else {
                u32x4 wa[4][2];
#pragma unroll
                for (int m = 0; m < 4; ++m)
#pragma unroll
                    for (int bj = 0; bj < 2; ++bj) { const size_t off = (size_t)(row0 + ai * HALF + m * 16) * ldc + col0; wa[m][bj] = *(const u32x4*)(base16 + off + bj * HALF); }
                asm volatile("" :: "v"(wa[0][0]), "v"(wa[0][1]), "v"(wa[1][0]), "v"(wa[1][1]), "v"(wa[2][0]), "v"(wa[2][1]), "v"(wa[3][0]), "v"(wa[3][1]) : "memory");
#pragma unroll
                for (int m = 0; m < 4; ++m) { const size_t off = (size_t)(row0 + ai * HALF + m * 16) * ldc + col0;
#pragma unroll
                    for (int bj = 0; bj < 2; ++bj) { const u32x4 w0 = wa[m][bj]; const f32x2 p0 = h2f(w0.x), p1 = h2f(w0.y), p2 = h2f(w0.z), p3 = h2f(w0.w);
                        const f32x4 b0 = (f32x4){p0.x, p0.y, p1.x, p1.y}, b1 = (f32x4){p2.x, p2.y, p3.x, p3.y};
                        const f32x4 v0 = b0 + gv[bj][0] * acc[ai][bj][m][0], v1 = b1 + gv[bj][1] * acc[ai][bj][m][1];
                        if (out32) { *(f32x4*)(out32 + off + bj * HALF) = v0; *(f32x4*)(out32 + off + bj * HALF + 4) = v1; }
                        else { u32x4 w; w.x = f2h(v0[0], v0[1]); w.y = f2h(v0[2], v0[3]); w.z = f2h(v1[0], v1[1]); w.w = f2h(v1[2], v1[3]); *(u32x4*)(out16 + off + bj * HALF) = w; } } }
            }
        }
    }
};

template <class Epi, class Sched, bool ALIGN_EPI = false, bool SP2 = false>
__device__ __forceinline__ void gemm_phase(PG8_LAS unsigned char* lds, const Gemm g, const Sched& S, const Epi& E) {
    int tid = threadIdx.x; asm volatile("" : "+v"(tid)); const int wid = __builtin_amdgcn_readfirstlane(tid >> 6), lane = tid & 63, wr = wid >> 2, wc = wid & 3, fr = lane & 15, fq = lane >> 4;
    const int K = g.K, nt = K / BK;
    unsigned voffA[2], voffB[2];
#pragma unroll
    for (int i = 0; i < 2; ++i) { int R, C; stage_rc(tid * 16 + i * 8192, R, C); const int Rb = Epi::PERM ? ((R & ~31) + perm32(R & 31)) : R;
        voffA[i] = (unsigned)(R * K + C) * 2u; voffB[i] = (unsigned)(Rb * K + C) * 2u; }
    const size_t kstep = (size_t)(BK * 2);
    const size_t hstep = (size_t)HALF * K * 2;
    const size_t tstep = 2 * hstep;
    const unsigned ldsw = (unsigned)wid * 1024u;
    const int aoff = lds_byte(wr * 64 + fr, fq * 8), boff = lds_byte(wc * 32 + fr, fq * 8);
#define PG8_SA(b, h) (((b) * 2 + (h)) * HTB)
#define PG8_SB(b, h) ((4 + (b) * 2 + (h)) * HTB)
#define PG8_STAGE(bufoff, gbase, voff) do { _Pragma("unroll") for (int _i = 0; _i < 2; ++_i) \
        __builtin_amdgcn_global_load_lds((const unsigned*)((const char*)(gbase) + (voff)[_i]), (PG8_LAS unsigned*)(lds + (bufoff) + ldsw + _i * 8192), 16, 0, 0); } while (0)
#define PG8_LDA(dst, b, h) do { _Pragma("unroll") for (int m = 0; m < 4; ++m) _Pragma("unroll") for (int k = 0; k < 2; ++k) dst[m][k] = *(const PG8_LAS bf16x8*)(lds + PG8_SA(b, h) + aoff + m * 2048 + k * 1024); } while (0)
#define PG8_LDB(dst, b, h) do { _Pragma("unroll") for (int n = 0; n < 2; ++n) _Pragma("unroll") for (int k = 0; k < 2; ++k) dst[n][k] = *(const PG8_LAS bf16x8*)(lds + PG8_SB(b, h) + boff + n * 2048 + k * 1024); } while (0)
#define PG8_MMA(ai, bj, At, Bt) do { __builtin_amdgcn_s_setprio(1); _Pragma("unroll") for (int m = 0; m < 4; ++m) _Pragma("unroll") for (int n = 0; n < 2; ++n) _Pragma("unroll") for (int k = 0; k < 2; ++k) \
        acc[ai][bj][m][n] = __builtin_amdgcn_mfma_f32_16x16x32_bf16(Bt[n][k], At[m][k], acc[ai][bj][m][n], 0, 0, 0); __builtin_amdgcn_s_setprio(0); } while (0)
#define PG8_WAIT_V(n) asm volatile("s_waitcnt vmcnt(" #n ")" ::: "memory")
#define PG8_WAIT_L(n) asm volatile("s_waitcnt lgkmcnt(" #n ")" ::: "memory")
#define PG8_BAR __builtin_amdgcn_s_barrier()
#define PG8_SCHED __builtin_amdgcn_sched_barrier(0)
    Unit cur, nxt; int ui = 0;
    if (!S.next(0, cur)) return;
    f32x4 acc[2][2][4][2];
#pragma unroll
    for (int a = 0; a < 2; ++a)
#pragma unroll
        for (int b = 0; b < 2; ++b)
#pragma unroll
            for (int m = 0; m < 4; ++m)
#pragma unroll
                for (int n = 0; n < 2; ++n) acc[a][b][m][n] = (f32x4){0.f, 0.f, 0.f, 0.f};
    bf16x8 At[4][2], B0[2][2], B1[2][2];
    const char* cA = (const char*)g.A + (size_t)cur.pm * tstep; const char* cB = (const char*)g.Bt + (size_t)cur.pn * tstep;
    S.a_ready(cur);
    if constexpr (SP2) {
        PG8_STAGE(PG8_SB(0, 0), cB, voffB); PG8_STAGE(PG8_SB(0, 1), cB + hstep, voffB); PG8_STAGE(PG8_SA(0, 0), cA, voffA); PG8_STAGE(PG8_SA(0, 1), cA + hstep, voffA);
        if (wr == 1) PG8_BAR;
        PG8_WAIT_V(2); PG8_BAR;
        PG8_STAGE(PG8_SB(1, 0), cB + kstep, voffB); PG8_STAGE(PG8_SA(1, 0), cA + kstep, voffA); PG8_STAGE(PG8_SB(1, 1), cB + hstep + kstep, voffB);
        PG8_WAIT_V(6); PG8_BAR;
    } else {
        PG8_STAGE(PG8_SB(0, 0), cB, voffB); PG8_STAGE(PG8_SA(0, 0), cA, voffA); PG8_STAGE(PG8_SB(0, 1), cB + hstep, voffB); PG8_STAGE(PG8_SA(0, 1), cA + hstep, voffA);
        if (wr == 1) PG8_BAR;
        PG8_WAIT_V(4); PG8_BAR;
        PG8_STAGE(PG8_SB(1, 0), cB + kstep, voffB); PG8_STAGE(PG8_SA(1, 0), cA + kstep, voffA); PG8_STAGE(PG8_SB(1, 1), cB + hstep + kstep, voffB);
        PG8_WAIT_V(6); PG8_BAR;
    }
    for (;;) {
        const bool has_next = S.next(ui + 1, nxt);
        const char* nA = has_next ? (const char*)g.A + (size_t)nxt.pm * tstep : cA; const char* nB = has_next ? (const char*)g.Bt + (size_t)nxt.pn * tstep : cB;
        for (int t = 0; t < nt; t += 2) {
            const bool last = (t == nt - 2);
            const char* a1 = cA + (size_t)(t + 1) * kstep;
            const char* a2 = last ? nA : cA + (size_t)(t + 2) * kstep; const char* b2 = last ? nB : cB + (size_t)(t + 2) * kstep;
            const char* a3 = a2 + kstep; const char* b3 = b2 + kstep;
            if (last && has_next) S.a_ready(nxt);
            if constexpr (SP2) {
            PG8_LDB(B0, 0, 0); PG8_LDB(B1, 0, 1); PG8_SCHED; PG8_LDA(At, 0, 0); PG8_STAGE(PG8_SA(1, 1), a1 + hstep, voffA);
            PG8_WAIT_V(8); PG8_WAIT_L(0); PG8_BAR; PG8_MMA(0, 0, At, B0); PG8_MMA(0, 1, At, B1); PG8_BAR; PG8_SCHED;
            PG8_LDA(At, 0, 1); PG8_STAGE(PG8_SB(0, 0), b2, voffB); PG8_STAGE(PG8_SB(0, 1), b2 + hstep, voffB); PG8_STAGE(PG8_SA(0, 0), a2, voffA);
            PG8_WAIT_V(8); PG8_WAIT_L(0); PG8_BAR; PG8_MMA(1, 0, At, B0); PG8_MMA(1, 1, At, B1); PG8_BAR; PG8_SCHED;
            PG8_LDB(B0, 1, 0); PG8_LDB(B1, 1, 1); PG8_SCHED; PG8_LDA(At, 1, 0); PG8_STAGE(PG8_SA(0, 1), a2 + hstep, voffA);
            PG8_WAIT_V(8); PG8_WAIT_L(0); PG8_BAR; PG8_MMA(0, 0, At, B0); PG8_MMA(0, 1, At, B1); PG8_BAR; PG8_SCHED;
            PG8_LDA(At, 1, 1); PG8_STAGE(PG8_SB(1, 0), b3, voffB); PG8_STAGE(PG8_SB(1, 1), b3 + hstep, voffB); PG8_STAGE(PG8_SA(1, 0), a3, voffA);
            PG8_WAIT_V(8); PG8_WAIT_L(0); PG8_BAR; PG8_MMA(1, 0, At, B0); PG8_MMA(1, 1, At, B1); PG8_BAR; PG8_SCHED;
            } else {
            PG8_LDB(B0, 0, 0); PG8_SCHED; PG8_LDA(At, 0, 0); PG8_STAGE(PG8_SA(1, 1), a1 + hstep, voffA);
            PG8_WAIT_L(8); PG8_BAR; PG8_WAIT_L(0); PG8_MMA(0, 0, At, B0); PG8_BAR; PG8_SCHED;
            PG8_LDB(B1, 0, 1); PG8_STAGE(PG8_SB(0, 0), b2, voffB);
            PG8_BAR; PG8_WAIT_L(0); PG8_MMA(0, 1, At, B1); PG8_BAR;
            PG8_LDA(At, 0, 1); PG8_STAGE(PG8_SA(0, 0), a2, voffA);
            PG8_BAR; PG8_WAIT_L(0); PG8_MMA(1, 0, At, B0); PG8_BAR; PG8_SCHED;
            PG8_STAGE(PG8_SB(0, 1), b2 + hstep, voffB);
            PG8_WAIT_V(6); PG8_BAR; PG8_MMA(1, 1, At, B1); PG8_BAR;
            PG8_LDB(B0, 1, 0); PG8_SCHED; PG8_LDA(At, 1, 0); PG8_STAGE(PG8_SA(0, 1), a2 + hstep, voffA);
            PG8_WAIT_L(8); PG8_BAR; PG8_WAIT_L(0); PG8_MMA(0, 0, At, B0); PG8_BAR; PG8_SCHED;
            PG8_LDB(B1, 1, 1); PG8_STAGE(PG8_SB(1, 0), b3, voffB);
            PG8_BAR; PG8_WAIT_L(0); PG8_MMA(0, 1, At, B1); PG8_BAR;
            PG8_LDA(At, 1, 1); PG8_STAGE(PG8_SA(1, 0), a3, voffA);
            PG8_BAR; PG8_WAIT_L(0); PG8_MMA(1, 0, At, B0); PG8_BAR; PG8_SCHED;
            PG8_STAGE(PG8_SB(1, 1), b3 + hstep, voffB);
            PG8_WAIT_V(6); PG8_BAR; PG8_MMA(1, 1, At, B1); PG8_BAR;
            }
        }
        if constexpr (ALIGN_EPI) { if (wr == 0) PG8_BAR; }
        if constexpr (!Epi::AFTER_DRAIN) { E(acc, cur, wr, wc, fr, fq); S.done(cur); }
        if (!has_next) break;
#pragma unroll
        for (int a = 0; a < 2; ++a)
#pragma unroll
            for (int b = 0; b < 2; ++b)
#pragma unroll
                for (int m = 0; m < 4; ++m)
#pragma unroll
                    for (int n = 0; n < 2; ++n) acc[a][b][m][n] = (f32x4){0.f, 0.f, 0.f, 0.f};
        cur = nxt; cA = nA; cB = nB; ++ui;
        if constexpr (ALIGN_EPI) { if (wr == 1) PG8_BAR; }
    }
    PG8_WAIT_V(0);
    if constexpr (!ALIGN_EPI) { if (wr == 0) PG8_BAR; }
    PG8_BAR;
    if constexpr (Epi::AFTER_DRAIN) { E.fused(acc, cur, wr, wc, fr, fq, lds, wid, lane); S.done(cur); }
#undef PG8_SA
#undef PG8_SB
#undef PG8_STAGE
#undef PG8_LDA
#undef PG8_LDB
#undef PG8_MMA
#undef PG8_WAIT_V
#undef PG8_WAIT_L
#undef PG8_BAR
#undef PG8_SCHED
}
}

#ifndef PG8_SP2
#define PG8_SP2 true
#endif
#ifndef PG8_ALIGN
#define PG8_ALIGN true
#endif
#include <hip/hip_bf16.h>
#include <cmath>
namespace attn_body {
using bf16=__hip_bfloat16;
using bf16x8=__attribute__((ext_vector_type(8)))short;
using s16x4=__attribute__((ext_vector_type(4)))short;
using f32x16=__attribute__((ext_vector_type(16)))float;
using u32x4=__attribute__((ext_vector_type(4)))unsigned;
constexpr int BATCH=4,NHEAD=6,SEQ=8192,D=64,DM=3072,ODM=1024;
constexpr int NW=8,QBLK=32,QB=QBLK*NW,KVBLK=64,NQB=SEQ/QB;
constexpr int ATTN_PITCH=DM, ATTN_UNIT_ROWS=QB;
__device__ __forceinline__ int crow(int r,int hi){return (r&3)+8*(r>>2)+4*hi;}
#define SBAR() __builtin_amdgcn_sched_barrier(0)
__device__ __forceinline__ void cmask(f32x16&p0,f32x16&p1,int jb,int qrel,int hi){
  const float NEG=-INFINITY; int kb=64*jb+4*hi;
  #pragma unroll
  for(int r=0;r<16;++r){int kv=kb+(r&3)+8*(r>>2); if(kv>qrel)p0[r]=NEG; if(kv+32>qrel)p1[r]=NEG;}
}

constexpr int NSLOT=3, SLOTB=8192;
constexpr int LDS_K=0, LDS_V=NSLOT*SLOTB, LDS_WS=2*NSLOT*SLOTB, LDS_OST=LDS_WS+NW*64*4, LDS_CKS=LDS_OST+NW*4096, LDS_BYTES=LDS_CKS+SEQ*4;
constexpr float C2=0.125f*1.4426950408889634f;
__device__ __forceinline__ void glds16(const void*gsrc,unsigned lds_dst){unsigned keep;
  asm volatile("s_mov_b32 %0, m0\n\ts_mov_b32 m0, %2\n\ts_nop 0\n\tglobal_load_lds_dwordx4 %1, off\n\ts_mov_b32 m0, %0":"=&s"(keep):"v"(gsrc),"s"(lds_dst):"memory");}
__device__ __forceinline__ float max3f(float a,float b,float c){float r;asm("v_max3_f32 %0, %1, %2, %3":"=v"(r):"v"(a),"v"(b),"v"(c));return r;}
__device__ __forceinline__ float max2f(float a,float b){float r;asm("v_max_f32_e32 %0, %1, %2":"=v"(r):"v"(a),"v"(b));return r;}
__device__ __forceinline__ float fadd_s(float a,float b){float r;asm("v_add_f32_e32 %0, %1, %2":"=v"(r):"v"(a),"v"(b));return r;}
__device__ __forceinline__ float fsub_s(float a,float b){float r;asm("v_sub_f32_e32 %0, %1, %2":"=v"(r):"v"(a),"v"(b));return r;}
typedef float f32x2_t __attribute__((ext_vector_type(2))); typedef __bf16 bf16x2_t __attribute__((ext_vector_type(2)));
__device__ __forceinline__ unsigned cvtpk_s(float lo,float hi){f32x2_t v={lo,hi};bf16x2_t b=__builtin_convertvector(v,bf16x2_t);return __builtin_bit_cast(unsigned,b);}
#define WAIT_BAR(N) asm volatile("s_waitcnt vmcnt(" #N ") lgkmcnt(0)\n\ts_barrier":::"memory")

__device__ __forceinline__ void qkt(f32x16&p0,f32x16&p1,const char*Kslot,const bf16x8*qr,const f32x16&negm,int r32,int hi){
  const char*kb=Kslot+hi*1024+r32*16;
  #pragma unroll
  for(int d0=0;d0<4;++d0){
    const bf16x8 b0=*reinterpret_cast<const bf16x8*>(kb+d0*2048);
    const bf16x8 b1=*reinterpret_cast<const bf16x8*>(kb+d0*2048+512);
    if(d0==0){p0=__builtin_amdgcn_mfma_f32_32x32x16_bf16(b0,qr[0],negm,0,0,0);p1=__builtin_amdgcn_mfma_f32_32x32x16_bf16(b1,qr[0],negm,0,0,0);}
    else{p0=__builtin_amdgcn_mfma_f32_32x32x16_bf16(b0,qr[d0],p0,0,0,0);p1=__builtin_amdgcn_mfma_f32_32x32x16_bf16(b1,qr[d0],p1,0,0,0);}}
}
typedef __attribute__((address_space(3))) const char* lds_cptr;
typedef short v4i16_t __attribute__((ext_vector_type(4)));
__device__ __forceinline__ void kload8(bf16x8*kf,lds_cptr kp){
  kf[0]=*(const __attribute__((address_space(3))) bf16x8*)(kp);      kf[1]=*(const __attribute__((address_space(3))) bf16x8*)(kp+512);
  kf[2]=*(const __attribute__((address_space(3))) bf16x8*)(kp+2048); kf[3]=*(const __attribute__((address_space(3))) bf16x8*)(kp+2560);
  kf[4]=*(const __attribute__((address_space(3))) bf16x8*)(kp+4096); kf[5]=*(const __attribute__((address_space(3))) bf16x8*)(kp+4608);
  kf[6]=*(const __attribute__((address_space(3))) bf16x8*)(kp+6144); kf[7]=*(const __attribute__((address_space(3))) bf16x8*)(kp+6656);
}
__device__ __forceinline__ void kload2(bf16x8*kf,lds_cptr kp,int j){ kf[2*j]=*(const __attribute__((address_space(3))) bf16x8*)(kp+j*2048); kf[2*j+1]=*(const __attribute__((address_space(3))) bf16x8*)(kp+j*2048+512); }
__device__ __forceinline__ s16x4 vtr(lds_cptr p){ return __builtin_bit_cast(s16x4,__builtin_amdgcn_ds_read_tr16_b64_v4i16((__attribute__((address_space(3))) v4i16_t*)p)); }
__device__ __forceinline__ float rowmax(const f32x16&p0,const f32x16&p1){
  float a=max3f(p0[0],p0[1],p1[0]),b=max3f(p0[2],p0[3],p1[1]);a=max3f(a,p1[2],p1[3]);
  #pragma unroll
  for(int r=4;r<16;r+=4){a=max3f(a,p0[r],p0[r+1]);b=max3f(b,p0[r+2],p0[r+3]);a=max3f(a,p1[r],p1[r+1]);b=max3f(b,p1[r+2],p1[r+3]);}
  const float m=max2f(a,b);
  auto rr=__builtin_amdgcn_permlane32_swap(__float_as_uint(m),__float_as_uint(m),false,false);
  return max2f(__uint_as_float(rr[0]),__uint_as_float(rr[1]));
}
__device__ __forceinline__ void pv(f32x16*o,int vb,bf16x8 pa0,bf16x8 pa1,bf16x8 pa2,bf16x8 pa3){
  #pragma unroll
  for(int d0=0;d0<2;++d0){s16x4 lo[4],hi[4];
    #pragma unroll
    for(int ks=0;ks<4;++ks){
      asm volatile("ds_read_b64_tr_b16 %0,%1 offset:%c2":"=&v"(lo[ks]):"v"(vb),"i"(d0*4096+ks*1024):"memory");
      asm volatile("ds_read_b64_tr_b16 %0,%1 offset:%c2":"=&v"(hi[ks]):"v"(vb),"i"(d0*4096+ks*1024+512):"memory");}
    asm volatile("s_waitcnt lgkmcnt(0)":::"memory");SBAR();
    #define PK(k) (bf16x8){lo[k][0],lo[k][1],lo[k][2],lo[k][3],hi[k][0],hi[k][1],hi[k][2],hi[k][3]}
    o[d0]=__builtin_amdgcn_mfma_f32_32x32x16_bf16(pa0,PK(0),o[d0],0,0,0);
    o[d0]=__builtin_amdgcn_mfma_f32_32x32x16_bf16(pa1,PK(1),o[d0],0,0,0);
    o[d0]=__builtin_amdgcn_mfma_f32_32x32x16_bf16(pa2,PK(2),o[d0],0,0,0);
    o[d0]=__builtin_amdgcn_mfma_f32_32x32x16_bf16(pa3,PK(3),o[d0],0,0,0);
    #undef PK
  }
}

#ifndef ATTN_STORE16
#define ATTN_STORE16(p,v) (*(u32x4*)(p)=(v))
#endif
template<int THRL> __device__ __forceinline__ void attn_unit(int b,int h,int qb,const bf16*Q,const bf16*__restrict__ K,const bf16*__restrict__ V,bf16*O,const float*__restrict__ CUMh,const float*__restrict__ qgain,const float skip_th,char*shm){
  int tid=threadIdx.x; asm volatile("":"+v"(tid)); const int lane=tid&63,r32=lane&31,hi=lane>>5; const int wid=__builtin_amdgcn_readfirstlane(tid>>6);
  const long rowbase=(long)b*SEQ; const int q0=qb*QB;
  const bf16*Qw=Q+(rowbase+q0+wid*QBLK)*DM+h*D;
  const bf16*Kh=K+rowbase*DM+h*D,*Vh=V+rowbase*DM+h*D;
  const float cref=CUMh[q0]; int ts=0;
  { const int tmax=(q0+QB)/KVBLK-4;
    for(int t0=0;t0<tmax;t0+=64){ const int t=t0+lane; bool sk=false; if(t<tmax) sk=(CUMh[64*t+63]-cref)*1.4426950408889634f>skip_th; ts+=__popcll(__ballot(sk)); }
    ts=__builtin_amdgcn_readfirstlane(ts)&~1; }
  Kh+=(long)ts*KVBLK*DM; Vh+=(long)ts*KVBLK*DM;
  const unsigned lds0=(unsigned)(uintptr_t)shm;
  float*wsf=(float*)(shm+LDS_WS)+wid*64;
  const bf16*ksrc=Kh+(long)lane*DM+wid*8;
  const bf16*vsrc=Vh+(long)(16*(wid&3)+(lane>>2))*DM+(wid>>2)*32+(lane&3)*8;
  const unsigned kdst=lds0+LDS_K+wid*1024, vdst=lds0+LDS_V+wid*1024;
  #define DMA_K(t,slot) glds16(ksrc+(long)(t)*KVBLK*DM,(unsigned)__builtin_amdgcn_readfirstlane(kdst+(slot)))
  #define DMA_V(t,slot) glds16(vsrc+(long)(t)*KVBLK*DM,(unsigned)__builtin_amdgcn_readfirstlane(vdst+(slot)))
  const int vb0=(int)(lds0+LDS_V)+((lane>>4)&1)*32+(lane&3)*8+(4*hi+((lane&15)>>2))*64;
  const char*Kbase=shm+LDS_K; bf16x8 kf[8];
  const lds_cptr shm3=(lds_cptr)shm; const lds_cptr kp0=shm3+LDS_K+hi*1024+r32*16; const lds_cptr vp0=shm3+LDS_V+((lane>>4)&1)*32+(lane&3)*8+(4*hi+((lane&15)>>2))*64;
  const int NT=(q0+QB)/KVBLK-ts;
  DMA_K(0,0);DMA_V(0,0);DMA_K(1,SLOTB);
  bf16x8 qr[4];
  #pragma unroll
  for(int d0=0;d0<4;++d0)qr[d0]=*reinterpret_cast<const bf16x8*>(&Qw[(long)r32*DM+d0*16+hi*8]);
  {
    __attribute__((address_space(3))) float*ckw=(__attribute__((address_space(3))) float*)(shm3+LDS_CKS); const int nkv=q0+QB-ts*KVBLK; const float*cums=CUMh+ts*KVBLK;
    for(int i=tid*4;i<nkv;i+=NW*64*4){ const float4 c4=*reinterpret_cast<const float4*>(cums+i);
      ckw[i]=(c4.x-cref)*1.4426950408889634f; ckw[i+1]=(c4.y-cref)*1.4426950408889634f; ckw[i+2]=(c4.z-cref)*1.4426950408889634f; ckw[i+3]=(c4.w-cref)*1.4426950408889634f; }
  }
  float mhat=0.f,l_reg=0.f;f32x16 o[2];o[0]=f32x16{};o[1]=f32x16{};f32x16 negm=f32x16{};asm volatile("":"+v"(negm));
  const int qrel=wid*QBLK+r32;
  #define CMASK(P0,P1,t) do{int jb_=(t)-(NT-4); if(jb_>=0)cmask(P0,P1,jb_,qrel,hi);}while(0)
  bool resc=false;
  #define START(P0,P1) do{ const float rm=rowmax(P0,P1); resc=false; \
    { const float dl=rm; mhat=fadd_s(mhat,dl); \
      _Pragma("unroll") for(int r=0;r<16;++r){P0[r]=fsub_s(P0[r],dl);P1[r]=fsub_s(P1[r],dl);} \
      _Pragma("unroll") for(int r=0;r<16;++r)negm[r]=-mhat; asm volatile("":"+v"(negm)); } \
    _Pragma("unroll") for(int r=0;r<16;++r)P0[r]=__builtin_amdgcn_exp2f(P0[r]); }while(0)
  #define RESC() do{ if(resc){ asm volatile("s_waitcnt lgkmcnt(0)":::"memory"); \
      _Pragma("unroll") for(int d_=0;d_<2;++d_) _Pragma("unroll") for(int r=0;r<16;++r)o[d_][r]*=wsf[crow(r,hi)]; } }while(0)
  typedef float f32x4_t __attribute__((ext_vector_type(4)));
  #define BIAS(P0,P1,t) do{ const __attribute__((address_space(3))) float*ck_=(const __attribute__((address_space(3))) float*)(shm3+LDS_CKS)+(t)*64+4*hi; \
    _Pragma("unroll") for(int g_=0;g_<4;++g_){ const f32x4_t a_=*(const __attribute__((address_space(3))) f32x4_t*)(ck_+8*g_), b_=*(const __attribute__((address_space(3))) f32x4_t*)(ck_+32+8*g_); \
      _Pragma("unroll") for(int j_=0;j_<4;++j_){ float t0_=P0[4*g_+j_]-a_[j_]; asm volatile("":"+v"(t0_)); P0[4*g_+j_]=t0_; float t1_=P1[4*g_+j_]-b_[j_]; asm volatile("":"+v"(t1_)); P1[4*g_+j_]=t1_; } } }while(0)
  f32x16 pA0,pA1,pB0,pB1;
  int sl_prev=0,sl_cur=0,sl_next=SLOTB;
  #define ROT() do{sl_prev=sl_cur;sl_cur=sl_next;sl_next=(sl_next==(NSLOT-1)*SLOTB)?0:sl_next+SLOTB;}while(0)
  DMA_K(2,2*SLOTB);
  WAIT_BAR(3);
  qkt(pA0,pA1,Kbase,qr,negm,r32,hi);asm volatile("s_nop 15\n\ts_nop 7":"+v"(pA0),"+v"(pA1));BIAS(pA0,pA1,0);CMASK(pA0,pA1,0);
  START(pA0,pA1);
  _Pragma("unroll") for(int r=0;r<16;++r)pA1[r]=__builtin_amdgcn_exp2f(pA1[r]);
  WAIT_BAR(0);
  DMA_K(3,0);DMA_V(1,SLOTB);
  ROT();
  kload8(kf,kp0+sl_cur);
  WAIT_BAR(2);
  s16x4 vlo[8],vhi[8]; u32x4 pw0,pw1,pw2,pw3;
  #define PKW(P,B) cvtpk_s(P[B],P[B+1])
  #define PAF(k) __builtin_bit_cast(bf16x8,pw##k)
  #define VFR(i) (bf16x8){vlo[i][0],vlo[i][1],vlo[i][2],vlo[i][3],vhi[i][0],vhi[i][1],vhi[i][2],vhi[i][3]}
  #define PIN(x) asm volatile("":"+v"(x))
  #define MX3(a,b,c) __builtin_fmaxf(__builtin_fmaxf((a),(b)),(c))
  #define GAPA(MF,A0,A1,A2,A3,W0,W1,PW) do{ MF; sacc+=A0; sacc+=A1; sacc+=A2; sacc+=A3; PIN(sacc); W0; W1; PIN(PW); SBAR(); }while(0)
  #define EX(v) __builtin_amdgcn_exp2f(v)
  #define GAPB(MF,X,B) do{ MF; X[B]=EX(X[B]); X[B+1]=EX(X[B+1]); X[B+2]=EX(X[B+2]); X[B+3]=EX(X[B+3]); PIN(X); SBAR(); }while(0)
  #define VRD(i) do{ vlo[i]=vtr(vp_+(((i)>>2)*4096+((i)&3)*1024)); vhi[i]=vtr(vp_+(((i)>>2)*4096+((i)&3)*1024+512)); }while(0)
  #define KRD(G,j) do{ if(G){ kload2(kf,kp0+sl_next,j); SBAR(); } }while(0)
  #define STEP(C0,C1,P0,P1,t,GK,GV,GL) do{ SBAR(); \
    const lds_cptr vp_=vp0+sl_prev; \
    VRD(0); SBAR(); float sacc=(P0[0]+P0[1]); \
    GAPA(C0=__builtin_amdgcn_mfma_f32_32x32x16_bf16(kf[0],qr[0],negm,0,0,0), P0[2],P0[3],P0[4],P0[5],     pw0[0]=PKW(P0,0), pw0[1]=PKW(P0,2), pw0); \
    VRD(4); SBAR(); GAPA(C1=__builtin_amdgcn_mfma_f32_32x32x16_bf16(kf[1],qr[0],negm,0,0,0), P0[6],P0[7],P0[8],P0[9],     pw0[2]=PKW(P0,4), pw0[3]=PKW(P0,6), pw0); \
    VRD(1); SBAR(); GAPA(C0=__builtin_amdgcn_mfma_f32_32x32x16_bf16(kf[2],qr[1],C0,0,0,0),   P0[10],P0[11],P0[12],P0[13], pw1[0]=PKW(P0,8), pw1[1]=PKW(P0,10), pw1); \
    VRD(5); SBAR(); GAPA(C1=__builtin_amdgcn_mfma_f32_32x32x16_bf16(kf[3],qr[1],C1,0,0,0),   P0[14],P0[15],P1[0],P1[1],   pw1[2]=PKW(P0,12),pw1[3]=PKW(P0,14), pw1); \
    VRD(2); SBAR(); GAPA(C0=__builtin_amdgcn_mfma_f32_32x32x16_bf16(kf[4],qr[2],C0,0,0,0),   P1[2],P1[3],P1[4],P1[5],     pw2[0]=PKW(P1,0), pw2[1]=PKW(P1,2), pw2); \
    VRD(6); SBAR(); GAPA(C1=__builtin_amdgcn_mfma_f32_32x32x16_bf16(kf[5],qr[2],C1,0,0,0),   P1[6],P1[7],P1[8],P1[9],     pw2[2]=PKW(P1,4), pw2[3]=PKW(P1,6), pw2); \
    VRD(3); SBAR(); GAPA(C0=__builtin_amdgcn_mfma_f32_32x32x16_bf16(kf[6],qr[3],C0,0,0,0),   P1[10],P1[11],P1[12],P1[13], pw3[0]=PKW(P1,8), pw3[1]=PKW(P1,10), pw3); \
    VRD(7); SBAR(); GAPA(C1=__builtin_amdgcn_mfma_f32_32x32x16_bf16(kf[7],qr[3],C1,0,0,0),   P1[14],P1[15],0.f,0.f,       pw3[2]=PKW(P1,12),pw3[3]=PKW(P1,14), pw3); \
    l_reg+=sacc; \
    if(GK){DMA_K((t)+3,sl_cur);} if(GV){DMA_V((t)+1,sl_next);} \
    BIAS(C0,C1,t); CMASK(C0,C1,t); \
    { float a=MX3(C0[0],C0[1],C1[0]),b=MX3(C0[2],C0[3],C1[1]); a=MX3(a,C1[2],C1[3]); \
      _Pragma("unroll") for(int r=4;r<16;r+=4){a=MX3(a,C0[r],C0[r+1]);b=MX3(b,C0[r+2],C0[r+3]);a=MX3(a,C1[r],C1[r+1]);b=MX3(b,C1[r+2],C1[r+3]);} \
      float rm=__builtin_fmaxf(a,b); { auto rr=__builtin_amdgcn_permlane32_swap(__float_as_uint(rm),__float_as_uint(rm),false,false); rm=__builtin_fmaxf(__uint_as_float(rr[0]),__uint_as_float(rr[1])); } \
      resc=false; \
      if(__builtin_expect(__any(rm>(float)THRL),0)){ const float dl=__builtin_fmaxf(rm,0.f); mhat+=dl; \
        _Pragma("unroll") for(int r=0;r<16;++r){C0[r]-=dl;C1[r]-=dl;} \
        _Pragma("unroll") for(int r=0;r<16;++r)negm[r]=-mhat; asm volatile("":"+v"(negm)); \
        const float f=__builtin_amdgcn_exp2f(-dl); l_reg*=f; if(hi==0)wsf[r32]=f; resc=true; } } \
    SBAR(); \
    GAPB(o[0]=__builtin_amdgcn_mfma_f32_32x32x16_bf16(PAF(0),VFR(0),o[0],0,0,0), C0,0); \
    GAPB(o[1]=__builtin_amdgcn_mfma_f32_32x32x16_bf16(PAF(0),VFR(4),o[1],0,0,0), C0,4); \
    KRD(GL,0); GAPB(o[0]=__builtin_amdgcn_mfma_f32_32x32x16_bf16(PAF(1),VFR(1),o[0],0,0,0), C0,8); \
    KRD(GL,1); GAPB(o[1]=__builtin_amdgcn_mfma_f32_32x32x16_bf16(PAF(1),VFR(5),o[1],0,0,0), C0,12); \
    KRD(GL,2); GAPB(o[0]=__builtin_amdgcn_mfma_f32_32x32x16_bf16(PAF(2),VFR(2),o[0],0,0,0), C1,0); \
    KRD(GL,3); GAPB(o[1]=__builtin_amdgcn_mfma_f32_32x32x16_bf16(PAF(2),VFR(6),o[1],0,0,0), C1,4); \
    GAPB(o[0]=__builtin_amdgcn_mfma_f32_32x32x16_bf16(PAF(3),VFR(3),o[0],0,0,0), C1,8); \
    GAPB(o[1]=__builtin_amdgcn_mfma_f32_32x32x16_bf16(PAF(3),VFR(7),o[1],0,0,0), C1,12); \
    }while(0)
  int t=1;
  #undef CMASK
  #define CMASK(P0,P1,t) do{}while(0)
  for(;t+5<NT;t+=2){
    STEP(pB0,pB1,pA0,pA1,t,true,true,true);     WAIT_BAR(2); RESC(); ROT();
    STEP(pA0,pA1,pB0,pB1,t+1,true,true,true);   WAIT_BAR(2); RESC(); ROT();
  }
  #undef CMASK
  #define CMASK(P0,P1,t) do{int jb_=(t)-(NT-4); if(jb_>=0)cmask(P0,P1,jb_,qrel,hi);}while(0)
  #define ENDW(tt) do{ if((tt)+3<NT){WAIT_BAR(2);} else if((tt)+2<NT){WAIT_BAR(1);} else {WAIT_BAR(0);} }while(0)
  for(;t+1<NT;t+=2){
    STEP(pB0,pB1,pA0,pA1,t,(t+3<NT),(t+1<NT),(t+1<NT));       ENDW(t);   RESC(); ROT();
    STEP(pA0,pA1,pB0,pB1,t+1,(t+4<NT),(t+2<NT),(t+2<NT));     ENDW(t+1); RESC(); ROT();
  }
  STEP(pB0,pB1,pA0,pA1,NT-1,false,false,false); RESC();
  { float sacc=pB0[0]+pB0[1]; _Pragma("unroll") for(int r=2;r<16;++r)sacc+=pB0[r]; _Pragma("unroll") for(int r=0;r<16;++r)sacc+=pB1[r]; l_reg+=sacc;
    pw0=(u32x4){PKW(pB0,0),PKW(pB0,2),PKW(pB0,4),PKW(pB0,6)};pw1=(u32x4){PKW(pB0,8),PKW(pB0,10),PKW(pB0,12),PKW(pB0,14)};pw2=(u32x4){PKW(pB1,0),PKW(pB1,2),PKW(pB1,4),PKW(pB1,6)};pw3=(u32x4){PKW(pB1,8),PKW(pB1,10),PKW(pB1,12),PKW(pB1,14)};
    SBAR(); pv(o,vb0+sl_cur,PAF(0),PAF(1),PAF(2),PAF(3)); }
  #undef PKW
  #undef PAF
  #undef VFR
  #undef PIN
  #undef MX3
  #undef GAPA
  #undef GAPB
  #undef EX
  #undef VRD
  #undef KRD
  #undef STEP
  #undef ENDW
  {auto rr=__builtin_amdgcn_permlane32_swap(__float_as_uint(l_reg),__float_as_uint(l_reg),false,false);l_reg=__uint_as_float(rr[0])+__uint_as_float(rr[1]);}
  if(hi==0)wsf[32+r32]=l_reg;asm volatile("s_waitcnt lgkmcnt(0)":::"memory");
  float rli[16];
  #pragma unroll
  for(int r=0;r<16;++r)rli[r]=__builtin_amdgcn_rcpf(wsf[32+crow(r,hi)]);
  bf16*Ow=O+(rowbase+q0+wid*QBLK)*ODM+h*D;
  { bf16*stg=(bf16*)(shm+LDS_OST)+wid*2048;
    #pragma unroll
    for(int r=0;r<16;++r){const int orow=crow(r,hi);
      #pragma unroll
      for(int d0=0;d0<2;++d0)stg[orow*64+d0*32+r32]=__float2bfloat16(o[d0][r]*rli[r]);}
    asm volatile("s_waitcnt lgkmcnt(0)":::"memory");
    #pragma unroll
    for(int i=0;i<4;++i){const int row=i*8+(lane>>3),ch=lane&7; const u32x4 v=*(const u32x4*)(stg+row*64+ch*8); ATTN_STORE16(Ow+(long)row*ODM+ch*8,v);} }
  asm volatile("s_waitcnt lgkmcnt(0)\n\ts_barrier":::"memory");
  #undef DMA_K
  #undef DMA_V
  #undef CMASK
  #undef START
  #undef RESC
  #undef ROT
  #undef BIAS
}
constexpr int ATTN_LDS_BYTES=LDS_BYTES;
#undef SBAR
#undef WAIT_BAR
}

#define LAS __attribute__((address_space(3)))
typedef unsigned short bfr;
typedef float f32x4v __attribute__((ext_vector_type(4)));
typedef unsigned u32x4v __attribute__((ext_vector_type(4)));
typedef unsigned u32x2v __attribute__((ext_vector_type(2)));
typedef short bf16x8v __attribute__((ext_vector_type(8)));

constexpr int NB = 4, SEQ = 8192, DMODEL = 1024, DEPTH = 4, MROWS = NB * SEQ;
constexpr int NPROJ = 3072, DIN = 2966, DFF = 2816, NGU = 5632, NMOD = 6144, DMIX = 1024;
constexpr int C_LX = 0, C_LG = 384, C_FQ = 768, C_FK = 1152, C_FV = 1536, C_GQ = 1920, C_GK = 2176, C_GV = 2432, C_GG = 2688, C_GL = 2944, C_FF = 2960;
constexpr float EPS = 1e-6f, LOG2E = 1.4426950408889634f;

constexpr size_t MiB = 1u << 20;
constexpr size_t WS_CTL = 0, CTL_BYTES = 65536;
constexpr int CW_BAR = 1024;
constexpr size_t WS_MOD = 1 * MiB;
constexpr size_t WS_CUM = 2 * MiB;
constexpr size_t WS_DEC = 3 * MiB;
constexpr size_t WS_SUMA = 4 * MiB, WS_SUMH = 5 * MiB;
constexpr size_t WS_LRUW = 6 * MiB;
constexpr size_t WS_WIN = 8 * MiB, WS_WOUT = 32 * MiB, WS_WGU = 40 * MiB, WS_WDN = 84 * MiB;
constexpr size_t WIN_L = (size_t)NPROJ * 1024 * 2, WOUT_L = (size_t)1024 * 1024 * 2, WGU_L = (size_t)NGU * 1024 * 2, WDN_L = (size_t)1024 * DFF * 2;
constexpr size_t WS_PROJ = 106 * MiB;
constexpr size_t WS_MIX = 298 * MiB;
constexpr size_t WS_HN = 362 * MiB;
constexpr size_t WS_HL = 362 * MiB, WS_ACUM = 386 * MiB, WS_QDEC = 410 * MiB;
constexpr size_t WS_OINTRA = 426 * MiB;
constexpr size_t WS_KV = 442 * MiB;
constexpr size_t WS_ST = 474 * MiB;
constexpr size_t WS_END = 490 * MiB;
static_assert(WS_WDN + 4 * WDN_L <= WS_PROJ && WS_WGU + 4 * WGU_L <= WS_WDN && WS_WIN + 4 * WIN_L <= WS_WOUT && WS_WOUT + 4 * WOUT_L <= WS_WGU, "ws map");

constexpr int RING_BYTES = 131072, MISC_OFF = RING_BYTES, LDS_BYTES = 147456;
static_assert(attn_body::ATTN_LDS_BYTES <= RING_BYTES, "attention LDS");

__device__ __forceinline__ float bf2f(bfr h) { return __uint_as_float((unsigned)h << 16); }
typedef float f32x2v_ __attribute__((ext_vector_type(2))); typedef __bf16 bf16x2v_ __attribute__((ext_vector_type(2)));
__device__ __forceinline__ unsigned pk2(float lo, float hi) { f32x2v_ v = {lo, hi}; bf16x2v_ b = __builtin_convertvector(v, bf16x2v_); return __builtin_bit_cast(unsigned, b); }
__device__ __forceinline__ bfr f2bf(float f) { return (bfr)(pk2(f, f) & 0xffffu); }
__device__ __forceinline__ float wave_sum(float v) {
#pragma unroll
    for (int o = 1; o < 64; o <<= 1) v += __shfl_xor(v, o);
    return v;
}
__device__ __forceinline__ float sigmoidf_(float x) { return __builtin_amdgcn_rcpf(1.0f + __expf(-x)); }
__device__ __forceinline__ float log_sigmoid_(float z) { return fminf(z, 0.f) - __logf(1.0f + __expf(-fabsf(z))); }
__device__ __forceinline__ float gelu_tanh_(float y) { const float z = 0.7978845608028654f * (y + 0.044715f * y * y * y); const float t = 1.0f - 2.0f * __builtin_amdgcn_rcpf(__expf(2.0f * z) + 1.0f); return 0.5f * y * (1.0f + t); }
__device__ __forceinline__ float silu_(float g) { return g * __builtin_amdgcn_rcpf(1.0f + __expf(-g)); }

struct Params { const float* in[23]; float* out; unsigned char* ws; };

__device__ __forceinline__ int map_in(int n) {
    if (n >= 768 && n < 1536) {
        const int c = n & 255, s_ = (c & 127) >> 5, d = (c & 31) + 32 * (c >> 7), H = 4 * ((n >> 8) - 3) + s_;
        return 768 + H * 64 + d; }
    if (n < 1920) return n;
    if (n < 2688) return n + 6;
    if (n < 2944) return n - 2688 + 2710;
    if (n < 2960) return n - 2944 + 2694;
    if (n < 2966) return n - 2960 + 1920;
    return -1;
}
__device__ __forceinline__ int map_gu(int n) { const int pn = n >> 8, r = n & 255; return r < 128 ? pn * 128 + r : DFF + pn * 128 + (r - 128); }
template <int MODE> __device__ __forceinline__ void transpose_item(const float* __restrict__ W, int K, int N, int NP, bfr* __restrict__ WT, LAS float* scr, int item, int lane) {
    const int nblk = NP / 32, kb = item / nblk, nb = item % nblk, k0 = 64 * kb, n0 = 32 * nb;
    const int nme = n0 + (lane & 31);
    const int nsrc = MODE == 0 ? nme : (MODE == 1 ? map_in(nme) : map_gu(nme));
    float tv_[32]; const int nsc = nsrc < 0 ? 0 : nsrc;
#pragma unroll
    for (int i = 0; i < 32; ++i) { const int kk = 2 * i + (lane >> 5); tv_[i] = W[(size_t)(k0 + kk) * N + nsc]; }
    asm volatile("" :: "v"(tv_[0]), "v"(tv_[1]), "v"(tv_[2]), "v"(tv_[3]), "v"(tv_[4]), "v"(tv_[5]), "v"(tv_[6]), "v"(tv_[7]), "v"(tv_[8]), "v"(tv_[9]), "v"(tv_[10]), "v"(tv_[11]), "v"(tv_[12]), "v"(tv_[13]), "v"(tv_[14]), "v"(tv_[15]) : "memory"); asm volatile("" :: "v"(tv_[16]), "v"(tv_[17]), "v"(tv_[18]), "v"(tv_[19]), "v"(tv_[20]), "v"(tv_[21]), "v"(tv_[22]), "v"(tv_[23]), "v"(tv_[24]), "v"(tv_[25]), "v"(tv_[26]), "v"(tv_[27]), "v"(tv_[28]), "v"(tv_[29]), "v"(tv_[30]), "v"(tv_[31]));
#pragma unroll
    for (int i = 0; i < 32; ++i) { const int kk = 2 * i + (lane >> 5); scr[kk * 33 + (lane & 31)] = nsrc >= 0 ? tv_[i] : 0.f; }
    asm volatile("s_waitcnt lgkmcnt(0)" ::: "memory");
    const int c = lane & 7;
#pragma unroll
    for (int j = 0; j < 4; ++j) { const int n = (lane >> 3) + 8 * j; const LAS float* s = scr + (8 * c) * 33 + n;
        u32x4v o; o.x = pk2(s[0 * 33], s[1 * 33]); o.y = pk2(s[2 * 33], s[3 * 33]); o.z = pk2(s[4 * 33], s[5 * 33]); o.w = pk2(s[6 * 33], s[7 * 33]);
        *(u32x4v*)(WT + (size_t)(n0 + n) * K + k0 + 8 * c) = o; }
    asm volatile("s_waitcnt lgkmcnt(0)" ::: "memory");
}
__device__ __forceinline__ void p0_prologue(const Params& P, LAS unsigned char* lds, int tid, int lane, int wid, int G) {
    asm volatile("" : "+v"(tid), "+v"(lane), "+s"(wid));
    unsigned char* ws = P.ws;
    {
        LAS float* CA = (LAS float*)lds;
        LAS float* RED = (LAS float*)(lds + 16384);
        const float* c = P.in[1];
        for (int i = tid; i < NB * DMODEL; i += 512) CA[i] = silu_(c[i]);
        __syncthreads();
        const int kp = tid >> 5, col = tid & 31;
        float* MOD = (float*)(ws + WS_MOD);
        for (int it = blockIdx.x; it < DEPTH * (NMOD / 32); it += G) {
            const int l = it / (NMOD / 32), c0 = (it % (NMOD / 32)) * 32;
            const float* w = P.in[4] + ((size_t)l * DMODEL + kp * 64) * NMOD + c0 + col;
            float a0 = 0.f, a1 = 0.f, a2 = 0.f, a3 = 0.f;
#pragma unroll 8
            for (int k = 0; k < 64; ++k) { const float wv = w[(size_t)k * NMOD]; const int kk = kp * 64 + k;
                a0 += CA[kk] * wv; a1 += CA[1024 + kk] * wv; a2 += CA[2048 + kk] * wv; a3 += CA[3072 + kk] * wv; }
            RED[(kp * 4 + 0) * 32 + col] = a0; RED[(kp * 4 + 1) * 32 + col] = a1; RED[(kp * 4 + 2) * 32 + col] = a2; RED[(kp * 4 + 3) * 32 + col] = a3;
            __syncthreads();
            if (tid < 128) { const int b = tid >> 5; float s = P.in[5][(size_t)l * NMOD + c0 + col];
#pragma unroll
                for (int q = 0; q < 16; ++q) s += RED[(q * 4 + b) * 32 + col];
                MOD[((size_t)l * NB + b) * NMOD + c0 + col] = s; }
            __syncthreads();
        }
    }
    __syncthreads();
    {
        bfr* LW = (bfr*)(ws + WS_LRUW);
        for (int i = blockIdx.x * 512 + tid; i < DEPTH * 6 * 2 * 4096; i += G * 512) {
            const int d = i & 63, e = (i >> 6) & 63, mat = (i >> 12) & 1, ln = i >> 13;
            const float* src = mat ? P.in[11] : P.in[9];
            LW[i] = f2bf(src[(size_t)ln * 4096 + d * 64 + e]);
        }
    }
    {
        LAS float* scr = (LAS float*)(lds + wid * 16384);
        const int gw = blockIdx.x * 8 + wid, NGW = G * 8;
        constexpr int I_IN = 16 * (NPROJ / 32), I_OUT = 16 * 32, I_GU = 16 * (NGU / 32), I_DN = (DFF / 64) * 32, I_L = I_IN + I_OUT + I_GU + I_DN;
        for (int it = gw; it < DEPTH * I_L; it += NGW) {
            const int l = it / I_L; int r = it % I_L;
            if (r < I_IN) { transpose_item<1>(P.in[6] + (size_t)l * DMODEL * DIN, DMODEL, DIN, NPROJ, (bfr*)(ws + WS_WIN + l * WIN_L), scr, r, lane); continue; } r -= I_IN;
            if (r < I_OUT) { transpose_item<0>(P.in[20] + (size_t)l * DMIX * DMODEL, DMIX, DMODEL, DMODEL, (bfr*)(ws + WS_WOUT + l * WOUT_L), scr, r, lane); continue; } r -= I_OUT;
            if (r < I_GU) { transpose_item<2>(P.in[21] + (size_t)l * DMODEL * NGU, DMODEL, NGU, NGU, (bfr*)(ws + WS_WGU + l * WGU_L), scr, r, lane); continue; } r -= I_GU;
            transpose_item<0>(P.in[22] + (size_t)l * DFF * DMODEL, DFF, DMODEL, DMODEL, (bfr*)(ws + WS_WDN + l * WDN_L), scr, r, lane);
        }
    }
}

__device__ __forceinline__ void norm_phase(const float* __restrict__ x, const bfr* __restrict__ x16, const float* __restrict__ gain, const float* __restrict__ modl, int shift_off, int scale_off, bfr* __restrict__ HN, int gw, int NGW, int lane) {
    asm volatile("" : "+v"(lane), "+s"(gw));
    const bool xloc = (NGW % 64) == 0;
    const int xq = xloc ? (gw >> 3) & 7 : 0, wloc = xloc ? ((gw >> 6) << 3) + (gw & 7) : gw, nwl = xloc ? NGW / 8 : NGW, rbase = xq * (MROWS / 8), rcnt = xloc ? MROWS / 8 : MROWS;
#pragma unroll 4
    for (int r = wloc; r < rcnt; r += nwl) {
        const int m = rbase + r;
        f32x4v v[4]; float s = 0.f;
        if (x16) {
            const u32x2v* xr = (const u32x2v*)(x16 + (size_t)m * DMODEL) + lane;
#pragma unroll
            for (int j = 0; j < 4; ++j) { const u32x2v w = xr[64 * j]; const pg8::f32x2 a = pg8::h2f(w.x), b = pg8::h2f(w.y); v[j] = (f32x4v){a.x, a.y, b.x, b.y}; }
        } else {
            const f32x4v* xr = (const f32x4v*)(x + (size_t)m * DMODEL) + lane;
#pragma unroll
            for (int j = 0; j < 4; ++j) v[j] = xr[64 * j];
        }
#pragma unroll
        for (int j = 0; j < 4; ++j) s += (v[j].x * v[j].x + v[j].y * v[j].y) + (v[j].z * v[j].z + v[j].w * v[j].w);
        const float rstd = 1.0f / sqrtf(wave_sum(s) * (1.0f / DMODEL) + EPS);
        const float* mb = modl + (size_t)(m / SEQ) * NMOD;
        u32x2v* o8 = (u32x2v*)(HN + (size_t)m * DMODEL) + lane;
#pragma unroll
        for (int j = 0; j < 4; ++j) { const int col = 4 * lane + 256 * j;
            const f32x4v g = *(const f32x4v*)(gain + col), sc = *(const f32x4v*)(mb + scale_off + col), sh = *(const f32x4v*)(mb + shift_off + col);
            const f32x4v h = v[j] * rstd * g * (sc + 1.0f) + sh;
            u32x2v w; w.x = pk2(h.x, h.y); w.y = pk2(h.z, h.w); o8[64 * j] = w; }
    }
}

struct LayerPtrs {
    const float *conv_w, *conv_b, *b_r, *b_i, *lam, *fox_bf, *qgain, *kgain, *w_alpha, *b_alpha, *ogain;
    const bfr* lruw;
};

constexpr int LRU_LC = 128, LRU_NCH = SEQ / LRU_LC;
__device__ __forceinline__ void lru_local_item(int idx, const LayerPtrs& L, unsigned char* ws, LAS unsigned char* lds, int tid, int lane, int wid) {
    asm volatile("" : "+v"(tid), "+v"(lane), "+s"(wid));
    const int n = idx % 6, c = (idx / 6) % LRU_NCH, b = idx / (6 * LRU_NCH);
    const int ch = tid & 63, tg = wid;
    const bfr* PROJ = (const bfr*)(ws + WS_PROJ);
    LAS bfr* XA = (LAS bfr*)lds;
    LAS float* RI = (LAS float*)(lds + 18432);
    LAS float* SEG = (LAS float*)(lds + 18432 + 65536);
    const int cg_ = n * 64 + ch;
    const int mat = wid >> 2, fr = lane & 15, fq = lane >> 4;
    const bfr* wt = L.lruw + (size_t)(n * 2 + mat) * 4096;
    bf16x8v bfrag[4][2];
#pragma unroll
    for (int te = 0; te < 4; ++te) { bfrag[te][0] = *(const bf16x8v*)(wt + (16 * te + fr) * 64 + 8 * fq); bfrag[te][1] = *(const bf16x8v*)(wt + (16 * te + fr) * 64 + 32 + 8 * fq); }
    const float lam = L.lam[cg_], br = L.b_r[cg_], bi = L.b_i[cg_];
    float xa[16];
    {
        float raw[19];
        unsigned rawu[19];
#pragma unroll
        for (int j = 0; j < 19; ++j) { const int tt = c * LRU_LC + 16 * tg - 3 + j; rawu[j] = PROJ[((size_t)b * SEQ + (tt < 0 ? 0 : tt)) * NPROJ + C_LX + cg_]; }
        asm volatile("" :: "v"(rawu[0]), "v"(rawu[1]), "v"(rawu[2]), "v"(rawu[3]), "v"(rawu[4]), "v"(rawu[5]), "v"(rawu[6]), "v"(rawu[7]), "v"(rawu[8]), "v"(rawu[9]), "v"(rawu[10]), "v"(rawu[11]), "v"(rawu[12]), "v"(rawu[13]), "v"(rawu[14]), "v"(rawu[15]), "v"(rawu[16]), "v"(rawu[17]), "v"(rawu[18]) : "memory");
#pragma unroll
        for (int j = 0; j < 19; ++j) { const int tt = c * LRU_LC + 16 * tg - 3 + j; raw[j] = tt >= 0 ? bf2f((bfr)rawu[j]) : 0.f; }
        const float w0 = L.conv_w[cg_], w1 = L.conv_w[384 + cg_], w2 = L.conv_w[768 + cg_], w3 = L.conv_w[1152 + cg_], cb = L.conv_b[cg_];
#pragma unroll
        for (int i = 0; i < 16; ++i) { xa[i] = cb + w0 * raw[i] + w1 * raw[i + 1] + w2 * raw[i + 2] + w3 * raw[i + 3]; XA[(16 * tg + i) * 72 + ch] = f2bf(xa[i]); }
    }
    __syncthreads();
    {
#pragma unroll
        for (int q = 0; q < 2; ++q) {
            const int tr = 2 * (wid & 3) + q;
            const bf16x8v a0 = *(const LAS bf16x8v*)(XA + (16 * tr + fr) * 72 + 8 * fq), a1 = *(const LAS bf16x8v*)(XA + (16 * tr + fr) * 72 + 32 + 8 * fq);
#pragma unroll
            for (int te = 0; te < 4; ++te) {
                f32x4v acc = {0.f, 0.f, 0.f, 0.f};
                acc = __builtin_amdgcn_mfma_f32_16x16x32_bf16(a0, bfrag[te][0], acc, 0, 0, 0);
                acc = __builtin_amdgcn_mfma_f32_16x16x32_bf16(a1, bfrag[te][1], acc, 0, 0, 0);
#pragma unroll
                for (int r = 0; r < 4; ++r) RI[(mat * LRU_LC + 16 * tr + 4 * fq + r) * 64 + 16 * te + fr] = acc[r];
            }
        }
    }
    __syncthreads();
    float hs[16], ps[16];
    {
        const float e_ = __expf(-fabsf(lam));
        const float sp = fmaxf(-lam, 0.f) + (e_ < 0.03125f ? e_ * (1.0f - e_ * (0.5f - e_ * (0.33333334f - 0.25f * e_))) : __logf(1.0f + e_));
        float h = 0.f, p = 1.f;
#pragma unroll
        for (int i = 0; i < 16; ++i) {
            const float r = sigmoidf_(RI[(16 * tg + i) * 64 + ch] + br), ig = sigmoidf_(RI[(LRU_LC + 16 * tg + i) * 64 + ch] + bi);
            const float la = -8.0f * r * sp; const float a = __expf(la); const float mult = __builtin_amdgcn_sqrtf(fmaxf(1.0f - a * a, 0.f));
            h = a * h + mult * ig * xa[i]; p *= a; hs[i] = h; ps[i] = p;
        }
        SEG[(tg * 2 + 0) * 64 + ch] = p; SEG[(tg * 2 + 1) * 64 + ch] = h;
    }
    __syncthreads();
    {
        float carry = 0.f, pref = 1.f;
        for (int g = 0; g < tg; ++g) { const float pg = SEG[(g * 2) * 64 + ch], hg = SEG[(g * 2 + 1) * 64 + ch]; carry = pg * carry + hg; pref *= pg; }
        bfr* HL = (bfr*)(ws + WS_HL); bfr* AC = (bfr*)(ws + WS_ACUM);
        const size_t m0 = (size_t)b * SEQ + c * LRU_LC + 16 * tg;
        float hl = 0.f, ac = 0.f;
#pragma unroll
        for (int i = 0; i < 16; ++i) { hl = hs[i] + ps[i] * carry; ac = ps[i] * pref; HL[(m0 + i) * 384 + cg_] = f2bf(hl); AC[(m0 + i) * 384 + cg_] = f2bf(ac); }
        if (tg == 7) { ((float*)(ws + WS_SUMA))[((size_t)b * LRU_NCH + c) * 384 + cg_] = ac; ((float*)(ws + WS_SUMH))[((size_t)b * LRU_NCH + c) * 384 + cg_] = hl; }
    }
    __syncthreads();
}
__device__ __forceinline__ void knorm_item(int idx, const LayerPtrs& L, unsigned char* ws, int tid) {
    asm volatile("" : "+v"(tid));
    bfr* PROJ = (bfr*)(ws + WS_PROJ);
    const int part = tid & 7, hr = tid >> 3;
    const f32x4v g0 = *(const f32x4v*)(L.kgain + part * 8), g1 = *(const f32x4v*)(L.kgain + part * 8 + 4);
#pragma unroll
    for (int p = 0; p < 6; ++p) {
        const int R = p * 64 + hr, tok = R / 6, head = R % 6;
        u32x4v* ptr = (u32x4v*)(PROJ + ((size_t)idx * 64 + tok) * NPROJ + C_FK + head * 64 + part * 8);
        const u32x4v w = *ptr;
        float f[8];
        f[0] = __uint_as_float(w.x << 16); f[1] = __uint_as_float(w.x & 0xffff0000u); f[2] = __uint_as_float(w.y << 16); f[3] = __uint_as_float(w.y & 0xffff0000u);
        f[4] = __uint_as_float(w.z << 16); f[5] = __uint_as_float(w.z & 0xffff0000u); f[6] = __uint_as_float(w.w << 16); f[7] = __uint_as_float(w.w & 0xffff0000u);
        float ss = 0.f;
#pragma unroll
        for (int j = 0; j < 8; ++j) ss += f[j] * f[j];
        ss += __shfl_xor(ss, 1); ss += __shfl_xor(ss, 2); ss += __shfl_xor(ss, 4);
        const float rs = 1.0f / sqrtf(ss * (1.0f / 64.0f) + EPS);
        u32x4v o; o.x = pk2(f[0] * rs * g0.x, f[1] * rs * g0.y); o.y = pk2(f[2] * rs * g0.z, f[3] * rs * g0.w); o.z = pk2(f[4] * rs * g1.x, f[5] * rs * g1.y); o.w = pk2(f[6] * rs * g1.z, f[7] * rs * g1.w);
        *ptr = o;
    }
}
__device__ __forceinline__ void cum_item(int idx, const LayerPtrs& L, unsigned char* ws, LAS unsigned char* lds, int tid, int lane, int wid) {
    asm volatile("" : "+v"(tid), "+v"(lane), "+s"(wid));
    const int b = idx / 6, h = idx % 6;
    const bfr* PROJ = (const bfr*)(ws + WS_PROJ);
    LAS float* WT = (LAS float*)lds;
    const float bf = L.fox_bf[h];
    float loc[16]; float run = 0.f; unsigned fr_[16];
#pragma unroll
    for (int i = 0; i < 16; ++i) fr_[i] = PROJ[((size_t)b * SEQ + 16 * tid + i) * NPROJ + C_FF + h];
    asm volatile("" :: "v"(fr_[0]), "v"(fr_[1]), "v"(fr_[2]), "v"(fr_[3]), "v"(fr_[4]), "v"(fr_[5]), "v"(fr_[6]), "v"(fr_[7]), "v"(fr_[8]), "v"(fr_[9]), "v"(fr_[10]), "v"(fr_[11]), "v"(fr_[12]), "v"(fr_[13]), "v"(fr_[14]), "v"(fr_[15]) : "memory");
#pragma unroll
    for (int i = 0; i < 16; ++i) { const float z = bf2f((bfr)fr_[i]) + bf; run += log_sigmoid_(z); loc[i] = run; }
    float inc = run;
#pragma unroll
    for (int o = 1; o < 64; o <<= 1) { const float t = __shfl_up(inc, o); if (lane >= o) inc += t; }
    if (lane == 63) WT[wid] = inc;
    __syncthreads();
    float base = inc - run;
    for (int w = 0; w < wid; ++w) base += WT[w];
    float* CUM = (float*)(ws + WS_CUM) + ((size_t)b * 6 + h) * SEQ + 16 * tid;
#pragma unroll
    for (int i = 0; i < 16; i += 4) *(f32x4v*)(CUM + i) = (f32x4v){loc[i] + base, loc[i + 1] + base, loc[i + 2] + base, loc[i + 3] + base};
    __syncthreads();
}
__device__ __forceinline__ void gla_local_item(int idx, const LayerPtrs& L, unsigned char* ws, LAS unsigned char* lds, int tid, int lane, int wid) {
    asm volatile("" : "+v"(tid), "+v"(lane), "+s"(wid));
    const int bh = idx >> 6, np = idx & 63, b = bh >> 2, h = bh & 3;
    const int d = tid & 63, tg = wid, fr = lane & 15, fq = lane >> 4;
    const bfr* PROJ = (const bfr*)(ws + WS_PROJ);
    constexpr int CCB = 49152;
    float qf[2][8], kf[2][8]; bfr vb[2][8];
#pragma unroll
    for (int cc = 0; cc < 2; ++cc) {
        unsigned qr_[8], kr_[8], vr_[8];
#pragma unroll
        for (int i = 0; i < 8; ++i) { const size_t m = (size_t)b * SEQ + (2 * np + cc) * 64 + 8 * tg + i;
            qr_[i] = PROJ[m * NPROJ + C_GQ + h * 64 + d]; kr_[i] = PROJ[m * NPROJ + C_GK + h * 64 + d]; vr_[i] = PROJ[m * NPROJ + C_GV + h * 64 + d]; }
        asm volatile("" :: "v"(qr_[0]), "v"(kr_[0]), "v"(vr_[0]), "v"(qr_[1]), "v"(kr_[1]), "v"(vr_[1]), "v"(qr_[2]), "v"(kr_[2]), "v"(vr_[2]), "v"(qr_[3]), "v"(kr_[3]), "v"(vr_[3]), "v"(qr_[4]), "v"(kr_[4]), "v"(vr_[4]), "v"(qr_[5]), "v"(kr_[5]), "v"(vr_[5]), "v"(qr_[6]), "v"(kr_[6]), "v"(vr_[6]), "v"(qr_[7]), "v"(kr_[7]), "v"(vr_[7]) : "memory");
#pragma unroll
        for (int i = 0; i < 8; ++i) { qf[cc][i] = bf2f((bfr)qr_[i]); kf[cc][i] = bf2f((bfr)kr_[i]); vb[cc][i] = (bfr)vr_[i]; }
    }
    float bc[2][8];
    {
        float wal[16];
#pragma unroll
        for (int r = 0; r < 16; ++r) wal[r] = L.w_alpha[r * 256 + h * 64 + d];
        const float bal = L.b_alpha[h * 64 + d];
#pragma unroll
        for (int cc = 0; cc < 2; ++cc) {
            LAS float* SEGB = (LAS float*)(lds + cc * CCB);
            const size_t m0 = (size_t)b * SEQ + (2 * np + cc) * 64;
            float run = 0.f;
            u32x4v l0a[8], l1a[8];
#pragma unroll
            for (int i = 0; i < 8; ++i) { const u32x4v* lp = (const u32x4v*)(PROJ + (m0 + 8 * tg + i) * NPROJ + C_GL); l0a[i] = lp[0]; l1a[i] = lp[1]; }
            asm volatile("" :: "v"(l0a[0]), "v"(l1a[0]), "v"(l0a[1]), "v"(l1a[1]), "v"(l0a[2]), "v"(l1a[2]), "v"(l0a[3]), "v"(l1a[3]), "v"(l0a[4]), "v"(l1a[4]), "v"(l0a[5]), "v"(l1a[5]), "v"(l0a[6]), "v"(l1a[6]), "v"(l0a[7]), "v"(l1a[7]) : "memory");
#pragma unroll
            for (int i = 0; i < 8; ++i) {
                const u32x4v l0 = l0a[i], l1 = l1a[i];
                float z = bal;
                z += __uint_as_float(l0.x << 16) * wal[0] + __uint_as_float(l0.x & 0xffff0000u) * wal[1] + __uint_as_float(l0.y << 16) * wal[2] + __uint_as_float(l0.y & 0xffff0000u) * wal[3];
                z += __uint_as_float(l0.z << 16) * wal[4] + __uint_as_float(l0.z & 0xffff0000u) * wal[5] + __uint_as_float(l0.w << 16) * wal[6] + __uint_as_float(l0.w & 0xffff0000u) * wal[7];
                z += __uint_as_float(l1.x << 16) * wal[8] + __uint_as_float(l1.x & 0xffff0000u) * wal[9] + __uint_as_float(l1.y << 16) * wal[10] + __uint_as_float(l1.y & 0xffff0000u) * wal[11];
                z += __uint_as_float(l1.z << 16) * wal[12] + __uint_as_float(l1.z & 0xffff0000u) * wal[13] + __uint_as_float(l1.w << 16) * wal[14] + __uint_as_float(l1.w & 0xffff0000u) * wal[15];
                run += log_sigmoid_(z) * (1.0f / 16.0f); bc[cc][i] = run;
            }
            SEGB[tg * 64 + d] = run;
        }
    }
    __syncthreads();
#pragma unroll
    for (int cc = 0; cc < 2; ++cc) {
        LAS float* SEGB = (LAS float*)(lds + cc * CCB);
        LAS bfr* QD = (LAS bfr*)(lds + cc * CCB + 2048); LAS bfr* KD = QD + 4608; LAS bfr* KTET = KD + 4608; LAS bfr* VT = KTET + 4608;
        const size_t m0 = (size_t)b * SEQ + (2 * np + cc) * 64;
        float off = 0.f, total = 0.f;
#pragma unroll
        for (int g = 0; g < 8; ++g) { const float sg = SEGB[g * 64 + d]; total += sg; if (g < tg) off += sg; }
        bfr* QDEC = (bfr*)(ws + WS_QDEC);
        unsigned kt[4], vv[4];
#pragma unroll
        for (int i = 0; i < 8; ++i) {
            const size_t m = m0 + 8 * tg + i; const float bcum = bc[cc][i] + off;
            const float q = qf[cc][i], k = kf[cc][i]; const bfr v = vb[cc][i];
            const bfr qd = f2bf(q * 0.125f * __expf(bcum)), kd = f2bf(k * __expf(-bcum)), kte = f2bf(k * __expf(total - bcum));
            QD[(8 * tg + i) * 72 + d] = qd; KD[(8 * tg + i) * 72 + d] = kd; QDEC[m * 256 + h * 64 + d] = qd;
            if (i & 1) { kt[i >> 1] |= (unsigned)kte << 16; vv[i >> 1] |= (unsigned)v << 16; } else { kt[i >> 1] = kte; vv[i >> 1] = v; }
        }
        *(LAS u32x4v*)(KTET + d * 72 + 8 * tg) = (u32x4v){kt[0], kt[1], kt[2], kt[3]};
        *(LAS u32x4v*)(VT + d * 72 + 8 * tg) = (u32x4v){vv[0], vv[1], vv[2], vv[3]};
        if (tg == 0) ((float*)(ws + WS_DEC))[((size_t)bh * 128 + 2 * np + cc) * 64 + d] = __expf(total);
    }
    __syncthreads();
#pragma unroll
    for (int cc = 0; cc < 2; ++cc) {
        LAS bfr* QD = (LAS bfr*)(lds + cc * CCB + 2048); LAS bfr* KD = QD + 4608; LAS bfr* ATT = QD + 4 * 4608;
        const int ti = wid & 3;
#pragma unroll
        for (int q = 0; q < 2; ++q) {
            const int tj = 2 * (wid >> 2) + q;
            f32x4v acc = {0.f, 0.f, 0.f, 0.f};
            if (tj <= ti) {
                const bf16x8v a0 = *(const LAS bf16x8v*)(QD + (16 * ti + fr) * 72 + 8 * fq), a1 = *(const LAS bf16x8v*)(QD + (16 * ti + fr) * 72 + 32 + 8 * fq);
                const bf16x8v b0 = *(const LAS bf16x8v*)(KD + (16 * tj + fr) * 72 + 8 * fq), b1 = *(const LAS bf16x8v*)(KD + (16 * tj + fr) * 72 + 32 + 8 * fq);
                acc = __builtin_amdgcn_mfma_f32_16x16x32_bf16(a0, b0, acc, 0, 0, 0);
                acc = __builtin_amdgcn_mfma_f32_16x16x32_bf16(a1, b1, acc, 0, 0, 0);
            }
#pragma unroll
            for (int r = 0; r < 4; ++r) { const int i = 16 * ti + 4 * fq + r, j = 16 * tj + fr; ATT[i * 72 + j] = f2bf(j <= i ? acc[r] : 0.f); }
        }
    }
    __syncthreads();
#pragma unroll
    for (int cc = 0; cc < 2; ++cc) {
        LAS bfr* QD = (LAS bfr*)(lds + cc * CCB + 2048); LAS bfr* KTET = QD + 2 * 4608; LAS bfr* VT = QD + 3 * 4608; LAS bfr* ATT = QD + 4 * 4608;
        const size_t m0 = (size_t)b * SEQ + (2 * np + cc) * 64;
        const int mat = wid >> 2, t4 = wid & 3;
        if (mat == 0) {
            bfr* OI = (bfr*)(ws + WS_OINTRA);
            const bf16x8v b0 = *(const LAS bf16x8v*)(ATT + (16 * t4 + fr) * 72 + 8 * fq), b1 = *(const LAS bf16x8v*)(ATT + (16 * t4 + fr) * 72 + 32 + 8 * fq);
#pragma unroll
            for (int tv = 0; tv < 4; ++tv) {
                const bf16x8v a0 = *(const LAS bf16x8v*)(VT + (16 * tv + fr) * 72 + 8 * fq), a1 = *(const LAS bf16x8v*)(VT + (16 * tv + fr) * 72 + 32 + 8 * fq);
                f32x4v acc = {0.f, 0.f, 0.f, 0.f};
                acc = __builtin_amdgcn_mfma_f32_16x16x32_bf16(a0, b0, acc, 0, 0, 0);
                acc = __builtin_amdgcn_mfma_f32_16x16x32_bf16(a1, b1, acc, 0, 0, 0);
                u32x2v w; w.x = pk2(acc[0], acc[1]); w.y = pk2(acc[2], acc[3]);
                *(u32x2v*)(OI + (m0 + 16 * t4 + fr) * 256 + h * 64 + 16 * tv + 4 * fq) = w;
            }
        } else {
            float* KV = (float*)(ws + WS_KV) + ((size_t)bh * 128 + 2 * np + cc) * 4096;
            const bf16x8v a0 = *(const LAS bf16x8v*)(KTET + (16 * t4 + fr) * 72 + 8 * fq), a1 = *(const LAS bf16x8v*)(KTET + (16 * t4 + fr) * 72 + 32 + 8 * fq);
#pragma unroll
            for (int tv = 0; tv < 4; ++tv) {
                const bf16x8v b0 = *(const LAS bf16x8v*)(VT + (16 * tv + fr) * 72 + 8 * fq), b1 = *(const LAS bf16x8v*)(VT + (16 * tv + fr) * 72 + 32 + 8 * fq);
                f32x4v acc = {0.f, 0.f, 0.f, 0.f};
                acc = __builtin_amdgcn_mfma_f32_16x16x32_bf16(a0, b0, acc, 0, 0, 0);
                acc = __builtin_amdgcn_mfma_f32_16x16x32_bf16(a1, b1, acc, 0, 0, 0);
                *(f32x4v*)(KV + (16 * tv + fr) * 64 + 16 * t4 + 4 * fq) = acc;
            }
        }
    }
    __syncthreads();
}

__device__ __forceinline__ void gla_scan_item(int idx, unsigned char* ws, int tid) {
    asm volatile("" : "+v"(tid));
    const int bh = idx >> 3, e = (idx & 7) * 512 + tid, d = e & 63;
    const float* KV = (const float*)(ws + WS_KV) + (size_t)bh * 128 * 4096 + e;
    const float* DEC = (const float*)(ws + WS_DEC) + (size_t)bh * 128 * 64 + d;
    bfr* ST = (bfr*)(ws + WS_ST) + (size_t)bh * 128 * 4096 + e;
    float s = 0.f;
    for (int n0 = 0; n0 < 128; n0 += 16) {
        float kv_[16], dc_[16];
#pragma unroll
        for (int k = 0; k < 16; ++k) { kv_[k] = KV[(size_t)(n0 + k) * 4096]; dc_[k] = DEC[(n0 + k) * 64]; }
        asm volatile("" :: "v"(kv_[0]), "v"(kv_[1]), "v"(kv_[2]), "v"(kv_[3]), "v"(kv_[4]), "v"(kv_[5]), "v"(kv_[6]), "v"(kv_[7]), "v"(kv_[8]), "v"(kv_[9]), "v"(kv_[10]), "v"(kv_[11]), "v"(kv_[12]), "v"(kv_[13]), "v"(kv_[14]), "v"(kv_[15]) : "memory"); asm volatile("" :: "v"(dc_[0]), "v"(dc_[1]), "v"(dc_[2]), "v"(dc_[3]), "v"(dc_[4]), "v"(dc_[5]), "v"(dc_[6]), "v"(dc_[7]), "v"(dc_[8]), "v"(dc_[9]), "v"(dc_[10]), "v"(dc_[11]), "v"(dc_[12]), "v"(dc_[13]), "v"(dc_[14]), "v"(dc_[15]));
#pragma unroll
        for (int k = 0; k < 16; ++k) { ST[(size_t)(n0 + k) * 4096] = f2bf(s); s = dc_[k] * s + kv_[k]; }
    }
}
__device__ __forceinline__ void lru_out_item(int q, unsigned char* ws, LAS unsigned char* lds, int tid, int wid) {
    asm volatile("" : "+v"(tid), "+s"(wid));
    const int b = q / 96, rem = q % 96, n = rem / 16, cgp = rem % 16;
    const int ch = tid & 63, tg = wid, cg_ = n * 64 + ch;
    const float* SA = (const float*)(ws + WS_SUMA) + (size_t)b * LRU_NCH * 384 + cg_;
    const float* SH = (const float*)(ws + WS_SUMH) + (size_t)b * LRU_NCH * 384 + cg_;
    LAS float* COMP = (LAS float*)lds;
    {
        const int nprev = 4 * cgp;
        float pw = 1.f, hw = 0.f;
        for (int j = (tg * nprev) >> 3; j < ((tg + 1) * nprev) >> 3; ++j) { const float a = SA[j * 384], hh = SH[j * 384]; hw = a * hw + hh; pw *= a; }
        COMP[(tg * 2) * 64 + ch] = pw; COMP[(tg * 2 + 1) * 64 + ch] = hw;
    }
    __syncthreads();
    float carry = 0.f;
#pragma unroll
    for (int g = 0; g < 8; ++g) carry = COMP[(g * 2) * 64 + ch] * carry + COMP[(g * 2 + 1) * 64 + ch];
    const bfr* HL = (const bfr*)(ws + WS_HL); const bfr* AC = (const bfr*)(ws + WS_ACUM); const bfr* PROJ = (const bfr*)(ws + WS_PROJ); bfr* MIX = (bfr*)(ws + WS_MIX);
    for (int cc = 0; cc < 4; ++cc) {
        const int c = cgp * 4 + cc;
        const size_t m0 = (size_t)b * SEQ + c * LRU_LC + 16 * tg;
        const float sa = SA[c * 384], sh = SH[c * 384];
        unsigned hlr[16], acr[16], yr[16];
#pragma unroll
        for (int i = 0; i < 16; ++i) { const size_t m = m0 + i; hlr[i] = HL[m * 384 + cg_]; acr[i] = AC[m * 384 + cg_]; yr[i] = PROJ[m * NPROJ + C_LG + cg_]; }
        asm volatile("" :: "v"(hlr[0]), "v"(hlr[1]), "v"(hlr[2]), "v"(hlr[3]), "v"(hlr[4]), "v"(hlr[5]), "v"(hlr[6]), "v"(hlr[7]), "v"(hlr[8]), "v"(hlr[9]), "v"(hlr[10]), "v"(hlr[11]), "v"(hlr[12]), "v"(hlr[13]), "v"(hlr[14]), "v"(hlr[15]) : "memory"); asm volatile("" :: "v"(acr[0]), "v"(acr[1]), "v"(acr[2]), "v"(acr[3]), "v"(acr[4]), "v"(acr[5]), "v"(acr[6]), "v"(acr[7]), "v"(acr[8]), "v"(acr[9]), "v"(acr[10]), "v"(acr[11]), "v"(acr[12]), "v"(acr[13]), "v"(acr[14]), "v"(acr[15]) : "memory"); asm volatile("" :: "v"(yr[0]), "v"(yr[1]), "v"(yr[2]), "v"(yr[3]), "v"(yr[4]), "v"(yr[5]), "v"(yr[6]), "v"(yr[7]), "v"(yr[8]), "v"(yr[9]), "v"(yr[10]), "v"(yr[11]), "v"(yr[12]), "v"(yr[13]), "v"(yr[14]), "v"(yr[15]) : "memory");
#pragma unroll
        for (int i = 0; i < 16; ++i) { const size_t m = m0 + i;
            const float hh = bf2f((bfr)hlr[i]) + bf2f((bfr)acr[i]) * carry; const float y = bf2f((bfr)yr[i]);
            MIX[m * DMIX + cg_] = f2bf(hh * gelu_tanh_(y)); }
        carry = sa * carry + sh;
    }
}
__device__ __forceinline__ void gla_out_item(int idx, const LayerPtrs& L, unsigned char* ws, int lane) {
    asm volatile("" : "+v"(lane));
    const int bh = idx >> 7, n = idx & 127, b = bh >> 2, h = bh & 3, fr = lane & 15, fq = lane >> 4;
    const size_t m0 = (size_t)b * SEQ + n * 64;
    const bfr* ST = (const bfr*)(ws + WS_ST) + (size_t)idx * 4096; const bfr* QDEC = (const bfr*)(ws + WS_QDEC); const bfr* OI = (const bfr*)(ws + WS_OINTRA);
    const bfr* PROJ = (const bfr*)(ws + WS_PROJ); bfr* MIX = (bfr*)(ws + WS_MIX);
    bf16x8v st[4][2];
#pragma unroll
    for (int tv = 0; tv < 4; ++tv)
#pragma unroll
        for (int ks = 0; ks < 2; ++ks) st[tv][ks] = *(const bf16x8v*)(ST + (16 * tv + fr) * 64 + 32 * ks + 8 * fq);
    f32x4v gn[4];
#pragma unroll
    for (int tv = 0; tv < 4; ++tv) gn[tv] = *(const f32x4v*)(L.ogain + 16 * tv + 4 * fq);
#pragma unroll
    for (int ti = 0; ti < 4; ++ti) {
        const size_t m = m0 + 16 * ti + fr;
        const bf16x8v q0 = *(const bf16x8v*)(QDEC + m * 256 + h * 64 + 8 * fq), q1 = *(const bf16x8v*)(QDEC + m * 256 + h * 64 + 32 + 8 * fq);
        u32x2v oiw[4], ggw[4];
#pragma unroll
        for (int tv = 0; tv < 4; ++tv) { oiw[tv] = *(const u32x2v*)(OI + m * 256 + h * 64 + 16 * tv + 4 * fq); ggw[tv] = *(const u32x2v*)(PROJ + m * NPROJ + C_GG + h * 64 + 16 * tv + 4 * fq); }
        asm volatile("" :: "v"(q0), "v"(q1), "v"(oiw[0]), "v"(oiw[1]), "v"(oiw[2]), "v"(oiw[3]), "v"(ggw[0]), "v"(ggw[1]), "v"(ggw[2]), "v"(ggw[3]) : "memory");
        f32x4v o[4]; float ss = 0.f;
#pragma unroll
        for (int tv = 0; tv < 4; ++tv) {
            f32x4v acc = {0.f, 0.f, 0.f, 0.f};
            acc = __builtin_amdgcn_mfma_f32_16x16x32_bf16(st[tv][0], q0, acc, 0, 0, 0);
            acc = __builtin_amdgcn_mfma_f32_16x16x32_bf16(st[tv][1], q1, acc, 0, 0, 0);
            const u32x2v w = oiw[tv];
            acc[0] += __uint_as_float(w.x << 16); acc[1] += __uint_as_float(w.x & 0xffff0000u); acc[2] += __uint_as_float(w.y << 16); acc[3] += __uint_as_float(w.y & 0xffff0000u);
            o[tv] = acc; ss += (acc[0] * acc[0] + acc[1] * acc[1]) + (acc[2] * acc[2] + acc[3] * acc[3]);
        }
        ss += __shfl_xor(ss, 16); ss += __shfl_xor(ss, 32);
        const float rs = 1.0f / sqrtf(ss * (1.0f / 64.0f) + EPS);
#pragma unroll
        for (int tv = 0; tv < 4; ++tv) {
            const u32x2v gw = ggw[tv];
            const float g0 = __uint_as_float(gw.x << 16), g1 = __uint_as_float(gw.x & 0xffff0000u), g2 = __uint_as_float(gw.y << 16), g3 = __uint_as_float(gw.y & 0xffff0000u);
            u32x2v w; w.x = pk2(o[tv][0] * rs * gn[tv][0] * silu_(g0), o[tv][1] * rs * gn[tv][1] * silu_(g1)); w.y = pk2(o[tv][2] * rs * gn[tv][2] * silu_(g2), o[tv][3] * rs * gn[tv][3] * silu_(g3));
            *(u32x2v*)(MIX + m * DMIX + 768 + h * 64 + 16 * tv + 4 * fq) = w;
        }
    }
}

#define XB_TMO      128
#define XB_XCNT(j)  (256  + 64 * (j))
#define XB_XSUB(j)  (1280 + 64 * (j))
#define XB_XGEN(j)  (2304 + 64 * (j))
#define XB_TOP      3328
#define XB_TOPGEN   3392
#define XCD_BAR_WORDS 3456
#define XB_SPIN_CAP (1u << 18)

__device__ __forceinline__ unsigned xb_ld(unsigned* p)              { return __hip_atomic_load(p, __ATOMIC_RELAXED, __HIP_MEMORY_SCOPE_AGENT); }
__device__ __forceinline__ unsigned xb_add(unsigned* p, unsigned v) { return __hip_atomic_fetch_add(p, v, __ATOMIC_RELAXED, __HIP_MEMORY_SCOPE_AGENT); }
__device__ __forceinline__ unsigned xb_xcc_id() { return (unsigned)__builtin_amdgcn_s_getreg((3 << 11) | 20) & 0xFu; }
#define XB_SPIN(cond, bar) do { unsigned _sp = 0; while (cond) { __builtin_amdgcn_s_sleep(1); \
    if ((++_sp & 255u) == 0u) { if (xb_ld(&(bar)[XB_TMO])) break; if (_sp > XB_SPIN_CAP) { atomicAdd(&(bar)[XB_TMO], 1u); break; } } } } while (0)

struct XcdBarrier {
    unsigned* bar; unsigned x;
    volatile LAS unsigned* st;
};

__device__ __forceinline__ XcdBarrier xcd_barrier_post(unsigned* bar, volatile LAS unsigned* st) {
    XcdBarrier b; b.bar = bar; b.x = xb_xcc_id(); b.st = st;
    if (threadIdx.x == 0) (void)xb_add(&bar[XB_XCNT(b.x)], 1u);
    return b;
}
__device__ __forceinline__ void xcd_barrier_complete(unsigned* bar, unsigned x, unsigned& nloc, unsigned& nx) {
    const unsigned G = gridDim.x * gridDim.y * gridDim.z;
    unsigned sum, cnt, mine, sp = 0u;
    for (;;) {
        sum = 0u; cnt = 0u; mine = 0u;
#pragma unroll
        for (unsigned j = 0; j < 16; ++j) { const unsigned c = xb_ld(&bar[XB_XCNT(j)]); sum += c; cnt += (c > 0u) ? 1u : 0u; mine = (j == x) ? c : mine; }
        if (sum == G) break;
        __builtin_amdgcn_s_sleep(1);
        if ((++sp & 255u) == 0u) { if (xb_ld(&bar[XB_TMO])) break; if (sp > XB_SPIN_CAP) { atomicAdd(&bar[XB_TMO], 1u); break; } }
    }
    nloc = mine > 0u ? mine : 1u; nx = cnt > 0u ? cnt : 1u;
}

__device__ __forceinline__ void xcd_barrier(const XcdBarrier& b) {
    asm volatile("s_waitcnt vmcnt(0)" ::: "memory");
    __syncthreads();
    if (threadIdx.x == 0) {
        unsigned* bar = b.bar;
        __builtin_amdgcn_s_waitcnt(0);
        unsigned nloc = b.st[0], nx = b.st[1];
        if (nloc == 0u) { xcd_barrier_complete(bar, b.x, nloc, nx); b.st[0] = nloc; b.st[1] = nx; }
        const unsigned old = xb_add(&bar[XB_XSUB(b.x)], 1u);
        const unsigned gen = old / nloc;
        if (old + 1u == (gen + 1u) * nloc) {
            __builtin_amdgcn_fence(__ATOMIC_RELEASE, "agent");
            asm volatile("s_waitcnt vmcnt(0)" ::: "memory");
            const unsigned og = xb_add(&bar[XB_TOP], 1u);
            const unsigned tg = og / nx;
            if (og + 1u == (tg + 1u) * nx) xb_add(&bar[XB_TOPGEN], 1u);
            else XB_SPIN(xb_ld(&bar[XB_TOPGEN]) == tg, bar);
            __builtin_amdgcn_fence(__ATOMIC_ACQUIRE, "agent");
            xb_add(&bar[XB_XGEN(b.x)], 1u);
            asm volatile("s_waitcnt vmcnt(0)" ::: "memory");
        } else {
            XB_SPIN(xb_ld(&bar[XB_XGEN(b.x)]) == gen, bar);
            __builtin_amdgcn_fence(__ATOMIC_ACQUIRE, "agent");
            asm volatile("s_waitcnt vmcnt(0)" ::: "memory");
        }
    }
    __syncthreads();
}

#ifdef EXP_P2
#define EXP_KN_ONCE (rep_ == 0)
#else
#define EXP_KN_ONCE true
#endif
#define XBAR1() do { XcdBarrier b_; b_.bar = (unsigned*)P.ws + CW_BAR; b_.x = xb_xcc_id(); b_.st = (volatile LAS unsigned*)(lds + MISC_OFF + 32); xcd_barrier(b_); } while (0)
#ifdef EXP_SYNC
#define GSYNC() do { XBAR1(); XBAR1(); } while (0)
#else
#define GSYNC() XBAR1()
#endif
__global__ void __launch_bounds__(512, 2) hybrid_fwd(Params P) {
    extern __shared__ __attribute__((aligned(16))) unsigned char lds_raw[];
    cg::grid_group grid = cg::this_grid();
    LAS unsigned char* lds = (LAS unsigned char*)lds_raw;
    const int tid = threadIdx.x, lane = tid & 63, wid = __builtin_amdgcn_readfirstlane(tid >> 6);
    const int G = gridDim.x, gw = blockIdx.x * 8 + wid, NGW = G * 8;
    unsigned char* ws = P.ws;
    unsigned* ctl = (unsigned*)(ws + WS_CTL);
    volatile LAS int* slot = (volatile LAS int*)(lds + MISC_OFF);
    const float* MOD = (const float*)(ws + WS_MOD);
    bfr* XB = (bfr*)P.out;
    bfr* HN = (bfr*)(ws + WS_HN); bfr* PROJ = (bfr*)(ws + WS_PROJ); bfr* MIX = (bfr*)(ws + WS_MIX); bfr* GB = (bfr*)(ws + WS_PROJ);

    if (tid < 16) ((LAS unsigned*)(lds + MISC_OFF))[tid] = 0u;
    __syncthreads();
    (void)xcd_barrier_post(ctl + CW_BAR, (volatile LAS unsigned*)(lds + MISC_OFF + 32));
    p0_prologue(P, lds, tid, lane, wid, G);
#ifdef EXP_P0
    __syncthreads(); p0_prologue(P, lds, tid, lane, wid, G);
#endif
    grid.sync();

    for (int l = 0; l < DEPTH; ++l) {
        const float* modl = MOD + (size_t)l * NB * NMOD;
        bfr* XBm = l < DEPTH - 1 ? XB : (bfr*)(ws + WS_OINTRA);
        LayerPtrs L;
        L.conv_w = P.in[7] + (size_t)l * 4 * 384; L.conv_b = P.in[8] + (size_t)l * 384; L.b_r = P.in[10] + (size_t)l * 384; L.b_i = P.in[12] + (size_t)l * 384; L.lam = P.in[13] + (size_t)l * 384;
        L.fox_bf = P.in[14] + (size_t)l * 6; L.qgain = P.in[15] + (size_t)l * 64; L.kgain = P.in[16] + (size_t)l * 64;
        L.w_alpha = P.in[17] + (size_t)l * 16 * 256; L.b_alpha = P.in[18] + (size_t)l * 256; L.ogain = P.in[19] + (size_t)l * 64;
        L.lruw = (const bfr*)(ws + WS_LRUW) + (size_t)l * 6 * 2 * 4096;

        norm_phase(P.in[0], l == 0 ? (const bfr*)nullptr : XB, P.in[2] + (size_t)l * DMODEL, modl, 0, 1024, HN, gw, NGW, lane);
        GSYNC();
        {
            pg8::Gemm g{HN, (const bfr*)(ws + WS_WIN + l * WIN_L), MROWS, NPROJ, DMODEL}; pg8::StaticOrder S; S.init(MROWS, NPROJ, G, (int)blockIdx.x);
            pg8::EpiProj E{PROJ, NPROJ, L.qgain, L.kgain, C_FQ};
            pg8::gemm_phase<pg8::EpiProj, pg8::StaticOrder, PG8_ALIGN, PG8_SP2>(lds, g, S, E);
#ifdef EXP_G16
            __syncthreads(); pg8::gemm_phase<pg8::EpiBf16<0>, pg8::StaticOrder, PG8_ALIGN, PG8_SP2>(lds, g, S, E);
#endif
        }
        GSYNC();
        {
            constexpr int N_CUM = 24, N_GLA = 1024, N_LL = 6 * LRU_NCH * NB, N_KN = 0, N_P2 = N_CUM + N_GLA + N_LL + N_KN;
#ifdef EXP_P2
          for (int rep_ = 0; rep_ < 2; ++rep_) {
            unsigned* ctr = ctl + 64 * l + 16 + 8 * rep_;
#else
            unsigned* ctr = ctl + 64 * l + 16;
#endif
            int cur = blockIdx.x, itn = 0;
            while (cur < N_P2) {
                if (tid == 0) slot[itn & 1] = (int)atomicAdd(ctr, 1u) + G;
                if (cur < N_CUM) cum_item(cur, L, ws, lds, tid, lane, wid);
                else if (cur < N_CUM + N_GLA) gla_local_item(cur - N_CUM, L, ws, lds, tid, lane, wid);
                else if (cur < N_CUM + N_GLA + N_LL) lru_local_item(cur - N_CUM - N_GLA, L, ws, lds, tid, lane, wid);
                __syncthreads();
                cur = slot[itn & 1]; ++itn;
            }
#ifdef EXP_P2
            __syncthreads();
          }
#endif
        }
        GSYNC();
        {
            constexpr int N_ATT = 768, N_SCAN = 128, N_LRU = 384, N_GO = 256, N_ALL = N_ATT + N_SCAN + N_LRU + N_GO;
            unsigned* sdone = ctl + 64 * l + 48;
#ifdef EXP_P3
          for (int rep_ = 0; rep_ < 2; ++rep_) {
            unsigned* ctr = ctl + 64 * l + 32 * rep_;
#else
            unsigned* ctr = ctl + 64 * l;
#endif
            float skip_th;
            { int ln_ = lane; asm volatile("" : "+v"(ln_)); float gq = fabsf(L.qgain[ln_]), gk = fabsf(L.kgain[ln_]);
#pragma unroll
              for (int o = 1; o < 64; o <<= 1) { gq = fmaxf(gq, __shfl_xor(gq, o)); gk = fmaxf(gk, __shfl_xor(gk, o)); }
              skip_th = 150.0f + 2.0f * 11.7f * gq * gk; }
            int cur = blockIdx.x, itn = 0;
            while (cur < N_ALL) {
                if (tid == 0) slot[itn & 1] = (int)atomicAdd(ctr, 1u) + G;
                if (cur < N_SCAN) {
                    gla_scan_item(cur, ws, tid);
                    __syncthreads();
                    if (tid == 0) { __builtin_amdgcn_fence(__ATOMIC_RELEASE, "agent"); asm volatile("s_waitcnt vmcnt(0)" ::: "memory"); __hip_atomic_fetch_add(sdone + (cur >> 3), 1u, __ATOMIC_RELAXED, __HIP_MEMORY_SCOPE_AGENT); }
                } else if (cur < N_SCAN + N_ATT) {
                    const int ua = cur - N_SCAN; const int qb = 31 - ua / 24, bh = ua % 24, b = bh / 6, h = bh % 6;
                    attn_body::attn_unit<96>(b, h, qb, (const attn_body::bf16*)(PROJ + C_FQ), (const attn_body::bf16*)(PROJ + C_FK), (const attn_body::bf16*)(PROJ + C_FV), (attn_body::bf16*)(MIX + 384),
                                            (const float*)(ws + WS_CUM) + (size_t)bh * SEQ, L.qgain, skip_th, (char*)lds_raw);
                } else if (cur < N_SCAN + N_ATT + N_LRU) {
                    lru_out_item(cur - N_ATT - N_SCAN, ws, lds, tid, wid);
                } else {
                    const int gi = (cur - N_SCAN - N_ATT - N_LRU) * 8;
                    if (tid == 0) { unsigned sp = 0; while (__hip_atomic_load(sdone + (gi >> 7), __ATOMIC_RELAXED, __HIP_MEMORY_SCOPE_AGENT) < 8u) { __builtin_amdgcn_s_sleep(2); if (++sp > (1u << 22)) break; }
                        __builtin_amdgcn_fence(__ATOMIC_ACQUIRE, "agent"); asm volatile("s_waitcnt vmcnt(0)" ::: "memory"); }
                    __syncthreads();
                    gla_out_item(gi + wid, L, ws, lane);
                }
                __syncthreads();
                cur = slot[itn & 1]; ++itn;
            }
#ifdef EXP_P3
            __syncthreads();
          }
#endif
        }
        GSYNC();
        {
            pg8::Gemm g{MIX, (const bfr*)(ws + WS_WOUT + l * WOUT_L), MROWS, DMODEL, DMIX}; pg8::StaticOrder S; S.init(MROWS, DMODEL, G, (int)blockIdx.x);
            pg8::EpiResidB E{l == 0 ? P.in[0] : (const float*)nullptr, XB, XBm, (float*)nullptr, DMODEL, modl + 2048, NMOD, SEQ};
            pg8::gemm_phase<pg8::EpiResidB, pg8::StaticOrder, PG8_ALIGN, PG8_SP2>(lds, g, S, E);
        }
        GSYNC();
        norm_phase(P.in[0], XBm, P.in[3] + (size_t)l * DMODEL, modl, 3072, 4096, HN, gw, NGW, lane);
        GSYNC();
        {
            pg8::Gemm g{HN, (const bfr*)(ws + WS_WGU + l * WGU_L), MROWS, NGU, DMODEL}; pg8::StaticOrder S; S.init(MROWS, NGU, G, (int)blockIdx.x);
            pg8::EpiSwiGLU E{GB, DFF};
            pg8::gemm_phase<pg8::EpiSwiGLU, pg8::StaticOrder, PG8_ALIGN, PG8_SP2>(lds, g, S, E);
#ifdef EXP_G16
            __syncthreads(); pg8::gemm_phase<pg8::EpiSwiGLU, pg8::StaticOrder, PG8_ALIGN, PG8_SP2>(lds, g, S, E);
#endif
        }
        GSYNC();
        {
            pg8::Gemm g{GB, (const bfr*)(ws + WS_WDN + l * WDN_L), MROWS, DMODEL, DFF}; pg8::StaticOrder S; S.init(MROWS, DMODEL, G, (int)blockIdx.x);
            pg8::EpiResidB E{(const float*)nullptr, XBm, l < DEPTH - 1 ? XB : (bfr*)nullptr, l < DEPTH - 1 ? (float*)nullptr : P.out, DMODEL, modl + 5120, NMOD, SEQ};
            pg8::gemm_phase<pg8::EpiResidB, pg8::StaticOrder, PG8_ALIGN, PG8_SP2>(lds, g, S, E);
        }
        if (l < DEPTH - 1) GSYNC();
    }
}

extern "C" void kernel_launch(void* const* d_in, const int* in_sizes, int n_in, void* d_out, int out_size, void* d_ws, size_t ws_size, hipStream_t stream) {
    static int grid = 0;
    if (grid == 0) {
        if (n_in != 23 || out_size != MROWS * DMODEL || ws_size < WS_END) { fprintf(stderr, "kernel_launch: unexpected shapes (n_in %d out %d ws %zu)\n", n_in, out_size, ws_size); grid = -1; return; }
        int dev = 0, cus = 0, per_cu = 0;
        if (hipGetDevice(&dev) != hipSuccess || hipDeviceGetAttribute(&cus, hipDeviceAttributeMultiprocessorCount, dev) != hipSuccess) { grid = -1; return; }
        if (hipFuncSetAttribute((const void*)hybrid_fwd, hipFuncAttributeMaxDynamicSharedMemorySize, LDS_BYTES) != hipSuccess) { fprintf(stderr, "kernel_launch: hipFuncSetAttribute failed\n"); grid = -1; return; }
        if (hipOccupancyMaxActiveBlocksPerMultiprocessor(&per_cu, (const void*)hybrid_fwd, 512, LDS_BYTES) != hipSuccess || per_cu < 1) { fprintf(stderr, "kernel_launch: occupancy query says %d\n", per_cu); per_cu = 1; }
        (void)hipGetLastError();
        grid = cus;
    }
    if (grid < 0) return;
    (void)hipMemsetAsync((char*)d_ws + WS_CTL, 0, CTL_BYTES, stream);
    Params p{};
    for (int i = 0; i < 23; ++i) p.in[i] = (const float*)d_in[i];
    p.out = (float*)d_out; p.ws = (unsigned char*)d_ws;
    void* args[] = {&p};
    hipError_t e = hipLaunchCooperativeKernel((const void*)hybrid_fwd, dim3(grid), dim3(512), args, LDS_BYTES, stream);
    if (e != hipSuccess) fprintf(stderr, "kernel_launch: cooperative launch failed: %s (grid %d)\n", hipGetErrorString(e), grid);
}
```
